# Optimizing an MI355X kernel written in HIP

```python
import jax, jax.numpy as jnp
from jax import lax
import numpy as np

D_MODEL = 1024
BATCH = 4
SEQ = 4096
DEPTH = 1

N_HEADS = 16
HEAD_DIM = 64
N_KV = 4
HPG = N_HEADS // N_KV
ATTN_DIM = N_HEADS * HEAD_DIM
KV_DIM = N_KV * HEAD_DIM
CMP_BLOCK = 32
CMP_STRIDE = 16
CMP_HIDDEN = 256
SEL_BLOCK = 64
N_SEL = 16
WINDOW = 512
Q_BLOCK = 128
FORCE_BONUS = 1e4
LRU_WIDTH = 1024
LRU_BLOCKS = 16
LRU_BW = LRU_WIDTH // LRU_BLOCKS
CONV_W = 4
LRU_C = 8.0
D_FF = -(-8 * D_MODEL // 768) * 256
IN_DIM = ATTN_DIM + 6 * KV_DIM + 3 * N_HEADS + 2 * LRU_WIDTH + 2 * D_MODEL
EPS = 1e-6

kernel_name = "hybrid_nsa_rglru_gated_block"


def _rmsnorm(x, g):
    xf = x.astype(jnp.float32)
    y = xf * lax.rsqrt(jnp.mean(xf * xf, axis=-1, keepdims=True) + EPS)
    return (y * g.astype(jnp.float32)).astype(x.dtype)


def _masked_softmax(s, mask):
    s = jnp.where(mask, s.astype(jnp.float32), -1e30)
    m = jnp.max(s, axis=-1, keepdims=True)
    e = jnp.exp(s - m) * mask
    return e / jnp.maximum(jnp.sum(e, axis=-1, keepdims=True), 1e-30)


def _alibi_slopes():
    return np.power(2.0, -8.0 * np.arange(1, N_HEADS + 1) / N_HEADS).astype(np.float32)


def _cmp_to_sel_map(n_cmp, n_blk):
    cs = np.arange(n_cmp) * CMP_STRIDE
    ce = cs + CMP_BLOCK - 1
    bs = np.arange(n_blk) * SEL_BLOCK
    be = bs + SEL_BLOCK - 1
    return ((cs[:, None] <= be[None, :]) & (ce[:, None] >= bs[None, :])).astype(np.float32)


def _compress(kv, pos, w1, b1, w2, b2):
    B, T, G, D = kv.shape
    chunks = kv.reshape(B, T // CMP_STRIDE, CMP_STRIDE, G, D)
    blocks = jnp.concatenate([chunks[:, :-1], chunks[:, 1:]], axis=2) + pos[None, None, :, None, :]
    hid = jax.nn.gelu(jnp.einsum('bnlgd,ldf->bngf', blocks, w1) + b1)
    return jnp.einsum('bngf,fd->bngd', hid, w2) + b2


def _nsa(q, k_cmp, v_cmp, k_slc, v_slc, k_win, v_win, gates):
    B, T = q.shape[0], q.shape[1]
    n_cmp = k_cmp.shape[1]
    n_blk = T // SEL_BLOCK
    n_sel = min(N_SEL, n_blk)
    n_tok = n_sel * SEL_BLOCK
    scale = HEAD_DIM ** -0.5
    slopes = jnp.asarray(_alibi_slopes()).reshape(1, N_KV, HPG, 1, 1)
    cmp_end = jnp.arange(n_cmp) * CMP_STRIDE + CMP_BLOCK - 1
    blk_map = jnp.asarray(_cmp_to_sel_map(n_cmp, n_blk))
    kb = k_slc.reshape(B, n_blk, SEL_BLOCK, N_KV, HEAD_DIM).transpose(0, 3, 1, 2, 4)
    vb = v_slc.reshape(B, n_blk, SEL_BLOCK, N_KV, HEAD_DIM).transpose(0, 3, 1, 2, 4)
    k_pad = jnp.pad(k_win, ((0, 0), (WINDOW, 0), (0, 0), (0, 0)))
    v_pad = jnp.pad(v_win, ((0, 0), (WINDOW, 0), (0, 0), (0, 0)))
    b_ix = jnp.arange(B)[:, None, None, None]
    g_ix = jnp.arange(N_KV)[None, :, None, None]
    blk_ids = jnp.arange(n_blk)

    def block(i):
        qs = i * Q_BLOCK
        qb = lax.dynamic_slice_in_dim(q, qs, Q_BLOCK, axis=1)
        gb = lax.dynamic_slice_in_dim(gates, qs, Q_BLOCK, axis=1)
        t = qs + jnp.arange(Q_BLOCK)
        dist = (t[:, None] - cmp_end[None, :]).astype(jnp.float32)
        s = jnp.einsum('bqghd,bngd->bghqn', qb, k_cmp) * scale
        p_cmp = _masked_softmax(s - slopes * dist, dist >= 0)
        o_cmp = jnp.einsum('bghqn,bngd->bqghd', p_cmp.astype(v_cmp.dtype), v_cmp)
        imp = jnp.einsum('bghqn,nj->bgqj', p_cmp, blk_map)
        cur = (t // SEL_BLOCK)[:, None]
        forced = ((blk_ids == 0) | (blk_ids == cur) | (blk_ids == cur - 1)).astype(jnp.float32)
        valid = blk_ids[None, :] * SEL_BLOCK <= t[:, None]
        imp = jnp.where(valid, imp + FORCE_BONUS * forced, -1e30)
        _, idx = lax.top_k(imp, n_sel)
        k_sel = kb[b_ix, g_ix, idx].reshape(B, N_KV, Q_BLOCK, n_tok, HEAD_DIM)
        v_sel = vb[b_ix, g_ix, idx].reshape(B, N_KV, Q_BLOCK, n_tok, HEAD_DIM)
        s_pos = (idx[..., None] * SEL_BLOCK + jnp.arange(SEL_BLOCK)).reshape(B, N_KV, 1, Q_BLOCK, n_tok)
        dist = (t[None, None, None, :, None] - s_pos).astype(jnp.float32)
        s = jnp.einsum('bqghd,bgqmd->bghqm', qb, k_sel) * scale
        p = _masked_softmax(s - slopes * dist, dist >= 0)
        o_slc = jnp.einsum('bghqm,bgqmd->bqghd', p.astype(v_sel.dtype), v_sel)
        kw = lax.dynamic_slice_in_dim(k_pad, qs, WINDOW + Q_BLOCK, axis=1)
        vw = lax.dynamic_slice_in_dim(v_pad, qs, WINDOW + Q_BLOCK, axis=1)
        w_pos = qs - WINDOW + jnp.arange(WINDOW + Q_BLOCK)
        wd = t[:, None] - w_pos[None, :]
        wmask = (wd >= 0) & (wd < WINDOW) & (w_pos[None, :] >= 0)
        s = jnp.einsum('bqghd,bkgd->bghqk', qb, kw) * scale
        p = _masked_softmax(s - slopes * wd.astype(jnp.float32), wmask)
        o_win = jnp.einsum('bghqk,bkgd->bqghd', p.astype(vw.dtype), vw)
        o = gb[..., 0:1] * o_cmp + gb[..., 1:2] * o_slc + gb[..., 2:3] * o_win
        return o.reshape(B, Q_BLOCK, ATTN_DIM)

    out = lax.map(block, jnp.arange(T // Q_BLOCK))
    return out.transpose(1, 0, 2, 3).reshape(B, T, ATTN_DIM)


def _lin_combine(c1, c2):
    a1, b1 = c1
    a2, b2 = c2
    return a1 * a2, a2 * b1 + b2


def _rglru_branch(xb, gate, conv_w, conv_b, wa, ba, wi, bi, lam):
    B, T, W = xb.shape
    xc = lax.conv_general_dilated(xb, conv_w, window_strides=(1,), padding=[(CONV_W - 1, 0)],
                                  dimension_numbers=('NWC', 'WIO', 'NWC'),
                                  feature_group_count=LRU_WIDTH) + conv_b
    xr = xc.reshape(B, T, LRU_BLOCKS, LRU_BW)
    r = jax.nn.sigmoid(jnp.einsum('btnk,nkj->btnj', xr, wa).reshape(B, T, W) + ba)
    i = jax.nn.sigmoid(jnp.einsum('btnk,nkj->btnj', xr, wi).reshape(B, T, W) + bi)
    log_a = -LRU_C * r.astype(jnp.float32) * jax.nn.softplus(-lam.astype(jnp.float32))
    a = jnp.exp(log_a)
    b = jnp.sqrt(-jnp.expm1(2.0 * log_a)) * (i * xc).astype(jnp.float32)
    _, h = lax.associative_scan(_lin_combine, (a, b), axis=1)
    return h.astype(xb.dtype) * jax.nn.gelu(gate)


def _layer(x, norm1_g, w_in, q_norm_g, k_norm_g, cmp_pos_k, cmp_w1_k, cmp_b1_k, cmp_w2_k, cmp_b2_k,
           cmp_pos_v, cmp_w1_v, cmp_b1_v, cmp_w2_v, cmp_b2_v, conv_w, conv_b, lru_wa, lru_ba,
           lru_wi, lru_bi, lru_lambda, w_o_attn, w_o_lru, w_out, norm2_g, w_gate, w_up, w_down):
    B, T, _ = x.shape
    h = _rmsnorm(x, norm1_g)
    proj = h @ w_in
    o1 = ATTN_DIM
    o2 = o1 + 6 * KV_DIM
    o3 = o2 + 3 * N_HEADS
    o4 = o3 + LRU_WIDTH
    o5 = o4 + LRU_WIDTH
    q = _rmsnorm(proj[..., :o1].reshape(B, T, N_KV, HPG, HEAD_DIM), q_norm_g)
    kv = proj[..., o1:o2].reshape(B, T, 6, N_KV, HEAD_DIM)
    nsa_g = jax.nn.sigmoid(proj[..., o2:o3].reshape(B, T, N_KV, HPG, 3))
    lru_x = proj[..., o3:o4]
    lru_gate = proj[..., o4:o5]
    merge_g = jax.nn.sigmoid(proj[..., o5:].reshape(B, T, 2, D_MODEL))
    k_cmp = _rmsnorm(_compress(kv[:, :, 0], cmp_pos_k, cmp_w1_k, cmp_b1_k, cmp_w2_k, cmp_b2_k), k_norm_g[0])
    v_cmp = _compress(kv[:, :, 1], cmp_pos_v, cmp_w1_v, cmp_b1_v, cmp_w2_v, cmp_b2_v)
    k_slc = _rmsnorm(kv[:, :, 2], k_norm_g[1])
    k_win = _rmsnorm(kv[:, :, 4], k_norm_g[2])
    attn = _nsa(q, k_cmp, v_cmp, k_slc, kv[:, :, 3], k_win, kv[:, :, 5], nsa_g)
    lru = _rglru_branch(lru_x, lru_gate, conv_w, conv_b, lru_wa, lru_ba, lru_wi, lru_bi, lru_lambda)
    merged = merge_g[:, :, 0] * (attn @ w_o_attn) + merge_g[:, :, 1] * (lru @ w_o_lru)
    x = x + merged @ w_out
    h2 = _rmsnorm(x, norm2_g)
    return x + (jax.nn.silu(h2 @ w_gate) * (h2 @ w_up)) @ w_down


def setup_inputs(seed: int = 0) -> dict:
    key = jax.random.key(seed)
    ks = jax.random.split(key, 32)
    L = DEPTH
    nrm = lambda k, shape, fan: jax.random.normal(k, shape, jnp.float32) * (fan ** -0.5)
    small = lambda k, shape, s: jax.random.normal(k, shape, jnp.float32) * s
    u = jax.random.uniform(ks[31], (L, LRU_WIDTH), jnp.float32, minval=0.9, maxval=0.999)
    a0 = u ** (1.0 / LRU_C)
    return {
        "x": jax.random.normal(ks[0], (BATCH, SEQ, D_MODEL), jnp.float32),
        "norm1_g": 1.0 + small(ks[1], (L, D_MODEL), 0.02),
        "w_in": nrm(ks[2], (L, D_MODEL, IN_DIM), D_MODEL),
        "q_norm_g": 1.0 + small(ks[3], (L, HEAD_DIM), 0.02),
        "k_norm_g": 1.0 + small(ks[4], (L, 3, HEAD_DIM), 0.02),
        "cmp_pos_k": small(ks[5], (L, CMP_BLOCK, HEAD_DIM), 0.1),
        "cmp_w1_k": nrm(ks[6], (L, CMP_BLOCK, HEAD_DIM, CMP_HIDDEN), CMP_BLOCK * HEAD_DIM),
        "cmp_b1_k": small(ks[7], (L, CMP_HIDDEN), 0.01),
        "cmp_w2_k": nrm(ks[8], (L, CMP_HIDDEN, HEAD_DIM), CMP_HIDDEN),
        "cmp_b2_k": small(ks[9], (L, HEAD_DIM), 0.01),
        "cmp_pos_v": small(ks[10], (L, CMP_BLOCK, HEAD_DIM), 0.1),
        "cmp_w1_v": nrm(ks[11], (L, CMP_BLOCK, HEAD_DIM, CMP_HIDDEN), CMP_BLOCK * HEAD_DIM),
        "cmp_b1_v": small(ks[12], (L, CMP_HIDDEN), 0.01),
        "cmp_w2_v": nrm(ks[13], (L, CMP_HIDDEN, HEAD_DIM), CMP_HIDDEN),
        "cmp_b2_v": small(ks[14], (L, HEAD_DIM), 0.01),
        "conv_w": nrm(ks[15], (L, CONV_W, 1, LRU_WIDTH), CONV_W),
        "conv_b": small(ks[16], (L, LRU_WIDTH), 0.01),
        "lru_wa": nrm(ks[17], (L, LRU_BLOCKS, LRU_BW, LRU_BW), LRU_BW),
        "lru_ba": small(ks[18], (L, LRU_WIDTH), 0.01),
        "lru_wi": nrm(ks[19], (L, LRU_BLOCKS, LRU_BW, LRU_BW), LRU_BW),
        "lru_bi": small(ks[20], (L, LRU_WIDTH), 0.01),
        "lru_lambda": jnp.log(a0) - jnp.log1p(-a0),
        "w_o_attn": nrm(ks[21], (L, ATTN_DIM, D_MODEL), ATTN_DIM),
        "w_o_lru": nrm(ks[22], (L, LRU_WIDTH, D_MODEL), LRU_WIDTH),
        "w_out": nrm(ks[23], (L, D_MODEL, D_MODEL), D_MODEL),
        "norm2_g": 1.0 + small(ks[24], (L, D_MODEL), 0.02),
        "w_gate": nrm(ks[25], (L, D_MODEL, D_FF), D_MODEL),
        "w_up": nrm(ks[26], (L, D_MODEL, D_FF), D_MODEL),
        "w_down": nrm(ks[27], (L, D_FF, D_MODEL), D_FF),
    }


def reference(x, norm1_g, w_in, q_norm_g, k_norm_g, cmp_pos_k, cmp_w1_k, cmp_b1_k, cmp_w2_k, cmp_b2_k,
              cmp_pos_v, cmp_w1_v, cmp_b1_v, cmp_w2_v, cmp_b2_v, conv_w, conv_b, lru_wa, lru_ba,
              lru_wi, lru_bi, lru_lambda, w_o_attn, w_o_lru, w_out, norm2_g, w_gate, w_up, w_down):
    for l in range(DEPTH):
        x = _layer(x, norm1_g[l], w_in[l], q_norm_g[l], k_norm_g[l], cmp_pos_k[l], cmp_w1_k[l],
                   cmp_b1_k[l], cmp_w2_k[l], cmp_b2_k[l], cmp_pos_v[l], cmp_w1_v[l], cmp_b1_v[l],
                   cmp_w2_v[l], cmp_b2_v[l], conv_w[l], conv_b[l], lru_wa[l], lru_ba[l], lru_wi[l],
                   lru_bi[l], lru_lambda[l], w_o_attn[l], w_o_lru[l], w_out[l], norm2_g[l],
                   w_gate[l], w_up[l], w_down[l])
    return x
```

```cpp
#include <hip/hip_runtime.h>
#include <cstdio>
#include <cstdint>
#ifndef N_LAUNCHES
#define N_LAUNCHES 8
#endif
#ifndef USE_NAIVE
#define USE_NAIVE 1
#endif
namespace pg8 {
#define PG8_LAS __attribute__((address_space(3)))
typedef unsigned short bf16_t;
typedef short bf16x8 __attribute__((ext_vector_type(8)));
typedef float f32x4 __attribute__((ext_vector_type(4)));
typedef float f32x2 __attribute__((ext_vector_type(2)));
typedef unsigned u32x4 __attribute__((ext_vector_type(4)));
typedef unsigned u32x2 __attribute__((ext_vector_type(2)));
constexpr int BM = 256, BK = 64, HALF = 128, HTB = HALF * BK * 2  , STAGE_BYTES = 8 * HTB, NXCD = 8, WGM = 8;

__host__ __device__ __forceinline__ int lds_byte(int r, int c) { const int st = (r >> 4) * 2 + (c >> 5), rr = r & 15, cc = c & 31, ob = rr * 64 + cc * 2; return st * 1024 + (ob ^ (((ob >> 9) & 1) << 5)); }
__host__ __device__ __forceinline__ void stage_rc(int b, int& R, int& C) { const int st = b / 1024, sb = b % 1024, swz = sb ^ (((sb >> 9) & 1) << 5); R = (st >> 1) * 16 + swz / 64; C = (st & 1) * 32 + (swz % 64) / 2; }
__host__ __device__ __forceinline__ int perm32(int rho) { const int n = rho >> 4, i = rho & 15; return 8 * (i >> 2) + 4 * n + (i & 3); }

struct Unit { int pm, pn, kind; };
struct Gemm { int rowA, kstepA, rowB, kstepB, nt; };

struct TileOrder {
    int nM, nN, nwg, G, c;
    __device__ void init(int M, int N, int G_, int c_) { nM = M / BM; nN = N / BM; nwg = nM * nN; G = G_; c = c_; }
    __device__ bool tile(int i, int& pm, int& pn) const {
        const long L = (long)i * G + c; if (L >= nwg) return false;
        int wgid = (int)L; { const int q = nwg / NXCD, r = nwg % NXCD, xcd = wgid % NXCD, off = wgid / NXCD; wgid = (xcd < r ? xcd * (q + 1) : r * (q + 1) + (xcd - r) * q) + off; }
        const int nig = WGM * nN, gid = wgid / nig, fm = gid * WGM, gsz = (nM - fm) < WGM ? (nM - fm) : WGM;
        pm = fm + ((wgid % nig) % gsz); pn = (wgid % nig) / gsz; return true;
    }
};

__device__ __forceinline__ unsigned cvt_pk_bf16(float lo, float hi) { unsigned r; asm volatile("v_cvt_pk_bf16_f32 %0, %1, %2" : "=v"(r) : "v"(lo), "v"(hi)); return r; }

template <class Epi, class Sched>
__device__ __forceinline__ void gemm_phase(PG8_LAS unsigned char* lds, const Gemm g, const Sched& S, const Epi& E) {
    const int tid = threadIdx.x, wid = __builtin_amdgcn_readfirstlane(tid >> 6), lane = tid & 63, wr = wid >> 2, wc = wid & 3, fr = lane & 15, fq = lane >> 4;
    const int nt = g.nt;
    unsigned voffA[2], voffB[2];
#pragma unroll
    for (int i = 0; i < 2; ++i) { int R, C; stage_rc(tid * 16 + i * 8192, R, C); const int Rb = Epi::PERM ? ((R & ~31) + perm32(R & 31)) : R;
        voffA[i] = (unsigned)(R * g.rowA + C * 2); voffB[i] = (unsigned)(Rb * g.rowB + C * 2); }
    const size_t kstepA = (size_t)g.kstepA, kstepB = (size_t)g.kstepB;
    const size_t hstepA = (size_t)HALF * g.rowA, hstepB = (size_t)HALF * g.rowB;
    const unsigned ldsw = (unsigned)wid * 1024u;
    const int aoff = lds_byte(wr * 64 + fr, fq * 8), boff = lds_byte(wc * 32 + fr, fq * 8);
#define PG8_SA(b, h) (((b) * 2 + (h)) * HTB)
#define PG8_SB(b, h) ((4 + (b) * 2 + (h)) * HTB)
#define PG8_STAGE(bufoff, gbase, voff) do { _Pragma("unroll") for (int _i = 0; _i < 2; ++_i) \
        __builtin_amdgcn_global_load_lds((const unsigned*)((const char*)(gbase) + (voff)[_i]), (PG8_LAS unsigned*)(lds + (bufoff) + ldsw + _i * 8192), 16, 0, 0); } while (0)
#define PG8_LDA(dst, b, h) do { _Pragma("unroll") for (int m = 0; m < 4; ++m) _Pragma("unroll") for (int k = 0; k < 2; ++k) dst[m][k] = *(const PG8_LAS bf16x8*)(lds + PG8_SA(b, h) + aoff + m * 2048 + k * 1024); } while (0)
#define PG8_LDB(dst, b, h) do { _Pragma("unroll") for (int n = 0; n < 2; ++n) _Pragma("unroll") for (int k = 0; k < 2; ++k) dst[n][k] = *(const PG8_LAS bf16x8*)(lds + PG8_SB(b, h) + boff + n * 2048 + k * 1024); } while (0)
#define PG8_MMA(ai, bj, At, Bt) do { __builtin_amdgcn_s_setprio(1); _Pragma("unroll") for (int m = 0; m < 4; ++m) _Pragma("unroll") for (int n = 0; n < 2; ++n) _Pragma("unroll") for (int k = 0; k < 2; ++k) \
        acc[ai][bj][m][n] = __builtin_amdgcn_mfma_f32_16x16x32_bf16(Bt[n][k], At[m][k], acc[ai][bj][m][n], 0, 0, 0); __builtin_amdgcn_s_setprio(0); } while (0)
#define PG8_WAIT_V(n) asm volatile("s_waitcnt vmcnt(" #n ")" ::: "memory")
#define PG8_WAIT_L(n) asm volatile("s_waitcnt lgkmcnt(" #n ")" ::: "memory")
#define PG8_BAR __builtin_amdgcn_s_barrier()
#define PG8_SCHED __builtin_amdgcn_sched_barrier(0)
    Unit cur, nxt; int ui = 0;
    if (!S.next(0, cur)) return;
    f32x4 acc[2][2][4][2];
#pragma unroll
    for (int a = 0; a < 2; ++a)
#pragma unroll
        for (int b = 0; b < 2; ++b)
#pragma unroll
            for (int m = 0; m < 4; ++m)
#pragma unroll
                for (int n = 0; n < 2; ++n) acc[a][b][m][n] = (f32x4){0.f, 0.f, 0.f, 0.f};
    bf16x8 At[4][2], B0[2][2], B1[2][2];
    const char* cA = S.abase(cur); const char* cB = S.bbase(cur);
    PG8_STAGE(PG8_SB(0, 0), cB, voffB); PG8_STAGE(PG8_SB(0, 1), cB + hstepB, voffB); PG8_STAGE(PG8_SA(0, 0), cA, voffA); PG8_STAGE(PG8_SA(0, 1), cA + hstepA, voffA);
    if (wr == 1) PG8_BAR;
    PG8_WAIT_V(2); PG8_BAR;
    PG8_STAGE(PG8_SB(1, 0), cB + kstepB, voffB); PG8_STAGE(PG8_SA(1, 0), cA + kstepA, voffA); PG8_STAGE(PG8_SB(1, 1), cB + hstepB + kstepB, voffB);
    PG8_WAIT_V(6); PG8_BAR;
    for (;;) {
        const bool has_next = S.next(ui + 1, nxt);
        const char* nA = has_next ? S.abase(nxt) : cA; const char* nB = has_next ? S.bbase(nxt) : cB;
        for (int t = 0; t < nt; t += 2) {
            const bool last = (t == nt - 2);
            const char* a1 = cA + (size_t)(t + 1) * kstepA;
            const char* a2 = last ? nA : cA + (size_t)(t + 2) * kstepA; const char* b2 = last ? nB : cB + (size_t)(t + 2) * kstepB;
            const char* a3 = a2 + kstepA; const char* b3 = b2 + kstepB;
            PG8_LDB(B0, 0, 0); PG8_LDB(B1, 0, 1); PG8_SCHED; PG8_LDA(At, 0, 0); PG8_STAGE(PG8_SA(1, 1), a1 + hstepA, voffA);
            PG8_WAIT_V(8); PG8_WAIT_L(0); PG8_BAR; PG8_MMA(0, 0, At, B0); PG8_MMA(0, 1, At, B1); PG8_BAR; PG8_SCHED;
            PG8_LDA(At, 0, 1); PG8_STAGE(PG8_SB(0, 0), b2, voffB); PG8_STAGE(PG8_SB(0, 1), b2 + hstepB, voffB); PG8_STAGE(PG8_SA(0, 0), a2, voffA);
            PG8_WAIT_V(8); PG8_WAIT_L(0); PG8_BAR; PG8_MMA(1, 0, At, B0); PG8_MMA(1, 1, At, B1); PG8_BAR; PG8_SCHED;
            PG8_LDB(B0, 1, 0); PG8_LDB(B1, 1, 1); PG8_SCHED; PG8_LDA(At, 1, 0); PG8_STAGE(PG8_SA(0, 1), a2 + hstepA, voffA);
            PG8_WAIT_V(8); PG8_WAIT_L(0); PG8_BAR; PG8_MMA(0, 0, At, B0); PG8_MMA(0, 1, At, B1); PG8_BAR; PG8_SCHED;
            PG8_LDA(At, 1, 1); PG8_STAGE(PG8_SB(1, 0), b3, voffB); PG8_STAGE(PG8_SB(1, 1), b3 + hstepB, voffB); PG8_STAGE(PG8_SA(1, 0), a3, voffA);
            PG8_WAIT_V(8); PG8_WAIT_L(0); PG8_BAR; PG8_MMA(1, 0, At, B0); PG8_MMA(1, 1, At, B1); PG8_BAR; PG8_SCHED;
        }
        if (wr == 0) PG8_BAR;
        E(acc, cur, wr, wc, fr, fq);
        if (!has_next) break;
#pragma unroll
        for (int a = 0; a < 2; ++a)
#pragma unroll
            for (int b = 0; b < 2; ++b)
#pragma unroll
                for (int m = 0; m < 4; ++m)
#pragma unroll
                    for (int n = 0; n < 2; ++n) acc[a][b][m][n] = (f32x4){0.f, 0.f, 0.f, 0.f};
        cur = nxt; cA = nA; cB = nB; ++ui;
        if (wr == 1) PG8_BAR;
    }
    PG8_WAIT_V(0);
    PG8_BAR;
#undef PG8_SA
#undef PG8_SB
#undef PG8_STAGE
#undef PG8_LDA
#undef PG8_LDB
#undef PG8_MMA
#undef PG8_WAIT_V
#undef PG8_WAIT_L
#undef PG8_BAR
#undef PG8_SCHED
}
}
constexpr int BATCH = 4, SEQ = 4096, DM = 1024, M_ROWS = BATCH * SEQ;
constexpr int NH = 16, HD = 64, NKV = 4, HPG = 4, KVW = 1536;
constexpr int IN_DIM = 6704, NPROJ = 6912;
constexpr int DFF = 2816, NGU = 2 * DFF;
constexpr int NCMP = 255, NCP = 256;
constexpr float EPS = 1e-6f;
constexpr float LOG2E = 1.4426950408889634f;

__device__ __forceinline__ float fast_sigmoid(float x) { return __builtin_amdgcn_rcpf(1.f + __builtin_amdgcn_exp2f(-LOG2E * x)); }
__device__ __forceinline__ float gelu_tanh(float x) { return x * fast_sigmoid(x * (1.5957691216f + 0.0713548163f * x * x)); }

namespace pg8 {
struct SchedSimple {
    TileOrder T; const char* A; const char* B; size_t tA, tB;
    __device__ __forceinline__ bool next(int i, Unit& u) const { u.kind = 0; return T.tile(i, u.pm, u.pn); }
    __device__ __forceinline__ const char* abase(const Unit& u) const { return A + (size_t)u.pm * tA; }
    __device__ __forceinline__ const char* bbase(const Unit& u) const { return B + (size_t)u.pn * tB; }
};
struct SchedMerge {
    TileOrder T; const char* A0; const char* A1; const char* B0; const char* B1; size_t tA, tB;
    __device__ __forceinline__ bool next(int i, Unit& u) const { u.kind = i & 1; return T.tile(i >> 1, u.pm, u.pn); }
    __device__ __forceinline__ const char* abase(const Unit& u) const { return (u.kind ? A1 : A0) + (size_t)u.pm * tA; }
    __device__ __forceinline__ const char* bbase(const Unit& u) const { return (u.kind ? B1 : B0) + (size_t)u.pn * tB; }
};

typedef f32x4 Acc[2][2][4][2];
#define EPI_ROW(ai, m) (u.pm * BM + (ai) * HALF + wr * 64 + (m) * 16 + fr)
#define EPI_CT(bj) ((bj) * HALF + wc * 32 + 8 * fq)

__device__ __forceinline__ u32x4 pack8(f32x4 a, f32x4 b) { u32x4 w; w.x = cvt_pk_bf16(a[0], a[1]); w.y = cvt_pk_bf16(a[2], a[3]); w.z = cvt_pk_bf16(b[0], b[1]); w.w = cvt_pk_bf16(b[2], b[3]); return w; }

struct EpiProj {
    static constexpr bool PERM = true;
    const float* rstd; bf16_t *QB, *KVB, *NG, *LX, *LGG, *MG;
    __device__ __forceinline__ void operator()(const Acc& acc, const Unit& u, int wr, int wc, int fr, int fq) const {
        const int pn = u.pn; bf16_t* dst; int ld, c0, act = 0, lim = 256;
        if (pn < 4) { dst = QB; ld = DM; c0 = pn * 256; }
        else if (pn < 10) { dst = KVB; ld = KVW; c0 = (pn - 4) * 256; }
        else if (pn == 10) { dst = NG; ld = 48; c0 = 0; act = 1; lim = 48; }
        else if (pn < 15) { dst = LX; ld = DM; c0 = (pn - 11) * 256; }
        else if (pn < 19) { dst = LGG; ld = DM; c0 = (pn - 15) * 256; act = 2; }
        else { dst = MG; ld = 2 * DM; c0 = (pn - 19) * 256; act = 1; }
#pragma unroll
        for (int ai = 0; ai < 2; ++ai)
#pragma unroll
            for (int m = 0; m < 4; ++m) {
                const int row = EPI_ROW(ai, m); const float rs = rstd[row];
#pragma unroll
                for (int bj = 0; bj < 2; ++bj) {
                    const int ct = EPI_CT(bj);
                    f32x4 v0 = acc[ai][bj][m][0] * rs, v1 = acc[ai][bj][m][1] * rs;
                    if (act == 1) {
#pragma unroll
                        for (int e = 0; e < 4; ++e) { v0[e] = fast_sigmoid(v0[e]); v1[e] = fast_sigmoid(v1[e]); }
                    } else if (act == 2) {
#pragma unroll
                        for (int e = 0; e < 4; ++e) { v0[e] = gelu_tanh(v0[e]); v1[e] = gelu_tanh(v1[e]); }
                    }
                    if (ct + 8 <= lim) *(u32x4*)(dst + (size_t)row * ld + c0 + ct) = pack8(v0, v1);
                }
            }
    }
};

struct EpiMerge {
    static constexpr bool PERM = true;
    const bf16_t* MG; f32x4* scr; bf16_t* MRG;
    __device__ __forceinline__ void operator()(const Acc& acc, const Unit& u, int wr, int wc, int fr, int fq) const {
        f32x4* my = scr + (size_t)blockIdx.x * (32 * 512) + threadIdx.x; const bf16_t* MGp = MG; bf16_t* MRGp = MRG;
        asm volatile("" : "+v"(my), "+s"(MGp), "+s"(MRGp));
#pragma unroll
        for (int ai = 0; ai < 2; ++ai)
#pragma unroll
            for (int m = 0; m < 4; ++m) {
                const int row = EPI_ROW(ai, m);
#pragma unroll
                for (int bj = 0; bj < 2; ++bj) {
                    const int col = u.pn * BM + EPI_CT(bj);
                    const u32x4 gw = *(const u32x4*)(MGp + (size_t)row * (2 * DM) + u.kind * DM + col);
                    f32x4 g0, g1;
                    g0[0] = __uint_as_float(gw.x << 16); g0[1] = __uint_as_float(gw.x & 0xffff0000u); g0[2] = __uint_as_float(gw.y << 16); g0[3] = __uint_as_float(gw.y & 0xffff0000u);
                    g1[0] = __uint_as_float(gw.z << 16); g1[1] = __uint_as_float(gw.z & 0xffff0000u); g1[2] = __uint_as_float(gw.w << 16); g1[3] = __uint_as_float(gw.w & 0xffff0000u);
                    const int ri = ((ai * 2 + bj) * 4 + m) * 2;
                    f32x4 v0 = acc[ai][bj][m][0] * g0, v1 = acc[ai][bj][m][1] * g1;
                    if (u.kind == 0) { my[(size_t)ri * 512] = v0; my[(size_t)(ri + 1) * 512] = v1; }
                    else { v0 += my[(size_t)ri * 512]; v1 += my[(size_t)(ri + 1) * 512]; *(u32x4*)(MRGp + (size_t)row * DM + col) = pack8(v0, v1); }
                }
                asm volatile("" ::: "memory");
            }
    }
};

struct EpiWout {
    static constexpr bool PERM = true;
    const float* x; float* out; bf16_t* X1B; float* ssq;
    __device__ __forceinline__ void operator()(const Acc& acc, const Unit& u, int wr, int wc, int fr, int fq) const {
#pragma unroll
        for (int ai = 0; ai < 2; ++ai)
#pragma unroll
            for (int m = 0; m < 4; ++m) {
                const int row = EPI_ROW(ai, m); float s = 0.f;
#pragma unroll
                for (int bj = 0; bj < 2; ++bj) {
                    const int col = u.pn * BM + EPI_CT(bj); const size_t off = (size_t)row * DM + col;
                    const f32x4 v0 = *(const f32x4*)(x + off) + acc[ai][bj][m][0], v1 = *(const f32x4*)(x + off + 4) + acc[ai][bj][m][1];
                    *(f32x4*)(out + off) = v0; *(f32x4*)(out + off + 4) = v1;
                    *(u32x4*)(X1B + off) = pack8(v0, v1);
                    s += (v0[0] * v0[0] + v0[1] * v0[1]) + (v0[2] * v0[2] + v0[3] * v0[3]) + (v1[0] * v1[0] + v1[1] * v1[1]) + (v1[2] * v1[2] + v1[3] * v1[3]);
                }
                s += __shfl_xor(s, 16); s += __shfl_xor(s, 32);
                if (fq == 0) ssq[(size_t)row * 16 + u.pn * 4 + wc] = s;
            }
    }
};

struct EpiGU {
    static constexpr bool PERM = true;
    const float* ssq; bf16_t* FF;
    __device__ __forceinline__ void operator()(const Acc& acc, const Unit& u, int wr, int wc, int fr, int fq) const {
#pragma unroll
        for (int ai = 0; ai < 2; ++ai)
#pragma unroll
            for (int m = 0; m < 4; ++m) {
                const int row = EPI_ROW(ai, m);
                const f32x4* sp = (const f32x4*)(ssq + (size_t)row * 16);
                const f32x4 s0 = sp[0], s1 = sp[1], s2 = sp[2], s3 = sp[3];
                const float tot = ((s0[0] + s0[1]) + (s0[2] + s0[3])) + ((s1[0] + s1[1]) + (s1[2] + s1[3])) + ((s2[0] + s2[1]) + (s2[2] + s2[3])) + ((s3[0] + s3[1]) + (s3[2] + s3[3]));
                const float rs = __builtin_amdgcn_rsqf(tot * (1.f / DM) + EPS);
                f32x4 o[2];
#pragma unroll
                for (int n = 0; n < 2; ++n)
#pragma unroll
                    for (int e = 0; e < 4; ++e) { const float g = acc[ai][0][m][n][e] * rs, up = acc[ai][1][m][n][e] * rs; o[n][e] = g * fast_sigmoid(g) * up; }
                *(u32x4*)(FF + (size_t)row * DFF + u.pn * HALF + wc * 32 + 8 * fq) = pack8(o[0], o[1]);
            }
    }
};

struct EpiDown {
    static constexpr bool PERM = true;
    float* out;
    __device__ __forceinline__ void operator()(const Acc& acc, const Unit& u, int wr, int wc, int fr, int fq) const {
#pragma unroll
        for (int ai = 0; ai < 2; ++ai)
#pragma unroll
            for (int m = 0; m < 4; ++m) {
                const int row = EPI_ROW(ai, m);
#pragma unroll
                for (int bj = 0; bj < 2; ++bj) {
                    const size_t off = (size_t)row * DM + u.pn * BM + EPI_CT(bj);
                    const f32x4 v0 = *(const f32x4*)(out + off) + acc[ai][bj][m][0], v1 = *(const f32x4*)(out + off + 4) + acc[ai][bj][m][1];
                    *(f32x4*)(out + off) = v0; *(f32x4*)(out + off + 4) = v1;
                }
            }
    }
};
#undef EPI_ROW
#undef EPI_CT
}
constexpr size_t MiB = 1u << 20;
constexpr size_t WS_CTL = 0, CTL_ZERO_BYTES = 1 * MiB;
constexpr size_t WS_NG = 1 * MiB;
constexpr size_t WS_RSTD1 = 3 * MiB;
constexpr size_t WS_SSQ = 4 * MiB;
constexpr size_t WS_KC = 5 * MiB;
constexpr size_t WS_VC = 5 * MiB + 512 * 1024;
constexpr size_t WS_LSUM = 6 * MiB;
constexpr size_t WS_CW2 = 7 * MiB;
constexpr size_t WS_LW = 7 * MiB + 256 * 1024;
constexpr size_t WS_HID = 8 * MiB;
constexpr size_t WS_CW1 = 12 * MiB;
constexpr size_t WS_WOA = 14 * MiB, WS_WOL = 16 * MiB, WS_WOUT = 18 * MiB;
constexpr size_t WS_WDN = 20 * MiB;
constexpr size_t WS_WGU = 26 * MiB;
constexpr size_t WS_WIN = 37 * MiB;
constexpr size_t WS_XB = 51 * MiB;
constexpr size_t WS_QB = 83 * MiB;
constexpr size_t WS_KVB = 115 * MiB;
constexpr size_t WS_LX = 163 * MiB;
constexpr size_t WS_LGG = 195 * MiB;
constexpr size_t WS_MRGF = 83 * MiB;
constexpr size_t WS_FF = 83 * MiB;
constexpr size_t WS_END = 227 * MiB;

constexpr int CW_BAR = 4096;

constexpr int RING_BYTES = 131072;
constexpr int LDSCTL_OFF = RING_BYTES, MISC_OFF = LDSCTL_OFF + 320;
constexpr int LDS_BYTES = 147456;
constexpr int NWAVES = 8;

#define GAS __attribute__((address_space(1)))
#define LAS __attribute__((address_space(3)))
typedef unsigned short bf16;
typedef unsigned v4u __attribute__((ext_vector_type(4)));
typedef unsigned v2u __attribute__((ext_vector_type(2)));
typedef float f32x4 __attribute__((ext_vector_type(4)));
typedef short bf16x8 __attribute__((ext_vector_type(8)));
typedef GAS unsigned gu32;
#define RLX_AGENT __ATOMIC_RELAXED, __HIP_MEMORY_SCOPE_AGENT
#define LDS_WAIT() asm volatile("s_waitcnt lgkmcnt(0)" ::: "memory")
#define VM_WAIT() asm volatile("s_waitcnt vmcnt(0)" ::: "memory")
__device__ __forceinline__ unsigned f2bf(float f) { unsigned u = __builtin_bit_cast(unsigned, f); return (u + 0x7fffu + ((u >> 16) & 1u)) >> 16; }
__device__ __forceinline__ unsigned pk2(float lo, float hi) { return f2bf(lo) | (f2bf(hi) << 16); }
__device__ __forceinline__ float bf2f(unsigned short h) { return __uint_as_float((unsigned)h << 16); }
__device__ __forceinline__ float bflo(unsigned w) { return __uint_as_float(w << 16); }
__device__ __forceinline__ float bfhi(unsigned w) { return __uint_as_float(w & 0xffff0000u); }

#define XB_TMO      128
#define XB_XCNT(j)  (256  + 64 * (j))
#define XB_XSUB(j)  (1280 + 64 * (j))
#define XB_XGEN(j)  (2304 + 64 * (j))
#define XB_TOP      3328
#define XB_TOPGEN   3392
#define XCD_BAR_WORDS 3456
#define XB_SPIN_CAP (1u << 20)
__device__ __forceinline__ unsigned xb_ld(unsigned* p)              { return __hip_atomic_load(p, __ATOMIC_RELAXED, __HIP_MEMORY_SCOPE_AGENT); }
__device__ __forceinline__ unsigned xb_add(unsigned* p, unsigned v) { return __hip_atomic_fetch_add(p, v, __ATOMIC_RELAXED, __HIP_MEMORY_SCOPE_AGENT); }
__device__ __forceinline__ unsigned xb_xcc_id() { return (unsigned)__builtin_amdgcn_s_getreg((3 << 11) | 20) & 0xFu; }
#define XB_SPIN(cond, bar) do { unsigned _sp = 0; while (cond) { __builtin_amdgcn_s_sleep(1); \
    if ((++_sp & 255u) == 0u) { if (xb_ld(&(bar)[XB_TMO])) break; if (_sp > XB_SPIN_CAP) { atomicAdd(&(bar)[XB_TMO], 1u); break; } } } } while (0)
struct XcdBarrier { unsigned* bar; unsigned x; volatile LAS unsigned* st; };
__device__ __forceinline__ XcdBarrier xcd_barrier_post(unsigned* bar, volatile LAS unsigned* st) {
    XcdBarrier b; b.bar = bar; b.x = xb_xcc_id(); b.st = st;
    if (threadIdx.x == 0) (void)xb_add(&bar[XB_XCNT(b.x)], 1u);
    return b;
}
__device__ __forceinline__ void xcd_barrier_complete(unsigned* bar, unsigned x, unsigned& nloc, unsigned& nx) {
    const unsigned G = gridDim.x * gridDim.y * gridDim.z;
    unsigned sum, cnt, mine, sp = 0u;
    for (;;) {
        sum = 0u; cnt = 0u; mine = 0u;
#pragma unroll
        for (unsigned j = 0; j < 16; ++j) { const unsigned c = xb_ld(&bar[XB_XCNT(j)]); sum += c; cnt += (c > 0u) ? 1u : 0u; mine = (j == x) ? c : mine; }
        if (sum == G) break;
        __builtin_amdgcn_s_sleep(1);
        if ((++sp & 255u) == 0u) { if (xb_ld(&bar[XB_TMO])) break; if (sp > XB_SPIN_CAP) { atomicAdd(&bar[XB_TMO], 1u); break; } }
    }
    nloc = mine > 0u ? mine : 1u; nx = cnt > 0u ? cnt : 1u;
}
__device__ __forceinline__ void xcd_barrier(const XcdBarrier& b) {
    asm volatile("s_waitcnt vmcnt(0)" ::: "memory");
    __syncthreads();
    if (threadIdx.x == 0) {
        unsigned* bar = b.bar;
        __builtin_amdgcn_s_waitcnt(0);
        unsigned nloc = b.st[0], nx = b.st[1];
        if (nloc == 0u) { xcd_barrier_complete(bar, b.x, nloc, nx); b.st[0] = nloc; b.st[1] = nx; }
        const unsigned old = xb_add(&bar[XB_XSUB(b.x)], 1u);
        const unsigned gen = old / nloc;
        if (old + 1u == (gen + 1u) * nloc) {
            __builtin_amdgcn_fence(__ATOMIC_RELEASE, "agent");
            asm volatile("s_waitcnt vmcnt(0)" ::: "memory");
            const unsigned og = xb_add(&bar[XB_TOP], 1u);
            const unsigned tg = og / nx;
            if (og + 1u == (tg + 1u) * nx) xb_add(&bar[XB_TOPGEN], 1u);
            else XB_SPIN(xb_ld(&bar[XB_TOPGEN]) == tg, bar);
            __builtin_amdgcn_fence(__ATOMIC_ACQUIRE, "agent");
            xb_add(&bar[XB_XGEN(b.x)], 1u);
            asm volatile("s_waitcnt vmcnt(0)" ::: "memory");
        } else {
            XB_SPIN(xb_ld(&bar[XB_XGEN(b.x)]) == gen, bar);
            __builtin_amdgcn_fence(__ATOMIC_ACQUIRE, "agent");
            asm volatile("s_waitcnt vmcnt(0)" ::: "memory");
        }
    }
    __syncthreads();
}

struct Frame {
    LAS unsigned char* lds;
    volatile LAS unsigned* MISC;
    gu32* ctl;
    int tid, lane, wave, vcu, G;
    float* out; unsigned char* ws;
};
struct Args { const float* in[29]; float* out; unsigned char* ws; int ph_lo, ph_hi; };
__device__ __forceinline__ float wave_sum(float v) {
#pragma unroll
    for (int o = 1; o < 64; o <<= 1) v += __shfl_xor(v, o);
    return v;
}

__device__ __forceinline__ void p0_transpose_item(const float* W, int ldw, int k0, int nsrc, int nvalid, bf16* WT, int ldt, int ndst, const float* gk, LAS float* scr, int lane) {
#pragma unroll 8
    for (int i = 0; i < 32; ++i) { const int kk = 2 * i + (lane >> 5), c = lane & 31;
        float v = 0.f; if (c < nvalid) { v = W[(size_t)(k0 + kk) * ldw + nsrc + c]; if (gk) v *= gk[k0 + kk]; }
        scr[kk * 33 + c] = v; }
    LDS_WAIT(); asm volatile("" ::: "memory");
    const int c = lane & 7;
#pragma unroll
    for (int j = 0; j < 4; ++j) { const int n = (lane >> 3) + 8 * j; const LAS float* s = scr + (8 * c) * 33 + n;
        v4u o; o.x = pk2(s[0 * 33], s[1 * 33]); o.y = pk2(s[2 * 33], s[3 * 33]); o.z = pk2(s[4 * 33], s[5 * 33]); o.w = pk2(s[6 * 33], s[7 * 33]);
        *(GAS v4u*)(WT + (size_t)(ndst + n) * ldt + k0 + 8 * c) = o; }
    LDS_WAIT(); asm volatile("" ::: "memory");
}
__device__ __forceinline__ void p0_prologue(Frame& F, const Args& A) {
    LAS float* scr = (LAS float*)(F.lds + F.wave * 16384);
    const int gw = F.vcu * NWAVES + F.wave, NGW = F.G * NWAVES;
    unsigned char* ws = F.ws;
    constexpr int I_IN = (NPROJ / 32) * 16, I_SQ = 32 * 16, I_GU = (DFF / 32) * 16, I_DN = 32 * (DFF / 64), I_C1 = 8 * 32, I_C2 = 2 * 4, I_LW = 16 * 2;
    constexpr int NITEMS = I_IN + 3 * I_SQ + 2 * I_GU + I_DN + 2 * I_C1 + 2 * I_C2 + 2 * I_LW;
    for (int it = gw; it < NITEMS; it += NGW) {
        int r = it;
        if (r < I_IN) { const int nb = r % (NPROJ / 32), kb = r / (NPROJ / 32); int nsrc, nv = 32;
            if (nb < 80) nsrc = 32 * nb; else if (nb < 88) { nsrc = 2560 + 32 * (nb - 80); nv = 48 - 32 * (nb - 80); nv = nv < 0 ? 0 : (nv > 32 ? 32 : nv); } else nsrc = 2608 + 32 * (nb - 88);
            p0_transpose_item(A.in[2], IN_DIM, 64 * kb, nsrc, nv, (bf16*)(ws + WS_WIN), DM, 32 * nb, A.in[1], scr, F.lane); continue; }
        r -= I_IN;
        if (r < 3 * I_SQ) { const int w = r / I_SQ, q = r % I_SQ, nb = q % 32, kb = q / 32;
            const float* W = w == 0 ? A.in[22] : (w == 1 ? A.in[23] : A.in[24]); bf16* WT = (bf16*)(ws + (w == 0 ? WS_WOA : (w == 1 ? WS_WOL : WS_WOUT)));
            p0_transpose_item(W, DM, 64 * kb, 32 * nb, 32, WT, DM, 32 * nb, nullptr, scr, F.lane); continue; }
        r -= 3 * I_SQ;
        if (r < 2 * I_GU) { const int w = r / I_GU, q = r % I_GU, nb = q % (DFF / 32), kb = q / (DFF / 32); const int c = 32 * nb;
            p0_transpose_item(w == 0 ? A.in[26] : A.in[27], DFF, 64 * kb, c, 32, (bf16*)(ws + WS_WGU), DM, 256 * (c / 128) + (c % 128) + 128 * w, A.in[25], scr, F.lane); continue; }
        r -= 2 * I_GU;
        if (r < I_DN) { const int nb = r % 32, kb = r / 32;
            p0_transpose_item(A.in[28], DM, 64 * kb, 32 * nb, 32, (bf16*)(ws + WS_WDN), DFF, 32 * nb, nullptr, scr, F.lane); continue; }
        r -= I_DN;
        if (r < 2 * I_C1) { const int w = r / I_C1, q = r % I_C1, nb = q % 8, kb = q / 8;
            p0_transpose_item(w == 0 ? A.in[6] : A.in[11], 256, 64 * kb, 32 * nb, 32, (bf16*)(ws + WS_CW1) + (size_t)w * 256 * 2048, 2048, 32 * nb, nullptr, scr, F.lane); continue; }
        r -= 2 * I_C1;
        if (r < 2 * I_C2) { const int w = r / I_C2, q = r % I_C2, nb = q % 2, kb = q / 2;
            p0_transpose_item(w == 0 ? A.in[8] : A.in[13], 64, 64 * kb, 32 * nb, 32, (bf16*)(ws + WS_CW2) + (size_t)w * 64 * 256, 256, 32 * nb, nullptr, scr, F.lane); continue; }
        r -= 2 * I_C2;
        { const int w = r / I_LW, q = r % I_LW, nb = q % 2, blk = q / 2;
            p0_transpose_item((w == 0 ? A.in[17] : A.in[19]) + (size_t)blk * 4096, 64, 0, 32 * nb, 32, (bf16*)(ws + WS_LW) + (size_t)(w * 16 + blk) * 4096, 64, 32 * nb, nullptr, scr, F.lane); }
    }
    const float* x = A.in[0]; bf16* XB = (bf16*)(ws + WS_XB); float* rstd = (float*)(ws + WS_RSTD1);
    for (int m = gw; m < M_ROWS; m += NGW) {
        const GAS f32x4* xr = (const GAS f32x4*)(x + (size_t)m * DM) + F.lane;
        f32x4 v[4]; float s = 0.f;
#pragma unroll
        for (int j = 0; j < 4; ++j) { v[j] = xr[64 * j]; s += (v[j].x * v[j].x + v[j].y * v[j].y) + (v[j].z * v[j].z + v[j].w * v[j].w); }
        s = wave_sum(s);
        if (F.lane == 0) rstd[m] = 1.0f / sqrtf(s * (1.f / DM) + EPS);
        GAS unsigned long long* o8 = (GAS unsigned long long*)(XB + (size_t)m * DM) + F.lane;
#pragma unroll
        for (int j = 0; j < 4; ++j) o8[64 * j] = (unsigned long long)pk2(v[j].x, v[j].y) | ((unsigned long long)pk2(v[j].z, v[j].w) << 32);
    }
}
#if USE_NAIVE
__global__ void __launch_bounds__(256) nv_knorm(unsigned char* ws, const float* kng) {
    const int idx = blockIdx.x * 256 + threadIdx.x; if (idx >= M_ROWS * 8) return;
    const int m = idx >> 3, s = (idx >> 2) & 1, g = idx & 3, set = s ? 4 : 2;
    bf16* p = (bf16*)(ws + WS_KVB) + (size_t)m * KVW + set * 256 + g * 64; const float* gw = kng + (s ? 2 : 1) * 64;
    float v[64], ss = 0.f;
    for (int d = 0; d < 64; ++d) { v[d] = bf2f(p[d]); ss += v[d] * v[d]; }
    const float r = 1.0f / sqrtf(ss * (1.f / 64) + EPS);
    for (int d = 0; d < 64; ++d) p[d] = (bf16)f2bf(v[d] * r * gw[d]);
}
__global__ void __launch_bounds__(256) nv_compress(unsigned char* ws, const float* posk, const float* w1k, const float* b1k, const float* w2k, const float* b2k,
                                                   const float* posv, const float* w1v, const float* b1v, const float* w2v, const float* b2v, const float* kng) {
    __shared__ float blk[2048]; __shared__ float hid[256]; __shared__ float red[64];
    int id = blockIdx.x; const int n = id % NCMP; id /= NCMP; const int bg = id % 16, set = id / 16; const int b = bg >> 2, g = bg & 3, tid = threadIdx.x;
    const float* pos = set ? posv : posk; const float* w1 = set ? w1v : w1k; const float* b1 = set ? b1v : b1k; const float* w2 = set ? w2v : w2k; const float* b2 = set ? b2v : b2k;
    const bf16* kv = (const bf16*)(ws + WS_KVB) + (size_t)(b * SEQ + 16 * n) * KVW + set * 256 + g * 64;
    for (int e = tid; e < 2048; e += 256) { const int l = e >> 6, d = e & 63; blk[e] = bf2f(kv[(size_t)l * KVW + d]) + pos[e]; }
    __syncthreads();
    float acc = b1[tid];
    for (int k = 0; k < 2048; ++k) acc += blk[k] * w1[(size_t)k * 256 + tid];
    hid[tid] = gelu_tanh(acc);
    __syncthreads();
    float o = 0.f;
    if (tid < 64) { o = b2[tid]; for (int f = 0; f < 256; ++f) o += hid[f] * w2[f * 64 + tid]; red[tid] = o * o; }
    __syncthreads();
    if (tid < 64) {
        if (set == 0) { float ss = 0.f; for (int d = 0; d < 64; ++d) ss += red[d]; o = o * (1.0f / sqrtf(ss * (1.f / 64) + EPS)) * kng[tid]; }
        bf16* dst = (bf16*)(ws + (set ? WS_VC : WS_KC)) + ((size_t)bg * NCP + n) * 64 + tid; *dst = (bf16)f2bf(o);
    }
}
__global__ void __launch_bounds__(64) nv_lru(unsigned char* ws, const float* convw, const float* convb, const float* wa, const float* ba, const float* wi, const float* bi, const float* lam) {
    __shared__ float xs[64];
    const int b = blockIdx.x >> 4, n = blockIdx.x & 15, tid = threadIdx.x, c = n * 64 + tid;
    float wac[64], wic[64];
    for (int k = 0; k < 64; ++k) { wac[k] = wa[(size_t)n * 4096 + k * 64 + tid]; wic[k] = wi[(size_t)n * 4096 + k * 64 + tid]; }
    const float cw0 = convw[c], cw1 = convw[1024 + c], cw2 = convw[2048 + c], cw3 = convw[3072 + c], cb = convb[c], bac = ba[c], bic = bi[c];
    const float sp = log1pf(expf(-lam[c]));
    const bf16* LX = (const bf16*)(ws + WS_LX); bf16* LG = (bf16*)(ws + WS_LGG);
    float h = 0.f, xm3 = 0.f, xm2 = 0.f, xm1 = 0.f;
    for (int t = 0; t < SEQ; ++t) {
        const size_t m = (size_t)b * SEQ + t;
        const float x0 = bf2f(LX[m * DM + c]); const float xc = cb + cw0 * xm3 + cw1 * xm2 + cw2 * xm1 + cw3 * x0; xm3 = xm2; xm2 = xm1; xm1 = x0;
        xs[tid] = xc; __syncthreads();
        float r = bac, i = bic;
#pragma unroll
        for (int k = 0; k < 64; ++k) { r += xs[k] * wac[k]; i += xs[k] * wic[k]; }
        __syncthreads();
        r = 1.f / (1.f + expf(-r)); i = 1.f / (1.f + expf(-i));
        const float la = -8.0f * r * sp, a = expf(la), bb = sqrtf(-expm1f(2.f * la)) * (i * xc);
        h = a * h + bb;
        LG[m * DM + c] = (bf16)f2bf(h * bf2f(LG[m * DM + c]));
    }
}
__global__ void __launch_bounds__(256) nv_attn(unsigned char* ws, const float* qng) {
    __shared__ float qs[4][4][64]; __shared__ float ps[4][4][1024];
    const int m = blockIdx.x, b = m / SEQ, t = m % SEQ, g = threadIdx.x >> 6, l = threadIdx.x & 63, bg = b * 4 + g;
    const bf16* QB = (const bf16*)(ws + WS_QB); const bf16* KVB = (const bf16*)(ws + WS_KVB); const bf16* NG = (const bf16*)(ws + WS_NG);
    const bf16* KC = (const bf16*)(ws + WS_KC) + (size_t)bg * NCP * 64; const bf16* VC = (const bf16*)(ws + WS_VC) + (size_t)bg * NCP * 64;
    bf16* AT = (bf16*)(ws + WS_XB);
    float slope[4];
    for (int h = 0; h < 4; ++h) {
        const float q = bf2f(QB[(size_t)m * DM + (g * 4 + h) * 64 + l]); const float ss = wave_sum(q * q);
        qs[g][h][l] = q * (1.0f / sqrtf(ss * (1.f / 64) + EPS)) * qng[l] * 0.125f;
        slope[h] = exp2f(-8.0f * (float)(g * 4 + h + 1) / 16.0f);
    }
    __syncthreads();
    float out[4] = {0.f, 0.f, 0.f, 0.f};
    const int ncnt = t >= 31 ? ((t - 31) / 16 + 1 > NCMP ? NCMP : (t - 31) / 16 + 1) : 0;
    {
        float s[4][4];
        for (int k = 0; k < 4; ++k) { const int n = l + 64 * k; float d[4] = {0.f, 0.f, 0.f, 0.f};
            if (n < ncnt) for (int e = 0; e < 64; ++e) { const float kk = bf2f(KC[n * 64 + e]); for (int h = 0; h < 4; ++h) d[h] += qs[g][h][e] * kk; }
            for (int h = 0; h < 4; ++h) s[h][k] = n < ncnt ? d[h] - slope[h] * (float)(t - (16 * n + 31)) : -1e30f; }
        for (int h = 0; h < 4; ++h) {
            float mx = fmaxf(fmaxf(s[h][0], s[h][1]), fmaxf(s[h][2], s[h][3]));
            for (int o = 1; o < 64; o <<= 1) mx = fmaxf(mx, __shfl_xor(mx, o));
            float e[4], sm = 0.f;
            for (int k = 0; k < 4; ++k) { e[k] = (l + 64 * k) < ncnt ? expf(s[h][k] - mx) : 0.f; sm += e[k]; }
            sm = wave_sum(sm); const float inv = 1.0f / fmaxf(sm, 1e-30f);
            for (int k = 0; k < 4; ++k) ps[g][h][l + 64 * k] = e[k] * inv;
        }
        __syncthreads();
        float oc[4] = {0.f, 0.f, 0.f, 0.f};
        for (int n = 0; n < ncnt; ++n) { const float v = bf2f(VC[n * 64 + l]); for (int h = 0; h < 4; ++h) oc[h] += ps[g][h][n] * v; }
        for (int h = 0; h < 4; ++h) out[h] += bf2f(NG[(size_t)m * 48 + (g * 4 + h) * 3 + 0]) * oc[h];
    }
    unsigned long long selmask;
    {
        float imp = 0.f;
        for (int n = 4 * l - 1; n <= 4 * l + 3; ++n) if (n >= 0 && n < NCMP) for (int h = 0; h < 4; ++h) imp += ps[g][h][n];
        const int cur = t >> 6; const bool valid = (64 * l <= t), forced = (l == 0 || l == cur || l == cur - 1);
        const float val = valid ? imp + (forced ? 1e4f : 0.f) : -1e30f;
        int rank = 0;
        for (int j = 0; j < 64; ++j) { const float o = __shfl(val, j); rank += (o > val || (o == val && j < l)) ? 1 : 0; }
        selmask = __ballot(rank < 16);
    }
    __syncthreads();
    {
        float mx[4] = {-1e30f, -1e30f, -1e30f, -1e30f}; int slot = 0;
        for (int j = 0; j < 64; ++j) if ((selmask >> j) & 1ull) {
            const int pos = 64 * j + l; float d[4] = {0.f, 0.f, 0.f, 0.f};
            if (pos <= t) { const bf16* kr = KVB + (size_t)(b * SEQ + pos) * KVW + 2 * 256 + g * 64;
                for (int e = 0; e < 64; ++e) { const float kk = bf2f(kr[e]); for (int h = 0; h < 4; ++h) d[h] += qs[g][h][e] * kk; } }
            for (int h = 0; h < 4; ++h) { const float s = pos <= t ? d[h] - slope[h] * (float)(t - pos) : -1e30f; ps[g][h][slot * 64 + l] = s; mx[h] = fmaxf(mx[h], s); }
            ++slot;
        }
        float inv[4];
        for (int h = 0; h < 4; ++h) {
            for (int o = 1; o < 64; o <<= 1) mx[h] = fmaxf(mx[h], __shfl_xor(mx[h], o));
            float sm = 0.f;
            for (int k = 0; k < slot; ++k) { const float s = ps[g][h][k * 64 + l]; const float e = s > -1e29f ? expf(s - mx[h]) : 0.f; ps[g][h][k * 64 + l] = e; sm += e; }
            sm = wave_sum(sm); inv[h] = 1.0f / fmaxf(sm, 1e-30f);
        }
        __syncthreads();
        float os[4] = {0.f, 0.f, 0.f, 0.f}; slot = 0;
        for (int j = 0; j < 64; ++j) if ((selmask >> j) & 1ull) {
            if (64 * j <= t) for (int i = 0; i < 64; ++i) { const int pos = 64 * j + i; if (pos > t) break;
                const float v = bf2f(KVB[(size_t)(b * SEQ + pos) * KVW + 3 * 256 + g * 64 + l]); for (int h = 0; h < 4; ++h) os[h] += ps[g][h][slot * 64 + i] * v; }
            ++slot;
        }
        for (int h = 0; h < 4; ++h) out[h] += bf2f(NG[(size_t)m * 48 + (g * 4 + h) * 3 + 1]) * os[h] * inv[h];
    }
    __syncthreads();
    {
        float mx[4] = {-1e30f, -1e30f, -1e30f, -1e30f};
        for (int k = 0; k < 8; ++k) {
            const int pos = t - 511 + 64 * k + l; float d[4] = {0.f, 0.f, 0.f, 0.f};
            if (pos >= 0) { const bf16* kr = KVB + (size_t)(b * SEQ + pos) * KVW + 4 * 256 + g * 64;
                for (int e = 0; e < 64; ++e) { const float kk = bf2f(kr[e]); for (int h = 0; h < 4; ++h) d[h] += qs[g][h][e] * kk; } }
            for (int h = 0; h < 4; ++h) { const float s = pos >= 0 ? d[h] - slope[h] * (float)(t - pos) : -1e30f; ps[g][h][k * 64 + l] = s; mx[h] = fmaxf(mx[h], s); }
        }
        float inv[4];
        for (int h = 0; h < 4; ++h) {
            for (int o = 1; o < 64; o <<= 1) mx[h] = fmaxf(mx[h], __shfl_xor(mx[h], o));
            float sm = 0.f;
            for (int k = 0; k < 8; ++k) { const float s = ps[g][h][k * 64 + l]; const float e = s > -1e29f ? expf(s - mx[h]) : 0.f; ps[g][h][k * 64 + l] = e; sm += e; }
            sm = wave_sum(sm); inv[h] = 1.0f / fmaxf(sm, 1e-30f);
        }
        __syncthreads();
        float ow[4] = {0.f, 0.f, 0.f, 0.f};
        for (int i = 0; i < 512; ++i) { const int pos = t - 511 + i; if (pos < 0) continue;
            const float v = bf2f(KVB[(size_t)(b * SEQ + pos) * KVW + 5 * 256 + g * 64 + l]); for (int h = 0; h < 4; ++h) ow[h] += ps[g][h][i] * v; }
        for (int h = 0; h < 4; ++h) out[h] += bf2f(NG[(size_t)m * 48 + (g * 4 + h) * 3 + 2]) * ow[h] * inv[h];
    }
    for (int h = 0; h < 4; ++h) AT[(size_t)m * DM + (g * 4 + h) * 64 + l] = (bf16)f2bf(out[h]);
}
#endif
__device__ __forceinline__ void phase2(Frame& F, const Args& A) {}
__device__ __forceinline__ void phase3(Frame& F, const Args& A) {}
constexpr int N_PHASES = 8;

__global__ void __launch_bounds__(NWAVES * 64, 2) fwd_kernel(Args args) {
    extern __shared__ __attribute__((aligned(16))) unsigned char lds[];
    Frame F;
    F.lds = (LAS unsigned char*)lds;
    F.MISC = (volatile LAS unsigned*)(F.lds + MISC_OFF);
    F.tid = threadIdx.x; F.lane = F.tid & 63; F.wave = __builtin_amdgcn_readfirstlane(F.tid >> 6);
    F.G = gridDim.x; { const int bx = blockIdx.x; F.vcu = (F.G % 8 == 0) ? (bx % 8) * (F.G / 8) + bx / 8 : bx; }
    F.out = args.out; F.ws = args.ws; unsigned char* ws = args.ws;
    F.ctl = (gu32*)(ws + WS_CTL);
    for (int u = F.tid; u < (LDS_BYTES - LDSCTL_OFF) / 4; u += NWAVES * 64) ((LAS unsigned*)(F.lds + LDSCTL_OFF))[u] = 0u;
    __syncthreads();
    const int lo = args.ph_lo, hi = args.ph_hi;
    const bool multi = (hi - lo) > 1;
    XcdBarrier bar; bar.bar = (unsigned*)(F.ctl + CW_BAR); bar.x = 0; bar.st = nullptr;
    if (multi) bar = xcd_barrier_post((unsigned*)(F.ctl + CW_BAR), F.MISC + 8);
#ifdef ONLY
#define IN(k) ((k) == ONLY && lo <= (k) && (k) < hi)
#else
#define IN(k) (lo <= (k) && (k) < hi)
#endif
#define SEAM(k) do { if (IN(k) && IN((k) + 1)) xcd_barrier(bar); } while (0)
    using namespace pg8;
    PG8_LAS unsigned char* ring = (PG8_LAS unsigned char*)lds;

    if (IN(0)) { p0_prologue(F, args); SEAM(0); }

    if (IN(1)) {
        Gemm g{2 * DM, 128, 2 * DM, 128, DM / 64};
        SchedSimple S; S.T.init(M_ROWS, NPROJ, F.G, (int)blockIdx.x); S.A = (const char*)(ws + WS_XB); S.B = (const char*)(ws + WS_WIN); S.tA = (size_t)256 * 2 * DM; S.tB = (size_t)256 * 2 * DM;
        EpiProj E{(const float*)(ws + WS_RSTD1), (bf16_t*)(ws + WS_QB), (bf16_t*)(ws + WS_KVB), (bf16_t*)(ws + WS_NG), (bf16_t*)(ws + WS_LX), (bf16_t*)(ws + WS_LGG), (bf16_t*)F.out};
        gemm_phase<EpiProj, SchedSimple>(ring, g, S, E);
        SEAM(1);
    }
    if (IN(2)) { phase2(F, args); SEAM(2); }
    if (IN(3)) { phase3(F, args); SEAM(3); }
    if (IN(4)) {
        Gemm g{2 * DM, 128, 2 * DM, 128, DM / 64};
        SchedMerge S; S.T.init(M_ROWS, DM, F.G, (int)blockIdx.x); S.A0 = (const char*)(ws + WS_XB); S.A1 = (const char*)(ws + WS_LGG); S.B0 = (const char*)(ws + WS_WOA); S.B1 = (const char*)(ws + WS_WOL);
        S.tA = (size_t)256 * 2 * DM; S.tB = (size_t)256 * 2 * DM;
        EpiMerge E{(const bf16_t*)F.out, (f32x4*)(ws + WS_MRGF), (bf16_t*)(ws + WS_LX)};
        gemm_phase<EpiMerge, SchedMerge>(ring, g, S, E);
        SEAM(4);
    }
    if (IN(5)) {
        Gemm g{2 * DM, 128, 2 * DM, 128, DM / 64};
        SchedSimple S; S.T.init(M_ROWS, DM, F.G, (int)blockIdx.x); S.A = (const char*)(ws + WS_LX); S.B = (const char*)(ws + WS_WOUT); S.tA = (size_t)256 * 2 * DM; S.tB = (size_t)256 * 2 * DM;
        EpiWout E{args.in[0], F.out, (bf16_t*)(ws + WS_XB), (float*)(ws + WS_SSQ)};
        gemm_phase<EpiWout, SchedSimple>(ring, g, S, E);
        SEAM(5);
    }
    if (IN(6)) {
        Gemm g{2 * DM, 128, 2 * DM, 128, DM / 64};
        SchedSimple S; S.T.init(M_ROWS, NGU, F.G, (int)blockIdx.x); S.A = (const char*)(ws + WS_XB); S.B = (const char*)(ws + WS_WGU); S.tA = (size_t)256 * 2 * DM; S.tB = (size_t)256 * 2 * DM;
        EpiGU E{(const float*)(ws + WS_SSQ), (bf16_t*)(ws + WS_FF)};
        gemm_phase<EpiGU, SchedSimple>(ring, g, S, E);
        SEAM(6);
    }
    if (IN(7)) {
        Gemm g{2 * DFF, 128, 2 * DFF, 128, DFF / 64};
        SchedSimple S; S.T.init(M_ROWS, DM, F.G, (int)blockIdx.x); S.A = (const char*)(ws + WS_FF); S.B = (const char*)(ws + WS_WDN); S.tA = (size_t)256 * 2 * DFF; S.tB = (size_t)256 * 2 * DFF;
        EpiDown E{F.out};
        gemm_phase<EpiDown, SchedSimple>(ring, g, S, E);
    }
#undef IN
#undef SEAM
}

extern "C" void kernel_launch(void* const* d_in, const int* in_sizes, int n_in, void* d_out, int out_size, void* d_ws, size_t ws_size, hipStream_t stream) {
    static int grid = 0;
    if (grid == 0) {
        if (n_in != 29 || out_size != M_ROWS * DM || ws_size < WS_END) { fprintf(stderr, "kernel_launch: unexpected problem (n_in %d, out %d, ws %zu)\n", n_in, out_size, ws_size); grid = -1; return; }
        int dev = 0, cus = 0, per_cu = 0;
        if (hipGetDevice(&dev) != hipSuccess || hipDeviceGetAttribute(&cus, hipDeviceAttributeMultiprocessorCount, dev) != hipSuccess) { grid = -1; return; }
        if (hipFuncSetAttribute((const void*)fwd_kernel, hipFuncAttributeMaxDynamicSharedMemorySize, LDS_BYTES) != hipSuccess) { fprintf(stderr, "kernel_launch: hipFuncSetAttribute failed\n"); grid = -1; return; }
        if (hipOccupancyMaxActiveBlocksPerMultiprocessor(&per_cu, (const void*)fwd_kernel, NWAVES * 64, LDS_BYTES) != hipSuccess || per_cu < 1) { fprintf(stderr, "kernel_launch: occupancy query says %d blocks per CU\n", per_cu); grid = -1; return; }
        (void)hipGetLastError();
        grid = cus;
        if (grid > 256) grid = 256;
    }
    if (grid < 0) return;
    (void)hipMemsetAsync((char*)d_ws + WS_CTL, 0, CTL_ZERO_BYTES, stream);
    Args a{};
    for (int i = 0; i < 29; ++i) a.in[i] = (const float*)d_in[i];
    a.out = (float*)d_out; a.ws = (unsigned char*)d_ws;
#if N_LAUNCHES == 1
    a.ph_lo = 0; a.ph_hi = N_PHASES;
    hipLaunchKernelGGL(fwd_kernel, dim3(grid), dim3(NWAVES * 64), LDS_BYTES, stream, a);
#else
    for (int p = 0; p < N_PHASES; ++p) {
#if USE_NAIVE
        if (p == 2) {
            unsigned char* ws = (unsigned char*)d_ws;
            hipLaunchKernelGGL(nv_knorm, dim3(M_ROWS * 8 / 256), dim3(256), 0, stream, ws, a.in[4]);
            hipLaunchKernelGGL(nv_compress, dim3(2 * 16 * NCMP), dim3(256), 0, stream, ws, a.in[5], a.in[6], a.in[7], a.in[8], a.in[9], a.in[10], a.in[11], a.in[12], a.in[13], a.in[14], a.in[4]);
            hipLaunchKernelGGL(nv_lru, dim3(64), dim3(64), 0, stream, ws, a.in[15], a.in[16], a.in[17], a.in[18], a.in[19], a.in[20], a.in[21]);
            continue;
        }
        if (p == 3) { hipLaunchKernelGGL(nv_attn, dim3(M_ROWS), dim3(256), 0, stream, (unsigned char*)d_ws, a.in[3]); continue; }
#endif
        a.ph_lo = p; a.ph_hi = p + 1;
        hipLaunchKernelGGL(fwd_kernel, dim3(grid), dim3(NWAVES * 64), LDS_BYTES, stream, a);
    }
#endif
}
```

```cpp
#include <hip/hip_runtime.h>
#include <cstdio>
#include <cstdint>
#ifndef N_LAUNCHES
#define N_LAUNCHES 1
#endif
#ifndef NAIVE_P2
#define NAIVE_P2 0
#endif
#ifndef NAIVE_ATTN
#define NAIVE_ATTN 0
#endif
#define FAST_ATTN (!NAIVE_ATTN)
#define USE_NAIVE (NAIVE_P2 || NAIVE_ATTN)
namespace pg8 {
#define PG8_LAS __attribute__((address_space(3)))
typedef unsigned short bf16_t;
typedef short bf16x8 __attribute__((ext_vector_type(8)));
typedef float f32x4 __attribute__((ext_vector_type(4)));
typedef float f32x2 __attribute__((ext_vector_type(2)));
typedef unsigned u32x4 __attribute__((ext_vector_type(4)));
typedef unsigned u32x2 __attribute__((ext_vector_type(2)));
constexpr int BM = 256, BK = 64, HALF = 128, HTB = HALF * BK * 2  , STAGE_BYTES = 8 * HTB, NXCD = 8, WGM = 8;

__host__ __device__ __forceinline__ int lds_byte(int r, int c) { const int st = (r >> 4) * 2 + (c >> 5), rr = r & 15, cc = c & 31, ob = rr * 64 + cc * 2; return st * 1024 + (ob ^ (((ob >> 9) & 1) << 5)); }
__host__ __device__ __forceinline__ void stage_rc(int b, int& R, int& C) { const int st = b / 1024, sb = b % 1024, swz = sb ^ (((sb >> 9) & 1) << 5); R = (st >> 1) * 16 + swz / 64; C = (st & 1) * 32 + (swz % 64) / 2; }
__host__ __device__ __forceinline__ int perm32(int rho) { const int n = rho >> 4, i = rho & 15; return 8 * (i >> 2) + 4 * n + (i & 3); }

struct Unit { int pm, pn, kind; };
struct Gemm { int rowA, kstepA, rowB, kstepB, nt; };

struct TileOrder {
    int nM, nN, nwg, G, c;
    __device__ void init(int M, int N, int G_, int c_) { nM = M / BM; nN = N / BM; nwg = nM * nN; G = G_; c = c_; }
    __device__ bool tile(int i, int& pm, int& pn) const {
        const long L = (long)i * G + c; if (L >= nwg) return false;
        int wgid = (int)L; { const int q = nwg / NXCD, r = nwg % NXCD, xcd = wgid % NXCD, off = wgid / NXCD; wgid = (xcd < r ? xcd * (q + 1) : r * (q + 1) + (xcd - r) * q) + off; }
        const int nig = WGM * nN, gid = wgid / nig, fm = gid * WGM, gsz = (nM - fm) < WGM ? (nM - fm) : WGM;
        pm = fm + ((wgid % nig) % gsz); pn = (wgid % nig) / gsz; return true;
    }
};

__device__ __forceinline__ unsigned cvt_pk_bf16(float lo, float hi) { unsigned r; asm volatile("v_cvt_pk_bf16_f32 %0, %1, %2" : "=v"(r) : "v"(lo), "v"(hi)); return r; }

template <class Epi, class Sched>
__device__ __forceinline__ void gemm_phase(PG8_LAS unsigned char* lds, const Gemm g, const Sched& S, const Epi& E) {
    const int tid = threadIdx.x, wid = __builtin_amdgcn_readfirstlane(tid >> 6), lane = tid & 63, wr = wid >> 2, wc = wid & 3, fr = lane & 15, fq = lane >> 4;
    const int nt = g.nt;
    unsigned voffA[2], voffB[2];
#pragma unroll
    for (int i = 0; i < 2; ++i) { int R, C; stage_rc(tid * 16 + i * 8192, R, C); const int Rb = Epi::PERM ? ((R & ~31) + perm32(R & 31)) : R;
        voffA[i] = (unsigned)(R * g.rowA + C * 2); voffB[i] = (unsigned)(Rb * g.rowB + C * 2); }
    const size_t kstepA = (size_t)g.kstepA, kstepB = (size_t)g.kstepB;
    const size_t hstepA = (size_t)HALF * g.rowA, hstepB = (size_t)HALF * g.rowB;
    const unsigned ldsw = (unsigned)wid * 1024u;
    const int aoff = lds_byte(wr * 64 + fr, fq * 8), boff = lds_byte(wc * 32 + fr, fq * 8);
#define PG8_SA(b, h) (((b) * 2 + (h)) * HTB)
#define PG8_SB(b, h) ((4 + (b) * 2 + (h)) * HTB)
#define PG8_STAGE(bufoff, gbase, voff) do { _Pragma("unroll") for (int _i = 0; _i < 2; ++_i) \
        __builtin_amdgcn_global_load_lds((const unsigned*)((const char*)(gbase) + (voff)[_i]), (PG8_LAS unsigned*)(lds + (bufoff) + ldsw + _i * 8192), 16, 0, 0); } while (0)
#define PG8_LDA(dst, b, h) do { _Pragma("unroll") for (int m = 0; m < 4; ++m) _Pragma("unroll") for (int k = 0; k < 2; ++k) dst[m][k] = *(const PG8_LAS bf16x8*)(lds + PG8_SA(b, h) + aoff + m * 2048 + k * 1024); } while (0)
#define PG8_LDB(dst, b, h) do { _Pragma("unroll") for (int n = 0; n < 2; ++n) _Pragma("unroll") for (int k = 0; k < 2; ++k) dst[n][k] = *(const PG8_LAS bf16x8*)(lds + PG8_SB(b, h) + boff + n * 2048 + k * 1024); } while (0)
#define PG8_MMA(ai, bj, At, Bt) do { __builtin_amdgcn_s_setprio(1); _Pragma("unroll") for (int m = 0; m < 4; ++m) _Pragma("unroll") for (int n = 0; n < 2; ++n) _Pragma("unroll") for (int k = 0; k < 2; ++k) \
        acc[ai][bj][m][n] = __builtin_amdgcn_mfma_f32_16x16x32_bf16(Bt[n][k], At[m][k], acc[ai][bj][m][n], 0, 0, 0); __builtin_amdgcn_s_setprio(0); } while (0)
#define PG8_WAIT_V(n) asm volatile("s_waitcnt vmcnt(" #n ")" ::: "memory")
#define PG8_WAIT_L(n) asm volatile("s_waitcnt lgkmcnt(" #n ")" ::: "memory")
#define PG8_BAR __builtin_amdgcn_s_barrier()
#define PG8_SCHED __builtin_amdgcn_sched_barrier(0)
    Unit cur, nxt; int ui = 0;
    if (!S.next(0, cur)) return;
    f32x4 acc[2][2][4][2];
#pragma unroll
    for (int a = 0; a < 2; ++a)
#pragma unroll
        for (int b = 0; b < 2; ++b)
#pragma unroll
            for (int m = 0; m < 4; ++m)
#pragma unroll
                for (int n = 0; n < 2; ++n) acc[a][b][m][n] = (f32x4){0.f, 0.f, 0.f, 0.f};
    bf16x8 At[4][2], B0[2][2], B1[2][2];
    const char* cA = S.abase(cur); const char* cB = S.bbase(cur);
    PG8_STAGE(PG8_SB(0, 0), cB, voffB); PG8_STAGE(PG8_SB(0, 1), cB + hstepB, voffB); PG8_STAGE(PG8_SA(0, 0), cA, voffA); PG8_STAGE(PG8_SA(0, 1), cA + hstepA, voffA);
    if (wr == 1) PG8_BAR;
    PG8_WAIT_V(2); PG8_BAR;
    PG8_STAGE(PG8_SB(1, 0), cB + kstepB, voffB); PG8_STAGE(PG8_SA(1, 0), cA + kstepA, voffA); PG8_STAGE(PG8_SB(1, 1), cB + hstepB + kstepB, voffB);
    PG8_WAIT_V(6); PG8_BAR;
    for (;;) {
        const bool has_next = S.next(ui + 1, nxt);
        const char* nA = has_next ? S.abase(nxt) : cA; const char* nB = has_next ? S.bbase(nxt) : cB;
        for (int t = 0; t < nt; t += 2) {
            const bool last = (t == nt - 2);
            const char* a1 = cA + (size_t)(t + 1) * kstepA;
            const char* a2 = last ? nA : cA + (size_t)(t + 2) * kstepA; const char* b2 = last ? nB : cB + (size_t)(t + 2) * kstepB;
            const char* a3 = a2 + kstepA; const char* b3 = b2 + kstepB;
            PG8_LDB(B0, 0, 0); PG8_LDB(B1, 0, 1); PG8_SCHED; PG8_LDA(At, 0, 0); PG8_STAGE(PG8_SA(1, 1), a1 + hstepA, voffA);
            PG8_WAIT_V(8); PG8_WAIT_L(0); PG8_BAR; PG8_MMA(0, 0, At, B0); PG8_MMA(0, 1, At, B1); PG8_BAR; PG8_SCHED;
            PG8_LDA(At, 0, 1); PG8_STAGE(PG8_SB(0, 0), b2, voffB); PG8_STAGE(PG8_SB(0, 1), b2 + hstepB, voffB); PG8_STAGE(PG8_SA(0, 0), a2, voffA);
            PG8_WAIT_V(8); PG8_WAIT_L(0); PG8_BAR; PG8_MMA(1, 0, At, B0); PG8_MMA(1, 1, At, B1); PG8_BAR; PG8_SCHED;
            PG8_LDB(B0, 1, 0); PG8_LDB(B1, 1, 1); PG8_SCHED; PG8_LDA(At, 1, 0); PG8_STAGE(PG8_SA(0, 1), a2 + hstepA, voffA);
            PG8_WAIT_V(8); PG8_WAIT_L(0); PG8_BAR; PG8_MMA(0, 0, At, B0); PG8_MMA(0, 1, At, B1); PG8_BAR; PG8_SCHED;
            PG8_LDA(At, 1, 1); PG8_STAGE(PG8_SB(1, 0), b3, voffB); PG8_STAGE(PG8_SB(1, 1), b3 + hstepB, voffB); PG8_STAGE(PG8_SA(1, 0), a3, voffA);
            PG8_WAIT_V(8); PG8_WAIT_L(0); PG8_BAR; PG8_MMA(1, 0, At, B0); PG8_MMA(1, 1, At, B1); PG8_BAR; PG8_SCHED;
        }
        if (wr == 0) PG8_BAR;
        E(acc, cur, wr, wc, fr, fq);
        if (!has_next) break;
#pragma unroll
        for (int a = 0; a < 2; ++a)
#pragma unroll
            for (int b = 0; b < 2; ++b)
#pragma unroll
                for (int m = 0; m < 4; ++m)
#pragma unroll
                    for (int n = 0; n < 2; ++n) acc[a][b][m][n] = (f32x4){0.f, 0.f, 0.f, 0.f};
        cur = nxt; cA = nA; cB = nB; ++ui;
        if (wr == 1) PG8_BAR;
    }
    PG8_WAIT_V(0);
    PG8_BAR;
#undef PG8_SA
#undef PG8_SB
#undef PG8_STAGE
#undef PG8_LDA
#undef PG8_LDB
#undef PG8_MMA
#undef PG8_WAIT_V
#undef PG8_WAIT_L
#undef PG8_BAR
#undef PG8_SCHED
}
}
constexpr int BATCH = 4, SEQ = 4096, DM = 1024, M_ROWS = BATCH * SEQ;
constexpr int NH = 16, HD = 64, NKV = 4, HPG = 4, KVW = 1536;
constexpr int IN_DIM = 6704, NPROJ = 6912;
constexpr int DFF = 2816, NGU = 2 * DFF;
constexpr int NCMP = 255, NCP = 256;
constexpr float EPS = 1e-6f;
constexpr float LOG2E = 1.4426950408889634f;

__device__ __forceinline__ float fast_sigmoid(float x) { return __builtin_amdgcn_rcpf(1.f + __builtin_amdgcn_exp2f(-LOG2E * x)); }
__device__ __forceinline__ float gelu_tanh(float x) { return x * fast_sigmoid(x * (1.5957691216f + 0.0713548163f * x * x)); }

namespace pg8 {
struct SchedSimple {
    TileOrder T; const char* A; const char* B; size_t tA, tB;
    __device__ __forceinline__ bool next(int i, Unit& u) const { u.kind = 0; return T.tile(i, u.pm, u.pn); }
    __device__ __forceinline__ const char* abase(const Unit& u) const { return A + (size_t)u.pm * tA; }
    __device__ __forceinline__ const char* bbase(const Unit& u) const { return B + (size_t)u.pn * tB; }
};
struct SchedMerge {
    TileOrder T; const char* A0; const char* A1; const char* B0; const char* B1; size_t tA, tB;
    __device__ __forceinline__ bool next(int i, Unit& u) const { u.kind = i & 1; return T.tile(i >> 1, u.pm, u.pn); }
    __device__ __forceinline__ const char* abase(const Unit& u) const { return (u.kind ? A1 : A0) + (size_t)u.pm * tA; }
    __device__ __forceinline__ const char* bbase(const Unit& u) const { return (u.kind ? B1 : B0) + (size_t)u.pn * tB; }
};

typedef f32x4 Acc[2][2][4][2];
#define EPI_ROW(ai, m) (u.pm * BM + (ai) * HALF + wr * 64 + (m) * 16 + fr)
#define EPI_CT(bj) ((bj) * HALF + wc * 32 + 8 * fq)

__device__ __forceinline__ u32x4 pack8(f32x4 a, f32x4 b) { u32x4 w; w.x = cvt_pk_bf16(a[0], a[1]); w.y = cvt_pk_bf16(a[2], a[3]); w.z = cvt_pk_bf16(b[0], b[1]); w.w = cvt_pk_bf16(b[2], b[3]); return w; }

struct EpiProj {
    static constexpr bool PERM = true;
    const float* rstd; bf16_t *QB, *KVB, *NG, *LX, *LGG, *MG;
    __device__ __forceinline__ void operator()(const Acc& acc, const Unit& u, int wr, int wc, int fr, int fq) const {
        const int pn = u.pn; bf16_t* dst; int ld, c0, act = 0, lim = 256;
        if (pn < 4) { dst = QB; ld = DM; c0 = pn * 256; }
        else if (pn < 10) { dst = KVB; ld = KVW; c0 = (pn - 4) * 256; }
        else if (pn == 10) { dst = NG; ld = 48; c0 = 0; act = 1; lim = 48; }
        else if (pn < 15) { dst = LX; ld = DM; c0 = (pn - 11) * 256; }
        else if (pn < 19) { dst = LGG; ld = DM; c0 = (pn - 15) * 256; act = 2; }
        else { dst = MG; ld = 2 * DM; c0 = (pn - 19) * 256; act = 1; }
#pragma unroll
        for (int ai = 0; ai < 2; ++ai)
#pragma unroll
            for (int m = 0; m < 4; ++m) {
                const int row = EPI_ROW(ai, m); const float rs = rstd[row];
#pragma unroll
                for (int bj = 0; bj < 2; ++bj) {
                    const int ct = EPI_CT(bj);
                    f32x4 v0 = acc[ai][bj][m][0] * rs, v1 = acc[ai][bj][m][1] * rs;
                    if (act == 1) {
#pragma unroll
                        for (int e = 0; e < 4; ++e) { v0[e] = fast_sigmoid(v0[e]); v1[e] = fast_sigmoid(v1[e]); }
                    } else if (act == 2) {
#pragma unroll
                        for (int e = 0; e < 4; ++e) { v0[e] = gelu_tanh(v0[e]); v1[e] = gelu_tanh(v1[e]); }
                    }
                    if (ct + 8 <= lim) *(u32x4*)(dst + (size_t)row * ld + c0 + ct) = pack8(v0, v1);
                }
            }
    }
};

struct EpiMerge {
    static constexpr bool PERM = true;
    const bf16_t* MG; f32x4* scr; bf16_t* MRG;
    __device__ __forceinline__ void operator()(const Acc& acc, const Unit& u, int wr, int wc, int fr, int fq) const {
        f32x4* my = scr + (size_t)blockIdx.x * (32 * 512) + threadIdx.x; const bf16_t* MGp = MG; bf16_t* MRGp = MRG;
        asm volatile("" : "+v"(my), "+s"(MGp), "+s"(MRGp));
#pragma unroll
        for (int ai = 0; ai < 2; ++ai)
#pragma unroll
            for (int m = 0; m < 4; ++m) {
                const int row = EPI_ROW(ai, m);
#pragma unroll
                for (int bj = 0; bj < 2; ++bj) {
                    const int col = u.pn * BM + EPI_CT(bj);
                    const u32x4 gw = *(const u32x4*)(MGp + (size_t)row * (2 * DM) + u.kind * DM + col);
                    f32x4 g0, g1;
                    g0[0] = __uint_as_float(gw.x << 16); g0[1] = __uint_as_float(gw.x & 0xffff0000u); g0[2] = __uint_as_float(gw.y << 16); g0[3] = __uint_as_float(gw.y & 0xffff0000u);
                    g1[0] = __uint_as_float(gw.z << 16); g1[1] = __uint_as_float(gw.z & 0xffff0000u); g1[2] = __uint_as_float(gw.w << 16); g1[3] = __uint_as_float(gw.w & 0xffff0000u);
                    const int ri = ((ai * 2 + bj) * 4 + m) * 2;
                    f32x4 v0 = acc[ai][bj][m][0] * g0, v1 = acc[ai][bj][m][1] * g1;
                    if (u.kind == 0) { my[(size_t)ri * 512] = v0; my[(size_t)(ri + 1) * 512] = v1; }
                    else { v0 += my[(size_t)ri * 512]; v1 += my[(size_t)(ri + 1) * 512]; *(u32x4*)(MRGp + (size_t)row * DM + col) = pack8(v0, v1); }
                }
                asm volatile("" ::: "memory");
            }
    }
};

struct EpiWout {
    static constexpr bool PERM = true;
    const float* x; float* out; bf16_t* X1B; float* ssq;
    __device__ __forceinline__ void operator()(const Acc& acc, const Unit& u, int wr, int wc, int fr, int fq) const {
#pragma unroll
        for (int ai = 0; ai < 2; ++ai)
#pragma unroll
            for (int m = 0; m < 4; ++m) {
                const int row = EPI_ROW(ai, m); float s = 0.f;
#pragma unroll
                for (int bj = 0; bj < 2; ++bj) {
                    const int col = u.pn * BM + EPI_CT(bj); const size_t off = (size_t)row * DM + col;
                    const f32x4 v0 = *(const f32x4*)(x + off) + acc[ai][bj][m][0], v1 = *(const f32x4*)(x + off + 4) + acc[ai][bj][m][1];
                    *(f32x4*)(out + off) = v0; *(f32x4*)(out + off + 4) = v1;
                    *(u32x4*)(X1B + off) = pack8(v0, v1);
                    s += (v0[0] * v0[0] + v0[1] * v0[1]) + (v0[2] * v0[2] + v0[3] * v0[3]) + (v1[0] * v1[0] + v1[1] * v1[1]) + (v1[2] * v1[2] + v1[3] * v1[3]);
                }
                s += __shfl_xor(s, 16); s += __shfl_xor(s, 32);
                if (fq == 0) ssq[(size_t)row * 16 + u.pn * 4 + wc] = s;
            }
    }
};

struct EpiGU {
    static constexpr bool PERM = true;
    const float* ssq; bf16_t* FF;
    __device__ __forceinline__ void operator()(const Acc& acc, const Unit& u, int wr, int wc, int fr, int fq) const {
#pragma unroll
        for (int ai = 0; ai < 2; ++ai)
#pragma unroll
            for (int m = 0; m < 4; ++m) {
                const int row = EPI_ROW(ai, m);
                const f32x4* sp = (const f32x4*)(ssq + (size_t)row * 16);
                const f32x4 s0 = sp[0], s1 = sp[1], s2 = sp[2], s3 = sp[3];
                const float tot = ((s0[0] + s0[1]) + (s0[2] + s0[3])) + ((s1[0] + s1[1]) + (s1[2] + s1[3])) + ((s2[0] + s2[1]) + (s2[2] + s2[3])) + ((s3[0] + s3[1]) + (s3[2] + s3[3]));
                const float rs = __builtin_amdgcn_rsqf(tot * (1.f / DM) + EPS);
                f32x4 o[2];
#pragma unroll
                for (int n = 0; n < 2; ++n)
#pragma unroll
                    for (int e = 0; e < 4; ++e) { const float g = acc[ai][0][m][n][e] * rs, up = acc[ai][1][m][n][e] * rs; o[n][e] = g * fast_sigmoid(g) * up; }
                *(u32x4*)(FF + (size_t)row * DFF + u.pn * HALF + wc * 32 + 8 * fq) = pack8(o[0], o[1]);
            }
    }
};

struct EpiDown {
    static constexpr bool PERM = true;
    float* out;
    __device__ __forceinline__ void operator()(const Acc& acc, const Unit& u, int wr, int wc, int fr, int fq) const {
#pragma unroll
        for (int ai = 0; ai < 2; ++ai)
#pragma unroll
            for (int m = 0; m < 4; ++m) {
                const int row = EPI_ROW(ai, m);
#pragma unroll
                for (int bj = 0; bj < 2; ++bj) {
                    const size_t off = (size_t)row * DM + u.pn * BM + EPI_CT(bj);
                    const f32x4 v0 = *(const f32x4*)(out + off) + acc[ai][bj][m][0], v1 = *(const f32x4*)(out + off + 4) + acc[ai][bj][m][1];
                    *(f32x4*)(out + off) = v0; *(f32x4*)(out + off + 4) = v1;
                }
            }
    }
};
#undef EPI_ROW
#undef EPI_CT
}
constexpr size_t MiB = 1u << 20;
constexpr size_t WS_CTL = 0, CTL_ZERO_BYTES = 1 * MiB;
constexpr size_t WS_NG = 1 * MiB;
constexpr size_t WS_RSTD1 = 3 * MiB;
constexpr size_t WS_SSQ = 4 * MiB;
constexpr size_t WS_KC = 5 * MiB;
constexpr size_t WS_VC = 5 * MiB + 512 * 1024;
constexpr size_t WS_LSUM = 6 * MiB;
constexpr size_t WS_CW2 = 7 * MiB;
constexpr size_t WS_LW = 7 * MiB + 256 * 1024;
constexpr size_t WS_HID = 8 * MiB;
constexpr size_t WS_CW1 = 12 * MiB;
constexpr size_t WS_WOA = 14 * MiB, WS_WOL = 16 * MiB, WS_WOUT = 18 * MiB;
constexpr size_t WS_WDN = 20 * MiB;
constexpr size_t WS_WGU = 26 * MiB;
constexpr size_t WS_WIN = 37 * MiB;
constexpr size_t WS_XB = 51 * MiB;
constexpr size_t WS_QB = 83 * MiB;
constexpr size_t WS_KVB = 115 * MiB;
constexpr size_t WS_LX = 163 * MiB;
constexpr size_t WS_LGG = 195 * MiB;
constexpr size_t WS_MRGF = 83 * MiB;
constexpr size_t WS_FF = 83 * MiB;
constexpr size_t WS_END = 227 * MiB;

constexpr int CW_BAR = 4096;

constexpr int RING_BYTES = 131072;
constexpr int LDSCTL_OFF = RING_BYTES, MISC_OFF = LDSCTL_OFF + 320;
constexpr int LDS_BYTES = 147456;
constexpr int NWAVES = 8;

#define GAS __attribute__((address_space(1)))
#define LAS __attribute__((address_space(3)))
typedef unsigned short bf16;
typedef unsigned v4u __attribute__((ext_vector_type(4)));
typedef unsigned v2u __attribute__((ext_vector_type(2)));
typedef float f32x4 __attribute__((ext_vector_type(4)));
typedef short bf16x8 __attribute__((ext_vector_type(8)));
typedef GAS unsigned gu32;
#define RLX_AGENT __ATOMIC_RELAXED, __HIP_MEMORY_SCOPE_AGENT
#define LDS_WAIT() asm volatile("s_waitcnt lgkmcnt(0)" ::: "memory")
#define VM_WAIT() asm volatile("s_waitcnt vmcnt(0)" ::: "memory")
__device__ __forceinline__ unsigned f2bf(float f) { unsigned u = __builtin_bit_cast(unsigned, f); return (u + 0x7fffu + ((u >> 16) & 1u)) >> 16; }
__device__ __forceinline__ unsigned pk2(float lo, float hi) { return f2bf(lo) | (f2bf(hi) << 16); }
__device__ __forceinline__ float bf2f(unsigned short h) { return __uint_as_float((unsigned)h << 16); }
__device__ __forceinline__ float bflo(unsigned w) { return __uint_as_float(w << 16); }
__device__ __forceinline__ float bfhi(unsigned w) { return __uint_as_float(w & 0xffff0000u); }

#define XB_TMO      128
#define XB_XCNT(j)  (256  + 64 * (j))
#define XB_XSUB(j)  (1280 + 64 * (j))
#define XB_XGEN(j)  (2304 + 64 * (j))
#define XB_TOP      3328
#define XB_TOPGEN   3392
#define XCD_BAR_WORDS 3456
#define XB_SPIN_CAP (1u << 20)
__device__ __forceinline__ unsigned xb_ld(unsigned* p)              { return __hip_atomic_load(p, __ATOMIC_RELAXED, __HIP_MEMORY_SCOPE_AGENT); }
__device__ __forceinline__ unsigned xb_add(unsigned* p, unsigned v) { return __hip_atomic_fetch_add(p, v, __ATOMIC_RELAXED, __HIP_MEMORY_SCOPE_AGENT); }
__device__ __forceinline__ unsigned xb_xcc_id() { return (unsigned)__builtin_amdgcn_s_getreg((3 << 11) | 20) & 0xFu; }
#define XB_SPIN(cond, bar) do { unsigned _sp = 0; while (cond) { __builtin_amdgcn_s_sleep(1); \
    if ((++_sp & 255u) == 0u) { if (xb_ld(&(bar)[XB_TMO])) break; if (_sp > XB_SPIN_CAP) { atomicAdd(&(bar)[XB_TMO], 1u); break; } } } } while (0)
struct XcdBarrier { unsigned* bar; unsigned x; volatile LAS unsigned* st; };
__device__ __forceinline__ XcdBarrier xcd_barrier_post(unsigned* bar, volatile LAS unsigned* st) {
    XcdBarrier b; b.bar = bar; b.x = xb_xcc_id(); b.st = st;
    if (threadIdx.x == 0) (void)xb_add(&bar[XB_XCNT(b.x)], 1u);
    return b;
}
__device__ __forceinline__ void xcd_barrier_complete(unsigned* bar, unsigned x, unsigned& nloc, unsigned& nx) {
    const unsigned G = gridDim.x * gridDim.y * gridDim.z;
    unsigned sum, cnt, mine, sp = 0u;
    for (;;) {
        sum = 0u; cnt = 0u; mine = 0u;
#pragma unroll
        for (unsigned j = 0; j < 16; ++j) { const unsigned c = xb_ld(&bar[XB_XCNT(j)]); sum += c; cnt += (c > 0u) ? 1u : 0u; mine = (j == x) ? c : mine; }
        if (sum == G) break;
        __builtin_amdgcn_s_sleep(1);
        if ((++sp & 255u) == 0u) { if (xb_ld(&bar[XB_TMO])) break; if (sp > XB_SPIN_CAP) { atomicAdd(&bar[XB_TMO], 1u); break; } }
    }
    nloc = mine > 0u ? mine : 1u; nx = cnt > 0u ? cnt : 1u;
}
__device__ __forceinline__ void xcd_barrier(const XcdBarrier& b) {
    asm volatile("s_waitcnt vmcnt(0)" ::: "memory");
    __syncthreads();
    if (threadIdx.x == 0) {
        unsigned* bar = b.bar;
        __builtin_amdgcn_s_waitcnt(0);
        unsigned nloc = b.st[0], nx = b.st[1];
        if (nloc == 0u) { xcd_barrier_complete(bar, b.x, nloc, nx); b.st[0] = nloc; b.st[1] = nx; }
        const unsigned old = xb_add(&bar[XB_XSUB(b.x)], 1u);
        const unsigned gen = old / nloc;
        if (old + 1u == (gen + 1u) * nloc) {
            __builtin_amdgcn_fence(__ATOMIC_RELEASE, "agent");
            asm volatile("s_waitcnt vmcnt(0)" ::: "memory");
            const unsigned og = xb_add(&bar[XB_TOP], 1u);
            const unsigned tg = og / nx;
            if (og + 1u == (tg + 1u) * nx) xb_add(&bar[XB_TOPGEN], 1u);
            else XB_SPIN(xb_ld(&bar[XB_TOPGEN]) == tg, bar);
            __builtin_amdgcn_fence(__ATOMIC_ACQUIRE, "agent");
            xb_add(&bar[XB_XGEN(b.x)], 1u);
            asm volatile("s_waitcnt vmcnt(0)" ::: "memory");
        } else {
            XB_SPIN(xb_ld(&bar[XB_XGEN(b.x)]) == gen, bar);
            __builtin_amdgcn_fence(__ATOMIC_ACQUIRE, "agent");
            asm volatile("s_waitcnt vmcnt(0)" ::: "memory");
        }
    }
    __syncthreads();
}

struct Frame {
    LAS unsigned char* lds;
    volatile LAS unsigned* MISC;
    gu32* ctl;
    int tid, lane, wave, vcu, G;
    float* out; unsigned char* ws;
};
struct Args { const float* in[29]; float* out; unsigned char* ws; int ph_lo, ph_hi; };
__device__ __forceinline__ float wave_sum(float v) {
#pragma unroll
    for (int o = 1; o < 64; o <<= 1) v += __shfl_xor(v, o);
    return v;
}

__device__ __forceinline__ void p0_transpose_item(const float* W, int ldw, int k0, int nsrc, int nvalid, bf16* WT, int ldt, int ndst, const float* gk, LAS float* scr, int lane) {
#pragma unroll 8
    for (int i = 0; i < 32; ++i) { const int kk = 2 * i + (lane >> 5), c = lane & 31;
        float v = 0.f; if (c < nvalid) { v = W[(size_t)(k0 + kk) * ldw + nsrc + c]; if (gk) v *= gk[k0 + kk]; }
        scr[kk * 33 + c] = v; }
    LDS_WAIT(); asm volatile("" ::: "memory");
    const int c = lane & 7;
#pragma unroll
    for (int j = 0; j < 4; ++j) { const int n = (lane >> 3) + 8 * j; const LAS float* s = scr + (8 * c) * 33 + n;
        v4u o; o.x = pk2(s[0 * 33], s[1 * 33]); o.y = pk2(s[2 * 33], s[3 * 33]); o.z = pk2(s[4 * 33], s[5 * 33]); o.w = pk2(s[6 * 33], s[7 * 33]);
        *(GAS v4u*)(WT + (size_t)(ndst + n) * ldt + k0 + 8 * c) = o; }
    LDS_WAIT(); asm volatile("" ::: "memory");
}
__device__ __forceinline__ void p0_prologue(Frame& F, const Args& A) {
    LAS float* scr = (LAS float*)(F.lds + F.wave * 16384);
    const int gw = F.vcu * NWAVES + F.wave, NGW = F.G * NWAVES;
    unsigned char* ws = F.ws;
    constexpr int I_IN = (NPROJ / 32) * 16, I_SQ = 32 * 16, I_GU = (DFF / 32) * 16, I_DN = 32 * (DFF / 64), I_C1 = 8 * 32, I_C2 = 2 * 4, I_LW = 16 * 2;
    constexpr int NITEMS = I_IN + 3 * I_SQ + 2 * I_GU + I_DN + 2 * I_C1 + 2 * I_C2 + 2 * I_LW;
    for (int it = gw; it < NITEMS; it += NGW) {
        int r = it;
        if (r < I_IN) { const int nb = r % (NPROJ / 32), kb = r / (NPROJ / 32); int nsrc, nv = 32;
            if (nb < 80) nsrc = 32 * nb; else if (nb < 88) { nsrc = 2560 + 32 * (nb - 80); nv = 48 - 32 * (nb - 80); nv = nv < 0 ? 0 : (nv > 32 ? 32 : nv); } else nsrc = 2608 + 32 * (nb - 88);
            p0_transpose_item(A.in[2], IN_DIM, 64 * kb, nsrc, nv, (bf16*)(ws + WS_WIN), DM, 32 * nb, A.in[1], scr, F.lane); continue; }
        r -= I_IN;
        if (r < 3 * I_SQ) { const int w = r / I_SQ, q = r % I_SQ, nb = q % 32, kb = q / 32;
            const float* W = w == 0 ? A.in[22] : (w == 1 ? A.in[23] : A.in[24]); bf16* WT = (bf16*)(ws + (w == 0 ? WS_WOA : (w == 1 ? WS_WOL : WS_WOUT)));
            p0_transpose_item(W, DM, 64 * kb, 32 * nb, 32, WT, DM, 32 * nb, nullptr, scr, F.lane); continue; }
        r -= 3 * I_SQ;
        if (r < 2 * I_GU) { const int w = r / I_GU, q = r % I_GU, nb = q % (DFF / 32), kb = q / (DFF / 32); const int c = 32 * nb;
            p0_transpose_item(w == 0 ? A.in[26] : A.in[27], DFF, 64 * kb, c, 32, (bf16*)(ws + WS_WGU), DM, 256 * (c / 128) + (c % 128) + 128 * w, A.in[25], scr, F.lane); continue; }
        r -= 2 * I_GU;
        if (r < I_DN) { const int nb = r % 32, kb = r / 32;
            p0_transpose_item(A.in[28], DM, 64 * kb, 32 * nb, 32, (bf16*)(ws + WS_WDN), DFF, 32 * nb, nullptr, scr, F.lane); continue; }
        r -= I_DN;
        if (r < 2 * I_C1) { const int w = r / I_C1, q = r % I_C1, nb = q % 8, kb = q / 8;
            p0_transpose_item(w == 0 ? A.in[6] : A.in[11], 256, 64 * kb, 32 * nb, 32, (bf16*)(ws + WS_CW1) + (size_t)w * 256 * 2048, 2048, 32 * nb, nullptr, scr, F.lane); continue; }
        r -= 2 * I_C1;
        if (r < 2 * I_C2) { const int w = r / I_C2, q = r % I_C2, nb = q % 2, kb = q / 2;
            p0_transpose_item(w == 0 ? A.in[8] : A.in[13], 64, 64 * kb, 32 * nb, 32, (bf16*)(ws + WS_CW2) + (size_t)w * 64 * 256, 256, 32 * nb, nullptr, scr, F.lane); continue; }
        r -= 2 * I_C2;
        { const int w = r / I_LW, q = r % I_LW, nb = q % 2, blk = q / 2;
            p0_transpose_item((w == 0 ? A.in[17] : A.in[19]) + (size_t)blk * 4096, 64, 0, 32 * nb, 32, (bf16*)(ws + WS_LW) + (size_t)(w * 16 + blk) * 4096, 64, 32 * nb, nullptr, scr, F.lane); }
    }
    const float* x = A.in[0]; bf16* XB = (bf16*)(ws + WS_XB); float* rstd = (float*)(ws + WS_RSTD1);
    for (int m = gw; m < M_ROWS; m += NGW) {
        const GAS f32x4* xr = (const GAS f32x4*)(x + (size_t)m * DM) + F.lane;
        f32x4 v[4]; float s = 0.f;
#pragma unroll
        for (int j = 0; j < 4; ++j) { v[j] = xr[64 * j]; s += (v[j].x * v[j].x + v[j].y * v[j].y) + (v[j].z * v[j].z + v[j].w * v[j].w); }
        s = wave_sum(s);
        if (F.lane == 0) rstd[m] = 1.0f / sqrtf(s * (1.f / DM) + EPS);
        GAS unsigned long long* o8 = (GAS unsigned long long*)(XB + (size_t)m * DM) + F.lane;
#pragma unroll
        for (int j = 0; j < 4; ++j) o8[64 * j] = (unsigned long long)pk2(v[j].x, v[j].y) | ((unsigned long long)pk2(v[j].z, v[j].w) << 32);
    }
}
#if USE_NAIVE
__global__ void __launch_bounds__(256) nv_knorm(unsigned char* ws, const float* kng) {
    const int idx = blockIdx.x * 256 + threadIdx.x; if (idx >= M_ROWS * 8) return;
    const int m = idx >> 3, s = (idx >> 2) & 1, g = idx & 3, set = s ? 4 : 2;
    bf16* p = (bf16*)(ws + WS_KVB) + (size_t)m * KVW + set * 256 + g * 64; const float* gw = kng + (s ? 2 : 1) * 64;
    float v[64], ss = 0.f;
    for (int d = 0; d < 64; ++d) { v[d] = bf2f(p[d]); ss += v[d] * v[d]; }
    const float r = 1.0f / sqrtf(ss * (1.f / 64) + EPS);
    for (int d = 0; d < 64; ++d) p[d] = (bf16)f2bf(v[d] * r * gw[d]);
}
__global__ void __launch_bounds__(256) nv_compress(unsigned char* ws, const float* posk, const float* w1k, const float* b1k, const float* w2k, const float* b2k,
                                                   const float* posv, const float* w1v, const float* b1v, const float* w2v, const float* b2v, const float* kng) {
    __shared__ float blk[2048]; __shared__ float hid[256]; __shared__ float red[64];
    int id = blockIdx.x; const int n = id % NCMP; id /= NCMP; const int bg = id % 16, set = id / 16; const int b = bg >> 2, g = bg & 3, tid = threadIdx.x;
    const float* pos = set ? posv : posk; const float* w1 = set ? w1v : w1k; const float* b1 = set ? b1v : b1k; const float* w2 = set ? w2v : w2k; const float* b2 = set ? b2v : b2k;
    const bf16* kv = (const bf16*)(ws + WS_KVB) + (size_t)(b * SEQ + 16 * n) * KVW + set * 256 + g * 64;
    for (int e = tid; e < 2048; e += 256) { const int l = e >> 6, d = e & 63; blk[e] = bf2f(kv[(size_t)l * KVW + d]) + pos[e]; }
    __syncthreads();
    float acc = b1[tid];
    for (int k = 0; k < 2048; ++k) acc += blk[k] * w1[(size_t)k * 256 + tid];
    hid[tid] = gelu_tanh(acc);
    __syncthreads();
    float o = 0.f;
    if (tid < 64) { o = b2[tid]; for (int f = 0; f < 256; ++f) o += hid[f] * w2[f * 64 + tid]; red[tid] = o * o; }
    __syncthreads();
    if (tid < 64) {
        if (set == 0) { float ss = 0.f; for (int d = 0; d < 64; ++d) ss += red[d]; o = o * (1.0f / sqrtf(ss * (1.f / 64) + EPS)) * kng[tid]; }
        bf16* dst = (bf16*)(ws + (set ? WS_VC : WS_KC)) + ((size_t)bg * NCP + n) * 64 + tid; *dst = (bf16)f2bf(o);
    }
}
__global__ void __launch_bounds__(64) nv_lru(unsigned char* ws, const float* convw, const float* convb, const float* wa, const float* ba, const float* wi, const float* bi, const float* lam) {
    __shared__ float xs[64];
    const int b = blockIdx.x >> 4, n = blockIdx.x & 15, tid = threadIdx.x, c = n * 64 + tid;
    float wac[64], wic[64];
    for (int k = 0; k < 64; ++k) { wac[k] = wa[(size_t)n * 4096 + k * 64 + tid]; wic[k] = wi[(size_t)n * 4096 + k * 64 + tid]; }
    const float cw0 = convw[c], cw1 = convw[1024 + c], cw2 = convw[2048 + c], cw3 = convw[3072 + c], cb = convb[c], bac = ba[c], bic = bi[c];
    const float sp = log1pf(expf(-lam[c]));
    const bf16* LX = (const bf16*)(ws + WS_LX); bf16* LG = (bf16*)(ws + WS_LGG);
    float h = 0.f, xm3 = 0.f, xm2 = 0.f, xm1 = 0.f;
    for (int t = 0; t < SEQ; ++t) {
        const size_t m = (size_t)b * SEQ + t;
        const float x0 = bf2f(LX[m * DM + c]); const float xc = cb + cw0 * xm3 + cw1 * xm2 + cw2 * xm1 + cw3 * x0; xm3 = xm2; xm2 = xm1; xm1 = x0;
        xs[tid] = xc; __syncthreads();
        float r = bac, i = bic;
#pragma unroll
        for (int k = 0; k < 64; ++k) { r += xs[k] * wac[k]; i += xs[k] * wic[k]; }
        __syncthreads();
        r = 1.f / (1.f + expf(-r)); i = 1.f / (1.f + expf(-i));
        const float la = -8.0f * r * sp, a = expf(la), bb = sqrtf(-expm1f(2.f * la)) * (i * xc);
        h = a * h + bb;
        LG[m * DM + c] = (bf16)f2bf(h * bf2f(LG[m * DM + c]));
    }
}
__global__ void __launch_bounds__(256) nv_attn(unsigned char* ws, const float* qng) {
    __shared__ float qs[4][4][64]; __shared__ float ps[4][4][1024];
    const int m = blockIdx.x, b = m / SEQ, t = m % SEQ, g = threadIdx.x >> 6, l = threadIdx.x & 63, bg = b * 4 + g;
    const bf16* QB = (const bf16*)(ws + WS_QB); const bf16* KVB = (const bf16*)(ws + WS_KVB); const bf16* NG = (const bf16*)(ws + WS_NG);
    const bf16* KC = (const bf16*)(ws + WS_KC) + (size_t)bg * NCP * 64; const bf16* VC = (const bf16*)(ws + WS_VC) + (size_t)bg * NCP * 64;
    bf16* AT = (bf16*)(ws + WS_XB);
    float slope[4];
    for (int h = 0; h < 4; ++h) {
        const float q = bf2f(QB[(size_t)m * DM + (g * 4 + h) * 64 + l]); const float ss = wave_sum(q * q);
        qs[g][h][l] = q * (1.0f / sqrtf(ss * (1.f / 64) + EPS)) * qng[l] * 0.125f;
        slope[h] = exp2f(-8.0f * (float)(g * 4 + h + 1) / 16.0f);
    }
    __syncthreads();
    float out[4] = {0.f, 0.f, 0.f, 0.f};
    const int ncnt = t >= 31 ? ((t - 31) / 16 + 1 > NCMP ? NCMP : (t - 31) / 16 + 1) : 0;
    {
        float s[4][4];
        for (int k = 0; k < 4; ++k) { const int n = l + 64 * k; float d[4] = {0.f, 0.f, 0.f, 0.f};
            if (n < ncnt) for (int e = 0; e < 64; ++e) { const float kk = bf2f(KC[n * 64 + e]); for (int h = 0; h < 4; ++h) d[h] += qs[g][h][e] * kk; }
            for (int h = 0; h < 4; ++h) s[h][k] = n < ncnt ? d[h] - slope[h] * (float)(t - (16 * n + 31)) : -1e30f; }
        for (int h = 0; h < 4; ++h) {
            float mx = fmaxf(fmaxf(s[h][0], s[h][1]), fmaxf(s[h][2], s[h][3]));
            for (int o = 1; o < 64; o <<= 1) mx = fmaxf(mx, __shfl_xor(mx, o));
            float e[4], sm = 0.f;
            for (int k = 0; k < 4; ++k) { e[k] = (l + 64 * k) < ncnt ? expf(s[h][k] - mx) : 0.f; sm += e[k]; }
            sm = wave_sum(sm); const float inv = 1.0f / fmaxf(sm, 1e-30f);
            for (int k = 0; k < 4; ++k) ps[g][h][l + 64 * k] = e[k] * inv;
        }
        __syncthreads();
        float oc[4] = {0.f, 0.f, 0.f, 0.f};
        for (int n = 0; n < ncnt; ++n) { const float v = bf2f(VC[n * 64 + l]); for (int h = 0; h < 4; ++h) oc[h] += ps[g][h][n] * v; }
        for (int h = 0; h < 4; ++h) out[h] += bf2f(NG[(size_t)m * 48 + (g * 4 + h) * 3 + 0]) * oc[h];
    }
    unsigned long long selmask;
    {
        float imp = 0.f;
        for (int n = 4 * l - 1; n <= 4 * l + 3; ++n) if (n >= 0 && n < NCMP) for (int h = 0; h < 4; ++h) imp += ps[g][h][n];
        const int cur = t >> 6; const bool valid = (64 * l <= t), forced = (l == 0 || l == cur || l == cur - 1);
        const float val = valid ? imp + (forced ? 1e4f : 0.f) : -1e30f;
        int rank = 0;
        for (int j = 0; j < 64; ++j) { const float o = __shfl(val, j); rank += (o > val || (o == val && j < l)) ? 1 : 0; }
        selmask = __ballot(rank < 16);
    }
    __syncthreads();
    {
        float mx[4] = {-1e30f, -1e30f, -1e30f, -1e30f}; int slot = 0;
        for (int j = 0; j < 64; ++j) if ((selmask >> j) & 1ull) {
            const int pos = 64 * j + l; float d[4] = {0.f, 0.f, 0.f, 0.f};
            if (pos <= t) { const bf16* kr = KVB + (size_t)(b * SEQ + pos) * KVW + 2 * 256 + g * 64;
                for (int e = 0; e < 64; ++e) { const float kk = bf2f(kr[e]); for (int h = 0; h < 4; ++h) d[h] += qs[g][h][e] * kk; } }
            for (int h = 0; h < 4; ++h) { const float s = pos <= t ? d[h] - slope[h] * (float)(t - pos) : -1e30f; ps[g][h][slot * 64 + l] = s; mx[h] = fmaxf(mx[h], s); }
            ++slot;
        }
        float inv[4];
        for (int h = 0; h < 4; ++h) {
            for (int o = 1; o < 64; o <<= 1) mx[h] = fmaxf(mx[h], __shfl_xor(mx[h], o));
            float sm = 0.f;
            for (int k = 0; k < slot; ++k) { const float s = ps[g][h][k * 64 + l]; const float e = s > -1e29f ? expf(s - mx[h]) : 0.f; ps[g][h][k * 64 + l] = e; sm += e; }
            sm = wave_sum(sm); inv[h] = 1.0f / fmaxf(sm, 1e-30f);
        }
        __syncthreads();
        float os[4] = {0.f, 0.f, 0.f, 0.f}; slot = 0;
        for (int j = 0; j < 64; ++j) if ((selmask >> j) & 1ull) {
            if (64 * j <= t) for (int i = 0; i < 64; ++i) { const int pos = 64 * j + i; if (pos > t) break;
                const float v = bf2f(KVB[(size_t)(b * SEQ + pos) * KVW + 3 * 256 + g * 64 + l]); for (int h = 0; h < 4; ++h) os[h] += ps[g][h][slot * 64 + i] * v; }
            ++slot;
        }
        for (int h = 0; h < 4; ++h) out[h] += bf2f(NG[(size_t)m * 48 + (g * 4 + h) * 3 + 1]) * os[h] * inv[h];
    }
    __syncthreads();
    {
        float mx[4] = {-1e30f, -1e30f, -1e30f, -1e30f};
        for (int k = 0; k < 8; ++k) {
            const int pos = t - 511 + 64 * k + l; float d[4] = {0.f, 0.f, 0.f, 0.f};
            if (pos >= 0) { const bf16* kr = KVB + (size_t)(b * SEQ + pos) * KVW + 4 * 256 + g * 64;
                for (int e = 0; e < 64; ++e) { const float kk = bf2f(kr[e]); for (int h = 0; h < 4; ++h) d[h] += qs[g][h][e] * kk; } }
            for (int h = 0; h < 4; ++h) { const float s = pos >= 0 ? d[h] - slope[h] * (float)(t - pos) : -1e30f; ps[g][h][k * 64 + l] = s; mx[h] = fmaxf(mx[h], s); }
        }
        float inv[4];
        for (int h = 0; h < 4; ++h) {
            for (int o = 1; o < 64; o <<= 1) mx[h] = fmaxf(mx[h], __shfl_xor(mx[h], o));
            float sm = 0.f;
            for (int k = 0; k < 8; ++k) { const float s = ps[g][h][k * 64 + l]; const float e = s > -1e29f ? expf(s - mx[h]) : 0.f; ps[g][h][k * 64 + l] = e; sm += e; }
            sm = wave_sum(sm); inv[h] = 1.0f / fmaxf(sm, 1e-30f);
        }
        __syncthreads();
        float ow[4] = {0.f, 0.f, 0.f, 0.f};
        for (int i = 0; i < 512; ++i) { const int pos = t - 511 + i; if (pos < 0) continue;
            const float v = bf2f(KVB[(size_t)(b * SEQ + pos) * KVW + 5 * 256 + g * 64 + l]); for (int h = 0; h < 4; ++h) ow[h] += ps[g][h][i] * v; }
        for (int h = 0; h < 4; ++h) out[h] += bf2f(NG[(size_t)m * 48 + (g * 4 + h) * 3 + 2]) * ow[h] * inv[h];
    }
    for (int h = 0; h < 4; ++h) AT[(size_t)m * DM + (g * 4 + h) * 64 + l] = (bf16)f2bf(out[h]);
}
#endif
typedef float f32x16 __attribute__((ext_vector_type(16)));
typedef short s16x4 __attribute__((ext_vector_type(4)));
__device__ __forceinline__ int crow(int r, int hi) { return (r & 3) + 8 * (r >> 2) + 4 * hi; }
__device__ __forceinline__ unsigned cvtpk(float lo, float hi) { unsigned r; asm volatile("v_cvt_pk_bf16_f32 %0, %1, %2" : "=v"(r) : "v"(lo), "v"(hi)); return r; }
__device__ __forceinline__ bf16x8 pack_bf8(const float* v) { v4u w; w.x = cvtpk(v[0], v[1]); w.y = cvtpk(v[2], v[3]); w.z = cvtpk(v[4], v[5]); w.w = cvtpk(v[6], v[7]); return __builtin_bit_cast(bf16x8, w); }
__device__ __forceinline__ void unpack_bf8(v4u w, float* v) { v[0] = bflo(w.x); v[1] = bfhi(w.x); v[2] = bflo(w.y); v[3] = bfhi(w.y); v[4] = bflo(w.z); v[5] = bfhi(w.z); v[6] = bflo(w.w); v[7] = bfhi(w.w); }

__device__ __forceinline__ void p2_knorm(Frame& F, const Args& A) {
    const int idx = F.vcu * 512 + F.tid;
    for (int it = idx; it < M_ROWS * 8; it += F.G * 512) {
        const int m = it >> 3, s = (it >> 2) & 1, g = it & 3, set = s ? 4 : 2;
        bf16* p = (bf16*)(F.ws + WS_KVB) + (size_t)m * KVW + set * 256 + g * 64; const float* gw = A.in[4] + (s ? 2 : 1) * 64;
        v4u w[8]; float ss = 0.f;
#pragma unroll
        for (int c = 0; c < 8; ++c) { w[c] = *(const v4u*)(p + 8 * c); float v[8]; unpack_bf8(w[c], v);
#pragma unroll
            for (int e = 0; e < 8; ++e) ss += v[e] * v[e]; }
        const float r = 1.0f / sqrtf(ss * (1.f / 64) + EPS);
#pragma unroll
        for (int c = 0; c < 8; ++c) { float v[8]; unpack_bf8(w[c], v); const f32x4 g0 = *(const f32x4*)(gw + 8 * c), g1 = *(const f32x4*)(gw + 8 * c + 4);
            v[0] *= r * g0[0]; v[1] *= r * g0[1]; v[2] *= r * g0[2]; v[3] *= r * g0[3]; v[4] *= r * g1[0]; v[5] *= r * g1[1]; v[6] *= r * g1[2]; v[7] *= r * g1[3];
            *(bf16x8*)(p + 8 * c) = pack_bf8(v); }
    }
}

constexpr int HID_LD = 264;
__device__ __forceinline__ void p2_compress(Frame& F, const Args& A, int unit) {
    const int set = unit >> 7, bg = (unit >> 3) & 15, oct = unit & 7, b = bg >> 2, g = bg & 3;
    const int lane = F.lane, w = F.wave, r32 = lane & 31, hi = lane >> 5, n0 = oct * 32;
    const bf16* kv = (const bf16*)(F.ws + WS_KVB) + (size_t)(b * SEQ + 16 * (n0 + r32)) * KVW + set * 256 + g * 64 + 8 * hi;
    const float* pos = (set ? A.in[10] : A.in[5]) + 8 * hi;
    const bf16* w1t = (const bf16*)(F.ws + WS_CW1) + ((size_t)set * 256 + w * 32 + r32) * 2048 + 8 * hi;
    f32x16 acc;
#pragma unroll
    for (int i = 0; i < 16; ++i) acc[i] = 0.f;
#pragma unroll 1
    for (int lt = 0; lt < 32; ++lt) {
#pragma unroll
        for (int kq = 0; kq < 4; ++kq) {
            const v4u a = *(const v4u*)(kv + (size_t)lt * KVW + 16 * kq);
            const f32x4 p0 = *(const f32x4*)(pos + lt * 64 + 16 * kq), p1 = *(const f32x4*)(pos + lt * 64 + 16 * kq + 4);
            float v[8]; unpack_bf8(a, v);
            v[0] += p0[0]; v[1] += p0[1]; v[2] += p0[2]; v[3] += p0[3]; v[4] += p1[0]; v[5] += p1[1]; v[6] += p1[2]; v[7] += p1[3];
            const bf16x8 bfr = *(const bf16x8*)(w1t + 64 * lt + 16 * kq);
            acc = __builtin_amdgcn_mfma_f32_32x32x16_bf16(pack_bf8(v), bfr, acc, 0, 0, 0);
        }
    }
    LAS bf16* hid = (LAS bf16*)F.lds;
    { const float b1 = (set ? A.in[12] : A.in[7])[w * 32 + r32];
#pragma unroll
      for (int r = 0; r < 16; ++r) hid[crow(r, hi) * HID_LD + w * 32 + r32] = (bf16)f2bf(gelu_tanh(acc[r] + b1)); }
    __syncthreads();
    if (w == 0) {
        const bf16* w2t = (const bf16*)(F.ws + WS_CW2) + (size_t)set * 64 * 256;
        f32x16 o[2];
#pragma unroll
        for (int mt = 0; mt < 2; ++mt)
#pragma unroll
            for (int i = 0; i < 16; ++i) o[mt][i] = 0.f;
#pragma unroll 4
        for (int ks = 0; ks < 16; ++ks) {
            const bf16x8 hb = *(const LAS bf16x8*)(hid + r32 * HID_LD + 16 * ks + 8 * hi);
#pragma unroll
            for (int mt = 0; mt < 2; ++mt) { const bf16x8 wa = *(const bf16x8*)(w2t + (size_t)(32 * mt + r32) * 256 + 16 * ks + 8 * hi);
                o[mt] = __builtin_amdgcn_mfma_f32_32x32x16_bf16(wa, hb, o[mt], 0, 0, 0); }
        }
        const float* b2 = set ? A.in[14] : A.in[9]; float ss = 0.f;
#pragma unroll
        for (int mt = 0; mt < 2; ++mt)
#pragma unroll
            for (int r = 0; r < 16; ++r) { o[mt][r] += b2[32 * mt + crow(r, hi)]; ss += o[mt][r] * o[mt][r]; }
        ss += __shfl_xor(ss, 32);
        const float rs = 1.0f / sqrtf(ss * (1.f / 64) + EPS);
        const int n = n0 + r32;
        bf16* dst = (bf16*)(F.ws + (set ? WS_VC : WS_KC)) + ((size_t)bg * NCP + n) * 64;
#pragma unroll
        for (int mt = 0; mt < 2; ++mt)
#pragma unroll
            for (int a = 0; a < 4; ++a) { float v[4];
#pragma unroll
                for (int e = 0; e < 4; ++e) { const int d = 32 * mt + 8 * a + 4 * hi + e; float x = o[mt][4 * a + e]; if (set == 0) x *= rs * A.in[4][d]; if (n >= NCMP) x = 0.f; v[e] = x; }
                v2u pk; pk.x = cvtpk(v[0], v[1]); pk.y = cvtpk(v[2], v[3]);
                *(v2u*)(dst + 32 * mt + 8 * a + 4 * hi) = pk; }
    }
}

constexpr int LRU_SEG = 128, LRU_NSEG = SEQ / LRU_SEG;
template <bool PASS2>
__device__ __forceinline__ void lru_item(Frame& F, const Args& A, int item, LAS float* cwL) {
    const int n = item & 15, seg = (item >> 4) & 31, b = item >> 9;
    const int lane = F.lane, r32 = lane & 31, hi = lane >> 5;
#pragma unroll
    for (int tap = 0; tap < 4; ++tap) cwL[tap * 64 + lane] = A.in[15][tap * 1024 + n * 64 + lane];
    cwL[256 + lane] = A.in[16][n * 64 + lane];
    const bf16* lw = (const bf16*)(F.ws + WS_LW);
    bf16x8 ID0, ID1;
    { const bool mine = (hi == ((r32 >> 3) & 1));
#pragma unroll
      for (int j = 0; j < 8; ++j) { const short one = (mine && j == (r32 & 7)) ? (short)0x3F80 : (short)0; ID0[j] = (r32 < 16) ? one : (short)0; ID1[j] = (r32 >= 16) ? one : (short)0; } }
    float L2A[2], bar_[2], bi_[2], carry[2], Aseg[2];
#pragma unroll
    for (int nt = 0; nt < 2; ++nt) { const int cj = n * 64 + 32 * nt + r32; const float lam = A.in[21][cj];
        L2A[nt] = -8.0f * log1pf(expf(-lam)) * LOG2E; bar_[nt] = A.in[18][cj]; bi_[nt] = A.in[20][cj]; carry[nt] = 0.f; Aseg[nt] = 1.f; }
    if (PASS2) {
        const float* ls = (const float*)(F.ws + WS_LSUM);
        for (int s = 0; s < seg; ++s)
#pragma unroll
            for (int nt = 0; nt < 2; ++nt) { const float2 ab = *(const float2*)(ls + ((size_t)(b * LRU_NSEG + s) * 1024 + n * 64 + 32 * nt + r32) * 2); carry[nt] = ab.x * carry[nt] + ab.y; }
    }
    LDS_WAIT();
    const bf16* LX = (const bf16*)(F.ws + WS_LX); bf16* LG = (bf16*)(F.ws + WS_LGG);
    for (int tile = 0; tile < LRU_SEG / 32; ++tile) {
        const int t0 = seg * LRU_SEG + tile * 32, t = t0 + r32;
        bf16x8 AX[4];
#pragma unroll
        for (int ks = 0; ks < 4; ++ks) {
            const int c0 = 16 * ks + 8 * hi; float xc[8];
            { const f32x4 b0 = *(const LAS f32x4*)(cwL + 256 + c0), b1 = *(const LAS f32x4*)(cwL + 256 + c0 + 4);
              xc[0] = b0[0]; xc[1] = b0[1]; xc[2] = b0[2]; xc[3] = b0[3]; xc[4] = b1[0]; xc[5] = b1[1]; xc[6] = b1[2]; xc[7] = b1[3]; }
#pragma unroll
            for (int tap = 0; tap < 4; ++tap) {
                const int tt = t - 3 + tap; v4u xw = (v4u){0u, 0u, 0u, 0u};
                if (tt >= 0) xw = *(const v4u*)(LX + (size_t)(b * SEQ + tt) * DM + n * 64 + c0);
                float xv[8]; unpack_bf8(xw, xv);
                const f32x4 w0 = *(const LAS f32x4*)(cwL + tap * 64 + c0), w1 = *(const LAS f32x4*)(cwL + tap * 64 + c0 + 4);
                xc[0] += w0[0] * xv[0]; xc[1] += w0[1] * xv[1]; xc[2] += w0[2] * xv[2]; xc[3] += w0[3] * xv[3];
                xc[4] += w1[0] * xv[4]; xc[5] += w1[1] * xv[5]; xc[6] += w1[2] * xv[6]; xc[7] += w1[3] * xv[7];
            }
            AX[ks] = pack_bf8(xc);
        }
#pragma unroll
        for (int nt = 0; nt < 2; ++nt) {
            f32x16 ar, ai, xq;
#pragma unroll
            for (int i = 0; i < 16; ++i) { ar[i] = 0.f; ai[i] = 0.f; xq[i] = 0.f; }
#pragma unroll
            for (int ks = 0; ks < 4; ++ks) {
                const bf16x8 bwr = *(const bf16x8*)(lw + ((size_t)(0 * 16 + n) * 64 + 32 * nt + r32) * 64 + 16 * ks + 8 * hi), bwi = *(const bf16x8*)(lw + ((size_t)(1 * 16 + n) * 64 + 32 * nt + r32) * 64 + 16 * ks + 8 * hi);
                ar = __builtin_amdgcn_mfma_f32_32x32x16_bf16(AX[ks], bwr, ar, 0, 0, 0); ai = __builtin_amdgcn_mfma_f32_32x32x16_bf16(AX[ks], bwi, ai, 0, 0, 0); }
            xq = __builtin_amdgcn_mfma_f32_32x32x16_bf16(AX[2 * nt], ID0, xq, 0, 0, 0);
            xq = __builtin_amdgcn_mfma_f32_32x32x16_bf16(AX[2 * nt + 1], ID1, xq, 0, 0, 0);
            float av[16], bv[16];
#pragma unroll
            for (int r = 0; r < 16; ++r) {
                const float rr = fast_sigmoid(ar[r] + bar_[nt]), ii = fast_sigmoid(ai[r] + bi_[nt]);
                const float a = __builtin_amdgcn_exp2f(rr * L2A[nt]);
                av[r] = a; bv[r] = __builtin_amdgcn_sqrtf(fmaxf(1.f - a * a, 0.f)) * (ii * xq[r]);
            }
            float Ag[4], Bg[4];
#pragma unroll
            for (int a = 0; a < 4; ++a) { Ag[a] = (av[4 * a] * av[4 * a + 1]) * (av[4 * a + 2] * av[4 * a + 3]);
                Bg[a] = ((bv[4 * a] * av[4 * a + 1] + bv[4 * a + 1]) * av[4 * a + 2] + bv[4 * a + 2]) * av[4 * a + 3] + bv[4 * a + 3]; }
            float st = carry[nt], hst[4];
#pragma unroll
            for (int a = 0; a < 4; ++a) {
                const float Ap = __shfl_xor(Ag[a], 32), Bp = __shfl_xor(Bg[a], 32);
                const float Alo = hi ? Ap : Ag[a], Blo = hi ? Bp : Bg[a], Ahi = hi ? Ag[a] : Ap, Bhi = hi ? Bg[a] : Bp;
                const float s_lo = st; st = Alo * st + Blo; const float s_hi = st; st = Ahi * st + Bhi;
                hst[a] = hi ? s_hi : s_lo; Aseg[nt] *= Alo * Ahi;
            }
            carry[nt] = st;
            if (PASS2) {
                const int cj = n * 64 + 32 * nt + r32;
#pragma unroll
                for (int a = 0; a < 4; ++a) { float h = hst[a];
#pragma unroll
                    for (int e = 0; e < 4; ++e) { const int r = 4 * a + e; h = av[r] * h + bv[r];
                        bf16* p = LG + (size_t)(b * SEQ + t0 + crow(r, hi)) * DM + cj; *p = (bf16)f2bf(h * bf2f(*p)); } }
            }
        }
    }
    if (!PASS2 && hi == 0) {
        float* ls = (float*)(F.ws + WS_LSUM);
#pragma unroll
        for (int nt = 0; nt < 2; ++nt) *(float2*)(ls + ((size_t)(b * LRU_NSEG + seg) * 1024 + n * 64 + 32 * nt + r32) * 2) = make_float2(Aseg[nt], carry[nt]);
    }
    LDS_WAIT();
}

__device__ __forceinline__ void phase2(Frame& F, const Args& A) {
    p2_knorm(F, A);
    for (int u = F.vcu; u < 256; u += F.G) { p2_compress(F, A, u); __syncthreads(); }
    LAS float* cwL = (LAS float*)(F.lds + 32768 + F.wave * 2048);
    for (int it = F.vcu * NWAVES + F.wave; it < 2048; it += F.G * NWAVES) lru_item<false>(F, A, it, cwL);
}

namespace att {
constexpr int K_OFF = 0, V_OFF = 16384, IMP_OFF = 32768, IMP_LD = 65, MSK_OFF = IMP_OFF + 4 * 64 * IMP_LD * 4, UNI_OFF = MSK_OFF + 512;
static_assert(UNI_OFF + 16 <= RING_BYTES, "attention LDS map");
constexpr float NEGBIG = -1e30f, MREF0 = -8192.f, C2 = 0.125f * LOG2E;

__device__ __forceinline__ void dma_k(LAS unsigned char* lds, int slot, const bf16* base, int pitch, int kb, int wid, int lane) {
    const bf16* kp = base + (size_t)(kb + lane) * pitch + wid * 8;
    __builtin_amdgcn_global_load_lds((const unsigned*)kp, (LAS unsigned*)(lds + K_OFF + slot * 8192 + wid * 1024), 16, 0, 0);
}
__device__ __forceinline__ void dma_v(LAS unsigned char* lds, int slot, const bf16* base, int pitch, int kb, int wid, int lane) {
    const bf16* vp = base + (size_t)(kb + 16 * (wid & 3) + (lane >> 2)) * pitch + (wid >> 2) * 32 + (lane & 3) * 8;
    __builtin_amdgcn_global_load_lds((const unsigned*)vp, (LAS unsigned*)(lds + V_OFF + slot * 8192 + wid * 1024), 16, 0, 0);
}
#define ATT_SYNC() do { asm volatile("s_waitcnt vmcnt(0) lgkmcnt(0)" ::: "memory"); __syncthreads(); } while (0)

__device__ __forceinline__ void qk_tile(const LAS unsigned char* kslot, const bf16x8* qf, float slk  , float base0, f32x16& p0, f32x16& p1, int r32, int hi) {
    const float bl = base0 + slk * (float)(4 * hi), bh = bl + slk * 32.f;
#pragma unroll
    for (int r = 0; r < 16; ++r) { const float c = (float)((r & 3) + 8 * (r >> 2)); p0[r] = __builtin_fmaf(slk, c, bl); p1[r] = __builtin_fmaf(slk, c, bh); }
    const LAS unsigned char* kp = kslot + hi * 1024 + r32 * 16;
#pragma unroll
    for (int d0 = 0; d0 < 4; ++d0) {
        const bf16x8 k0 = *(const LAS bf16x8*)(kp + d0 * 2048), k1 = *(const LAS bf16x8*)(kp + d0 * 2048 + 512);
        p0 = __builtin_amdgcn_mfma_f32_32x32x16_bf16(k0, qf[d0], p0, 0, 0, 0);
        p1 = __builtin_amdgcn_mfma_f32_32x32x16_bf16(k1, qf[d0], p1, 0, 0, 0);
    }
}
template <bool LE> __device__ __forceinline__ void mask_tile(f32x16& p0, f32x16& p1, int bound, int hi) {
    const int bb = bound - 4 * hi;
#pragma unroll
    for (int r = 0; r < 16; ++r) { const int c = (r & 3) + 8 * (r >> 2);
        if (LE) { if (c > bb) p0[r] = NEGBIG; if (c + 32 > bb) p1[r] = NEGBIG; }
        else { if (c < bb) p0[r] = NEGBIG; if (c + 32 < bb) p1[r] = NEGBIG; } }
}
__device__ __forceinline__ float row_max(const f32x16& p0, const f32x16& p1) {
    float a = fmaxf(p0[0], p1[0]);
#pragma unroll
    for (int r = 1; r < 16; ++r) a = fmaxf(a, fmaxf(p0[r], p1[r]));
    return fmaxf(a, __shfl_xor(a, 32));
}
__device__ __forceinline__ s16x4 vtr(const LAS unsigned char* p) { typedef short v4i16_t __attribute__((ext_vector_type(4))); return __builtin_bit_cast(s16x4, __builtin_amdgcn_ds_read_tr16_b64_v4i16((LAS v4i16_t*)p)); }
__device__ __forceinline__ void pv_tile(const LAS unsigned char* vslot, const f32x16& p0, const f32x16& p1, f32x16* o, int lane, int hi) {
    bf16x8 pa[4];
    { float t[8];
#pragma unroll
      for (int i = 0; i < 8; ++i) t[i] = p0[i];
      pa[0] = pack_bf8(t);
#pragma unroll
      for (int i = 0; i < 8; ++i) t[i] = p0[8 + i];
      pa[1] = pack_bf8(t);
#pragma unroll
      for (int i = 0; i < 8; ++i) t[i] = p1[i];
      pa[2] = pack_bf8(t);
#pragma unroll
      for (int i = 0; i < 8; ++i) t[i] = p1[8 + i];
      pa[3] = pack_bf8(t); }
    const LAS unsigned char* vp = vslot + ((lane >> 4) & 1) * 32 + (lane & 3) * 8 + (4 * hi + ((lane & 15) >> 2)) * 64;
#pragma unroll
    for (int d0 = 0; d0 < 2; ++d0)
#pragma unroll
        for (int ks = 0; ks < 4; ++ks) {
            const s16x4 lo = vtr(vp + d0 * 4096 + ks * 1024), hh = vtr(vp + d0 * 4096 + ks * 1024 + 512);
            const bf16x8 vf = (bf16x8){lo[0], lo[1], lo[2], lo[3], hh[0], hh[1], hh[2], hh[3]};
            o[d0] = __builtin_amdgcn_mfma_f32_32x32x16_bf16(vf, pa[ks], o[d0], 0, 0, 0);
        }
}
__device__ __forceinline__ void softmax_step(f32x16& p0, f32x16& p1, float& mref, float& l, f32x16* o, bool has_o) {
    const float rm = row_max(p0, p1);
    if (__any(rm > 0.f)) {
        const float d = fmaxf(rm, 0.f), alpha = __builtin_amdgcn_exp2f(-d); mref += d; l *= alpha;
#pragma unroll
        for (int r = 0; r < 16; ++r) { p0[r] -= d; p1[r] -= d; }
        if (has_o) {
#pragma unroll
            for (int r = 0; r < 16; ++r) { o[0][r] *= alpha; o[1][r] *= alpha; }
        }
    }
    float s = 0.f;
#pragma unroll
    for (int r = 0; r < 16; ++r) { p0[r] = __builtin_amdgcn_exp2f(p0[r]); p1[r] = __builtin_amdgcn_exp2f(p1[r]); s += p0[r] + p1[r]; }
    l += s;
}

__device__ __forceinline__ void attn_unit(Frame& F, const Args& A, int bg, int qt) {
    const int b = bg >> 2, g = bg & 3, lane = F.lane, wid = F.wave, r32 = lane & 31, hi = lane >> 5;
    const int hh = wid & 3, qh = wid >> 2, head = g * 4 + hh;
    const int t0 = qt * 64, u = 32 * qh + r32, t = t0 + u; const size_t m = (size_t)b * SEQ + t;
    LAS unsigned char* lds = F.lds;
    unsigned char* ws = F.ws;
    if (F.tid == 0) { *(LAS unsigned*)(lds + UNI_OFF) = 0u; *(LAS unsigned*)(lds + UNI_OFF + 4) = 0u; }
    bf16x8 qf[4];
    {
        const bf16* qp = (const bf16*)(ws + WS_QB) + m * DM + head * 64 + 8 * hi; const float* qng = A.in[3] + 8 * hi;
        v4u w[4]; float ss = 0.f;
#pragma unroll
        for (int ks = 0; ks < 4; ++ks) { w[ks] = *(const v4u*)(qp + 16 * ks); float v[8]; unpack_bf8(w[ks], v);
#pragma unroll
            for (int e = 0; e < 8; ++e) ss += v[e] * v[e]; }
        ss += __shfl_xor(ss, 32);
        const float rs = C2 / sqrtf(ss * (1.f / 64) + EPS);
#pragma unroll
        for (int ks = 0; ks < 4; ++ks) { float v[8]; unpack_bf8(w[ks], v);
#pragma unroll
            for (int e = 0; e < 8; ++e) v[e] *= rs * qng[16 * ks + e];
            qf[ks] = pack_bf8(v); }
    }
    const float sl2 = exp2f(-0.5f * (float)(head + 1)) * LOG2E;
    const bf16* NGp = (const bf16*)(ws + WS_NG) + m * 48 + head * 3;
    const float gate_c = bf2f(NGp[0]), gate_s = bf2f(NGp[1]), gate_w = bf2f(NGp[2]);
    f32x16 oacc[2], o[2];
#pragma unroll
    for (int r = 0; r < 16; ++r) { oacc[0][r] = 0.f; oacc[1][r] = 0.f; }
    int slot = 0;
    {
        const bf16* KCb = (const bf16*)(ws + WS_KC) + (size_t)bg * NCP * 64; const bf16* VCb = (const bf16*)(ws + WS_VC) + (size_t)bg * NCP * 64;
        const int nct = (((t0 + 32) >> 4) >> 6) + 1;
        const int nmax = (t - 31) >> 4;
        float mref = MREF0, l = 0.f;
        dma_k(lds, slot, KCb, 64, 0, wid, lane); ATT_SYNC();
        for (int kt = 0; kt < nct; ++kt) {
            if (kt + 1 < nct) dma_k(lds, slot ^ 1, KCb, 64, 64 * (kt + 1), wid, lane);
            f32x16 p0, p1;
            qk_tile(lds + K_OFF + slot * 8192, qf, sl2 * 16.f, sl2 * (float)(1024 * kt + 31 - t0) - mref, p0, p1, r32, hi);
            mask_tile<true>(p0, p1, nmax - 64 * kt, hi);
            softmax_step(p0, p1, mref, l, o, false);
            ATT_SYNC(); slot ^= 1;
        }
        l += __shfl_xor(l, 32);
        const float inv = l > 0.f ? 1.0f / l : 0.f;
#pragma unroll
        for (int r = 0; r < 16; ++r) { o[0][r] = 0.f; o[1][r] = 0.f; }
        LAS float* impw = (LAS float*)(lds + IMP_OFF) + (hh * 64 + u) * IMP_LD;
        float ecarry = 0.f;
        dma_k(lds, slot, KCb, 64, 0, wid, lane); dma_v(lds, slot, VCb, 64, 0, wid, lane); ATT_SYNC();
        for (int kt = 0; kt < nct; ++kt) {
            if (kt + 1 < nct) { dma_k(lds, slot ^ 1, KCb, 64, 64 * (kt + 1), wid, lane); dma_v(lds, slot ^ 1, VCb, 64, 64 * (kt + 1), wid, lane); }
            f32x16 p0, p1;
            qk_tile(lds + K_OFF + slot * 8192, qf, sl2 * 16.f, sl2 * (float)(1024 * kt + 31 - t0) - mref, p0, p1, r32, hi);
            mask_tile<true>(p0, p1, nmax - 64 * kt, hi);
#pragma unroll
            for (int r = 0; r < 16; ++r) { p0[r] = __builtin_amdgcn_exp2f(p0[r]) * inv; p1[r] = __builtin_amdgcn_exp2f(p1[r]) * inv; }
            float Eo[2][4];
#pragma unroll
            for (int a = 0; a < 4; ++a) { Eo[0][a] = __shfl_xor(p0[4 * a + 3], 32); Eo[1][a] = __shfl_xor(p1[4 * a + 3], 32); }
#pragma unroll
            for (int s = 0; s < 2; ++s)
#pragma unroll
                for (int a = 0; a < 4; ++a) {
                    const float G = s == 0 ? (p0[4 * a] + p0[4 * a + 1]) + (p0[4 * a + 2] + p0[4 * a + 3]) : (p1[4 * a] + p1[4 * a + 1]) + (p1[4 * a + 2] + p1[4 * a + 3]);
                    const float prev = a >= 1 ? Eo[s][a - 1] : (s == 1 ? Eo[0][3] : ecarry);
                    impw[16 * kt + 8 * s + 2 * a + hi] = G + (hi ? Eo[s][a] : prev);
                }
            ecarry = Eo[1][3];
            pv_tile(lds + V_OFF + slot * 8192, p0, p1, o, lane, hi);
            ATT_SYNC(); slot ^= 1;
        }
#pragma unroll
        for (int r = 0; r < 16; ++r) { oacc[0][r] += gate_c * o[0][r]; oacc[1][r] += gate_c * o[1][r]; }
    }
    {
        const LAS float* imp = (const LAS float*)(lds + IMP_OFF);
        unsigned long long uni = 0ull;
        for (int qq = 0; qq < 8; ++qq) {
            const int uq = 8 * wid + qq, tq = t0 + uq;
            const float v4 = (imp[(0 * 64 + uq) * IMP_LD + lane] + imp[(1 * 64 + uq) * IMP_LD + lane]) + (imp[(2 * 64 + uq) * IMP_LD + lane] + imp[(3 * 64 + uq) * IMP_LD + lane]);
            const bool valid = (64 * lane <= tq), forced = (lane == 0) || (lane == qt) || (lane == qt - 1);
            const float val = v4 + (forced ? 1e4f : 0.f);
            const unsigned key = valid ? ((__float_as_uint(val) & ~63u) | (unsigned)(63 - lane)) : 0u;
            int rank = 0;
#pragma unroll
            for (int i = 0; i < 64; ++i) rank += ((unsigned)__builtin_amdgcn_readlane((int)key, i) > key) ? 1 : 0;
            const unsigned long long msk = __ballot(valid && rank < 16);
            if (lane == 0) { *(LAS unsigned*)(lds + MSK_OFF + 8 * uq) = (unsigned)msk; *(LAS unsigned*)(lds + MSK_OFF + 8 * uq + 4) = (unsigned)(msk >> 32); }
            uni |= msk;
        }
        if (lane == 0) { __hip_atomic_fetch_or((LAS unsigned*)(lds + UNI_OFF), (unsigned)uni, __ATOMIC_RELAXED, __HIP_MEMORY_SCOPE_WORKGROUP);
                         __hip_atomic_fetch_or((LAS unsigned*)(lds + UNI_OFF + 4), (unsigned)(uni >> 32), __ATOMIC_RELAXED, __HIP_MEMORY_SCOPE_WORKGROUP); }
    }
    const bf16* KVb = (const bf16*)(ws + WS_KVB) + (size_t)b * SEQ * KVW + g * 64;
    {
        const bf16* Kb = KVb + 4 * 256; const bf16* Vb = KVb + 5 * 256;
        const int jlast = qt >= 8 ? qt - 8 : 0;
        float mref = MREF0, l = 0.f;
#pragma unroll
        for (int r = 0; r < 16; ++r) { o[0][r] = 0.f; o[1][r] = 0.f; }
        dma_k(lds, slot, Kb, KVW, 64 * qt, wid, lane); dma_v(lds, slot, Vb, KVW, 64 * qt, wid, lane); ATT_SYNC();
        for (int j = qt; j >= jlast; --j) {
            if (j > jlast) { dma_k(lds, slot ^ 1, Kb, KVW, 64 * (j - 1), wid, lane); dma_v(lds, slot ^ 1, Vb, KVW, 64 * (j - 1), wid, lane); }
            f32x16 p0, p1;
            qk_tile(lds + K_OFF + slot * 8192, qf, sl2, sl2 * (float)(64 * j - t0) - mref, p0, p1, r32, hi);
            if (j == qt) mask_tile<true>(p0, p1, u, hi);
            if (j == qt - 8) mask_tile<false>(p0, p1, u + 1, hi);
            softmax_step(p0, p1, mref, l, o, true);
            pv_tile(lds + V_OFF + slot * 8192, p0, p1, o, lane, hi);
            ATT_SYNC(); slot ^= 1;
        }
        l += __shfl_xor(l, 32);
        const float sc = l > 0.f ? gate_w / l : 0.f;
#pragma unroll
        for (int r = 0; r < 16; ++r) { oacc[0][r] += sc * o[0][r]; oacc[1][r] += sc * o[1][r]; }
    }
    {
        const bf16* Kb = KVb + 2 * 256; const bf16* Vb = KVb + 3 * 256;
        const unsigned mlo = *(const LAS unsigned*)(lds + MSK_OFF + 8 * u), mhi = *(const LAS unsigned*)(lds + MSK_OFF + 8 * u + 4);
        const unsigned long long mymask = ((unsigned long long)mhi << 32) | mlo;
        unsigned long long uni = ((unsigned long long)(unsigned)__builtin_amdgcn_readfirstlane((int)*(const LAS unsigned*)(lds + UNI_OFF + 4)) << 32) | (unsigned)__builtin_amdgcn_readfirstlane((int)*(const LAS unsigned*)(lds + UNI_OFF));
        float mref = MREF0, l = 0.f;
#pragma unroll
        for (int r = 0; r < 16; ++r) { o[0][r] = 0.f; o[1][r] = 0.f; }
        int j = 63 - __builtin_clzll(uni); uni &= ~(1ull << j);
        dma_k(lds, slot, Kb, KVW, 64 * j, wid, lane); dma_v(lds, slot, Vb, KVW, 64 * j, wid, lane); ATT_SYNC();
        for (;;) {
            int jn = -1;
            if (uni) { jn = 63 - __builtin_clzll(uni); uni &= ~(1ull << jn); dma_k(lds, slot ^ 1, Kb, KVW, 64 * jn, wid, lane); dma_v(lds, slot ^ 1, Vb, KVW, 64 * jn, wid, lane); }
            f32x16 p0, p1;
            const float selb = ((mymask >> j) & 1ull) ? 0.f : NEGBIG;
            qk_tile(lds + K_OFF + slot * 8192, qf, sl2, sl2 * (float)(64 * j - t0) - mref + selb, p0, p1, r32, hi);
            if (j == qt) mask_tile<true>(p0, p1, u, hi);
            softmax_step(p0, p1, mref, l, o, true);
            pv_tile(lds + V_OFF + slot * 8192, p0, p1, o, lane, hi);
            ATT_SYNC(); slot ^= 1;
            if (jn < 0) break;
            j = jn;
        }
        l += __shfl_xor(l, 32);
        const float sc = l > 0.f ? gate_s / l : 0.f;
#pragma unroll
        for (int r = 0; r < 16; ++r) { oacc[0][r] += sc * o[0][r]; oacc[1][r] += sc * o[1][r]; }
    }
    bf16* op = (bf16*)(ws + WS_XB) + m * DM + head * 64 + 4 * hi;
#pragma unroll
    for (int d0 = 0; d0 < 2; ++d0)
#pragma unroll
        for (int a = 0; a < 4; ++a) { v2u pk; pk.x = cvtpk(oacc[d0][4 * a], oacc[d0][4 * a + 1]); pk.y = cvtpk(oacc[d0][4 * a + 2], oacc[d0][4 * a + 3]); *(v2u*)(op + 32 * d0 + 8 * a) = pk; }
}
#undef ATT_SYNC
}

__device__ __forceinline__ void phase3(Frame& F, const Args& A) {
    LAS float* cwL = (LAS float*)(F.lds + 114688 + F.wave * 2048);
    for (int it = F.vcu * NWAVES + F.wave; it < 2048; it += F.G * NWAVES) lru_item<true>(F, A, it, cwL);
#if FAST_ATTN
    __syncthreads();
    for (int v = F.vcu; v < 256; v += F.G) {
        const int bg = v >> 4, s = v & 15;
#pragma unroll 1
        for (int i = 0; i < 4; ++i) { const int qt = (i == 0) ? s : (i == 1) ? 31 - s : (i == 2) ? 32 + s : 63 - s; att::attn_unit(F, A, bg, qt); __syncthreads(); }
    }
#endif
}
constexpr int N_PHASES = 8;

__global__ void __launch_bounds__(NWAVES * 64, 2) fwd_kernel(Args args) {
    extern __shared__ __attribute__((aligned(16))) unsigned char lds[];
    Frame F;
    F.lds = (LAS unsigned char*)lds;
    F.MISC = (volatile LAS unsigned*)(F.lds + MISC_OFF);
    F.tid = threadIdx.x; F.lane = F.tid & 63; F.wave = __builtin_amdgcn_readfirstlane(F.tid >> 6);
    F.G = gridDim.x; { const int bx = blockIdx.x; F.vcu = (F.G % 8 == 0) ? (bx % 8) * (F.G / 8) + bx / 8 : bx; }
    F.out = args.out; F.ws = args.ws; unsigned char* ws = args.ws;
    F.ctl = (gu32*)(ws + WS_CTL);
    for (int u = F.tid; u < (LDS_BYTES - LDSCTL_OFF) / 4; u += NWAVES * 64) ((LAS unsigned*)(F.lds + LDSCTL_OFF))[u] = 0u;
    __syncthreads();
    const int lo = args.ph_lo, hi = args.ph_hi;
    const bool multi = (hi - lo) > 1;
    XcdBarrier bar; bar.bar = (unsigned*)(F.ctl + CW_BAR); bar.x = 0; bar.st = nullptr;
    if (multi) bar = xcd_barrier_post((unsigned*)(F.ctl + CW_BAR), F.MISC + 8);
#ifdef ONLY
#define IN(k) ((k) == ONLY && lo <= (k) && (k) < hi)
#else
#define IN(k) (lo <= (k) && (k) < hi)
#endif
#define SEAM(k) do { if (IN(k) && IN((k) + 1)) xcd_barrier(bar); } while (0)
    using namespace pg8;
    PG8_LAS unsigned char* ring = (PG8_LAS unsigned char*)lds;

    if (IN(0)) { p0_prologue(F, args); SEAM(0); }

    if (IN(1)) {
        Gemm g{2 * DM, 128, 2 * DM, 128, DM / 64};
        SchedSimple S; S.T.init(M_ROWS, NPROJ, F.G, (int)blockIdx.x); S.A = (const char*)(ws + WS_XB); S.B = (const char*)(ws + WS_WIN); S.tA = (size_t)256 * 2 * DM; S.tB = (size_t)256 * 2 * DM;
        EpiProj E{(const float*)(ws + WS_RSTD1), (bf16_t*)(ws + WS_QB), (bf16_t*)(ws + WS_KVB), (bf16_t*)(ws + WS_NG), (bf16_t*)(ws + WS_LX), (bf16_t*)(ws + WS_LGG), (bf16_t*)F.out};
        gemm_phase<EpiProj, SchedSimple>(ring, g, S, E);
        SEAM(1);
    }
    if (IN(2)) { phase2(F, args); SEAM(2); }
    if (IN(3)) { phase3(F, args); SEAM(3); }
    if (IN(4)) {
        Gemm g{2 * DM, 128, 2 * DM, 128, DM / 64};
        SchedMerge S; S.T.init(M_ROWS, DM, F.G, (int)blockIdx.x); S.A0 = (const char*)(ws + WS_XB); S.A1 = (const char*)(ws + WS_LGG); S.B0 = (const char*)(ws + WS_WOA); S.B1 = (const char*)(ws + WS_WOL);
        S.tA = (size_t)256 * 2 * DM; S.tB = (size_t)256 * 2 * DM;
        EpiMerge E{(const bf16_t*)F.out, (f32x4*)(ws + WS_MRGF), (bf16_t*)(ws + WS_LX)};
        gemm_phase<EpiMerge, SchedMerge>(ring, g, S, E);
        SEAM(4);
    }
    if (IN(5)) {
        Gemm g{2 * DM, 128, 2 * DM, 128, DM / 64};
        SchedSimple S; S.T.init(M_ROWS, DM, F.G, (int)blockIdx.x); S.A = (const char*)(ws + WS_LX); S.B = (const char*)(ws + WS_WOUT); S.tA = (size_t)256 * 2 * DM; S.tB = (size_t)256 * 2 * DM;
        EpiWout E{args.in[0], F.out, (bf16_t*)(ws + WS_XB), (float*)(ws + WS_SSQ)};
        gemm_phase<EpiWout, SchedSimple>(ring, g, S, E);
        SEAM(5);
    }
    if (IN(6)) {
        Gemm g{2 * DM, 128, 2 * DM, 128, DM / 64};
        SchedSimple S; S.T.init(M_ROWS, NGU, F.G, (int)blockIdx.x); S.A = (const char*)(ws + WS_XB); S.B = (const char*)(ws + WS_WGU); S.tA = (size_t)256 * 2 * DM; S.tB = (size_t)256 * 2 * DM;
        EpiGU E{(const float*)(ws + WS_SSQ), (bf16_t*)(ws + WS_FF)};
        gemm_phase<EpiGU, SchedSimple>(ring, g, S, E);
        SEAM(6);
    }
    if (IN(7)) {
        Gemm g{2 * DFF, 128, 2 * DFF, 128, DFF / 64};
        SchedSimple S; S.T.init(M_ROWS, DM, F.G, (int)blockIdx.x); S.A = (const char*)(ws + WS_FF); S.B = (const char*)(ws + WS_WDN); S.tA = (size_t)256 * 2 * DFF; S.tB = (size_t)256 * 2 * DFF;
        EpiDown E{F.out};
        gemm_phase<EpiDown, SchedSimple>(ring, g, S, E);
    }
#undef IN
#undef SEAM
}

extern "C" void kernel_launch(void* const* d_in, const int* in_sizes, int n_in, void* d_out, int out_size, void* d_ws, size_t ws_size, hipStream_t stream) {
    static int grid = 0;
    if (grid == 0) {
        if (n_in != 29 || out_size != M_ROWS * DM || ws_size < WS_END) { fprintf(stderr, "kernel_launch: unexpected problem (n_in %d, out %d, ws %zu)\n", n_in, out_size, ws_size); grid = -1; return; }
        int dev = 0, cus = 0, per_cu = 0;
        if (hipGetDevice(&dev) != hipSuccess || hipDeviceGetAttribute(&cus, hipDeviceAttributeMultiprocessorCount, dev) != hipSuccess) { grid = -1; return; }
        if (hipFuncSetAttribute((const void*)fwd_kernel, hipFuncAttributeMaxDynamicSharedMemorySize, LDS_BYTES) != hipSuccess) { fprintf(stderr, "kernel_launch: hipFuncSetAttribute failed\n"); grid = -1; return; }
        if (hipOccupancyMaxActiveBlocksPerMultiprocessor(&per_cu, (const void*)fwd_kernel, NWAVES * 64, LDS_BYTES) != hipSuccess || per_cu < 1) { fprintf(stderr, "kernel_launch: occupancy query says %d blocks per CU\n", per_cu); grid = -1; return; }
        (void)hipGetLastError();
        grid = cus;
        if (grid > 256) grid = 256;
    }
    if (grid < 0) return;
    (void)hipMemsetAsync((char*)d_ws + WS_CTL, 0, CTL_ZERO_BYTES, stream);
    Args a{};
    for (int i = 0; i < 29; ++i) a.in[i] = (const float*)d_in[i];
    a.out = (float*)d_out; a.ws = (unsigned char*)d_ws;
#if N_LAUNCHES == 1
    a.ph_lo = 0; a.ph_hi = N_PHASES;
    hipLaunchKernelGGL(fwd_kernel, dim3(grid), dim3(NWAVES * 64), LDS_BYTES, stream, a);
#else
    for (int p = 0; p < N_PHASES; ++p) {
#if NAIVE_P2
        if (p == 2) {
            unsigned char* ws = (unsigned char*)d_ws;
            hipLaunchKernelGGL(nv_knorm, dim3(M_ROWS * 8 / 256), dim3(256), 0, stream, ws, a.in[4]);
            hipLaunchKernelGGL(nv_compress, dim3(2 * 16 * NCMP), dim3(256), 0, stream, ws, a.in[5], a.in[6], a.in[7], a.in[8], a.in[9], a.in[10], a.in[11], a.in[12], a.in[13], a.in[14], a.in[4]);
            hipLaunchKernelGGL(nv_lru, dim3(64), dim3(64), 0, stream, ws, a.in[15], a.in[16], a.in[17], a.in[18], a.in[19], a.in[20], a.in[21]);
            continue;
        }
#endif
#if NAIVE_ATTN
        if (p == 3) {
            hipLaunchKernelGGL(nv_attn, dim3(M_ROWS), dim3(256), 0, stream, (unsigned char*)d_ws, a.in[3]);
#if NAIVE_P2
            continue;
#endif
        }
#endif
        a.ph_lo = p; a.ph_hi = p + 1;
        hipLaunchKernelGGL(fwd_kernel, dim3(grid), dim3(NWAVES * 64), LDS_BYTES, stream, a);
    }
#endif
}
```

```cpp
#include <hip/hip_runtime.h>
#include <cstdio>
#include <cstdint>
#ifndef N_LAUNCHES
#define N_LAUNCHES 1
#endif
#define NAIVE_P2 0
#define NAIVE_ATTN 0
#define FAST_ATTN 1
#define USE_NAIVE 0
#ifndef REP_PHASE
#define REP_PHASE -1
#endif
#ifndef PROBE_ID
#define PROBE_ID 0
#endif
#ifndef GEMM_ALIGN_P1
#define GEMM_ALIGN_P1 true
#endif
#ifndef GEMM_ALIGN_P6
#define GEMM_ALIGN_P6 true
#endif
namespace pg8 {
#define PG8_LAS __attribute__((address_space(3)))
typedef unsigned short bf16_t;
typedef short bf16x8 __attribute__((ext_vector_type(8)));
typedef float f32x4 __attribute__((ext_vector_type(4)));
typedef float f32x2 __attribute__((ext_vector_type(2)));
typedef unsigned u32x4 __attribute__((ext_vector_type(4)));
typedef unsigned u32x2 __attribute__((ext_vector_type(2)));
constexpr int BM = 256, BK = 64, HALF = 128, HTB = HALF * BK * 2  , STAGE_BYTES = 8 * HTB, NXCD = 8, WGM = 8;

__host__ __device__ __forceinline__ int lds_byte(int r, int c) { const int st = (r >> 4) * 2 + (c >> 5), rr = r & 15, cc = c & 31, ob = rr * 64 + cc * 2; return st * 1024 + (ob ^ (((ob >> 9) & 1) << 5)); }
__host__ __device__ __forceinline__ void stage_rc(int b, int& R, int& C) { const int st = b / 1024, sb = b % 1024, swz = sb ^ (((sb >> 9) & 1) << 5); R = (st >> 1) * 16 + swz / 64; C = (st & 1) * 32 + (swz % 64) / 2; }
__host__ __device__ __forceinline__ int perm32(int rho) { const int n = rho >> 4, i = rho & 15; return 8 * (i >> 2) + 4 * n + (i & 3); }

struct Unit { int pm, pn, kind, r0, half; };
struct Gemm { int rowA, kstepA, rowB, kstepB, nt; };

struct TileOrder {
    int nM, nN, nwg, G, c;
    __device__ void init(int M, int N, int G_, int c_) { nM = M / BM; nN = N / BM; nwg = nM * nN; G = G_; c = c_; }
    __device__ bool tile(int i, int& pm, int& pn) const { return tileL((long)i * G + c, pm, pn); }
    __device__ bool tileL(long L, int& pm, int& pn) const {
        if (L >= nwg) return false;
        int wgid = (int)L; { const int q = nwg / NXCD, r = nwg % NXCD, xcd = wgid % NXCD, off = wgid / NXCD; wgid = (xcd < r ? xcd * (q + 1) : r * (q + 1) + (xcd - r) * q) + off; }
        const int nig = WGM * nN, gid = wgid / nig, fm = gid * WGM, gsz = (nM - fm) < WGM ? (nM - fm) : WGM;
        pm = fm + ((wgid % nig) % gsz); pn = (wgid % nig) / gsz; return true;
    }
};

__device__ __forceinline__ unsigned cvt_pk_bf16(float lo, float hi) { unsigned r; asm volatile("v_cvt_pk_bf16_f32 %0, %1, %2" : "=v"(r) : "v"(lo), "v"(hi)); return r; }

template <class Epi, class Sched, bool ALIGN_EPI = true>
__device__ __forceinline__ void gemm_phase(PG8_LAS unsigned char* lds, const Gemm g, const Sched& S, const Epi& E) {
    const int tid = threadIdx.x, wid = __builtin_amdgcn_readfirstlane(tid >> 6), lane = tid & 63, wr = wid >> 2, wc = wid & 3, fr = lane & 15, fq = lane >> 4;
    const int nt = g.nt;
    unsigned voffA[2], voffB[2];
#pragma unroll
    for (int i = 0; i < 2; ++i) { int R, C; stage_rc(tid * 16 + i * 8192, R, C); const int Rb = Epi::PERM ? ((R & ~31) + perm32(R & 31)) : R;
        voffA[i] = (unsigned)(R * g.rowA + C * 2); voffB[i] = (unsigned)(Rb * g.rowB + C * 2); }
    const size_t kstepA = (size_t)g.kstepA, kstepB = (size_t)g.kstepB;
    const size_t hstepA = (size_t)HALF * g.rowA, hstepB = (size_t)HALF * g.rowB;
    const unsigned ldsw = (unsigned)wid * 1024u;
    const int aoff = lds_byte(wr * 64 + fr, fq * 8), boff = lds_byte(wc * 32 + fr, fq * 8);
#define PG8_SA(b, h) (((b) * 2 + (h)) * HTB)
#define PG8_SB(b, h) ((4 + (b) * 2 + (h)) * HTB)
#define PG8_STAGE(bufoff, gbase, voff) do { _Pragma("unroll") for (int _i = 0; _i < 2; ++_i) \
        __builtin_amdgcn_global_load_lds((const unsigned*)((const char*)(gbase) + (voff)[_i]), (PG8_LAS unsigned*)(lds + (bufoff) + ldsw + _i * 8192), 16, 0, 0); } while (0)
#define PG8_LDA(dst, b, h) do { _Pragma("unroll") for (int m = 0; m < 4; ++m) _Pragma("unroll") for (int k = 0; k < 2; ++k) dst[m][k] = *(const PG8_LAS bf16x8*)(lds + PG8_SA(b, h) + aoff + m * 2048 + k * 1024); } while (0)
#define PG8_LDB(dst, b, h) do { _Pragma("unroll") for (int n = 0; n < 2; ++n) _Pragma("unroll") for (int k = 0; k < 2; ++k) dst[n][k] = *(const PG8_LAS bf16x8*)(lds + PG8_SB(b, h) + boff + n * 2048 + k * 1024); } while (0)
#define PG8_MMA(ai, bj, At, Bt) do { __builtin_amdgcn_s_setprio(1); _Pragma("unroll") for (int m = 0; m < 4; ++m) _Pragma("unroll") for (int n = 0; n < 2; ++n) _Pragma("unroll") for (int k = 0; k < 2; ++k) \
        acc[ai][bj][m][n] = __builtin_amdgcn_mfma_f32_16x16x32_bf16(Bt[n][k], At[m][k], acc[ai][bj][m][n], 0, 0, 0); __builtin_amdgcn_s_setprio(0); } while (0)
#define PG8_WAIT_V(n) asm volatile("s_waitcnt vmcnt(" #n ")" ::: "memory")
#define PG8_WAIT_L(n) asm volatile("s_waitcnt lgkmcnt(" #n ")" ::: "memory")
#define PG8_BAR __builtin_amdgcn_s_barrier()
#define PG8_SCHED __builtin_amdgcn_sched_barrier(0)
    Unit cur, nxt; int ui = 0;
    if (!S.next(0, cur)) return;
    f32x4 acc[2][2][4][2];
#pragma unroll
    for (int a = 0; a < 2; ++a)
#pragma unroll
        for (int b = 0; b < 2; ++b)
#pragma unroll
            for (int m = 0; m < 4; ++m)
#pragma unroll
                for (int n = 0; n < 2; ++n) acc[a][b][m][n] = (f32x4){0.f, 0.f, 0.f, 0.f};
    bf16x8 At[4][2], B0[2][2], B1[2][2];
    const char* cA = S.abase(cur); const char* cB = S.bbase(cur);
    PG8_STAGE(PG8_SB(0, 0), cB, voffB); PG8_STAGE(PG8_SB(0, 1), cB + hstepB, voffB); PG8_STAGE(PG8_SA(0, 0), cA, voffA); PG8_STAGE(PG8_SA(0, 1), cA + hstepA, voffA);
    if (wr == 1) PG8_BAR;
    PG8_WAIT_V(2); PG8_BAR;
    PG8_STAGE(PG8_SB(1, 0), cB + kstepB, voffB); PG8_STAGE(PG8_SA(1, 0), cA + kstepA, voffA); PG8_STAGE(PG8_SB(1, 1), cB + hstepB + kstepB, voffB);
    PG8_WAIT_V(6); PG8_BAR;
    for (;;) {
        const bool has_next = S.next(ui + 1, nxt);
        const char* nA = has_next ? S.abase(nxt) : cA; const char* nB = has_next ? S.bbase(nxt) : cB;
        asm volatile(".p2align 8\n\ts_nop 0\n\ts_nop 0\n\ts_nop 0\n\ts_nop 0\n\ts_nop 0\n\ts_nop 0");
        for (int t = 0; t < nt; t += 2) {
            const bool last = (t == nt - 2);
            const char* a1 = cA + (size_t)(t + 1) * kstepA;
            const char* a2 = last ? nA : cA + (size_t)(t + 2) * kstepA; const char* b2 = last ? nB : cB + (size_t)(t + 2) * kstepB;
            const char* a3 = a2 + kstepA; const char* b3 = b2 + kstepB;
            PG8_LDB(B0, 0, 0); PG8_LDB(B1, 0, 1); PG8_SCHED; PG8_LDA(At, 0, 0); PG8_STAGE(PG8_SA(1, 1), a1 + hstepA, voffA);
            PG8_WAIT_V(8); PG8_WAIT_L(0); PG8_BAR; PG8_MMA(0, 0, At, B0); PG8_MMA(0, 1, At, B1); PG8_BAR; PG8_SCHED;
            PG8_LDA(At, 0, 1); PG8_STAGE(PG8_SB(0, 0), b2, voffB); PG8_STAGE(PG8_SB(0, 1), b2 + hstepB, voffB); PG8_STAGE(PG8_SA(0, 0), a2, voffA);
            PG8_WAIT_V(8); PG8_WAIT_L(0); PG8_BAR; if (!cur.half) { PG8_MMA(1, 0, At, B0); PG8_MMA(1, 1, At, B1); } PG8_BAR; PG8_SCHED;
            PG8_LDB(B0, 1, 0); PG8_LDB(B1, 1, 1); PG8_SCHED; PG8_LDA(At, 1, 0); PG8_STAGE(PG8_SA(0, 1), a2 + hstepA, voffA);
            PG8_WAIT_V(8); PG8_WAIT_L(0); PG8_BAR; PG8_MMA(0, 0, At, B0); PG8_MMA(0, 1, At, B1); PG8_BAR; PG8_SCHED;
            PG8_LDA(At, 1, 1); PG8_STAGE(PG8_SB(1, 0), b3, voffB); PG8_STAGE(PG8_SB(1, 1), b3 + hstepB, voffB); PG8_STAGE(PG8_SA(1, 0), a3, voffA);
            PG8_WAIT_V(8); PG8_WAIT_L(0); PG8_BAR; if (!cur.half) { PG8_MMA(1, 0, At, B0); PG8_MMA(1, 1, At, B1); } PG8_BAR; PG8_SCHED;
        }
        if constexpr (ALIGN_EPI) { if (wr == 0) PG8_BAR; }
        const bool keep = E(acc, cur, wr, wc, fr, fq);
        if (!has_next) break;
        if (!keep) {
#pragma unroll
        for (int a = 0; a < 2; ++a)
#pragma unroll
            for (int b = 0; b < 2; ++b)
#pragma unroll
                for (int m = 0; m < 4; ++m)
#pragma unroll
                    for (int n = 0; n < 2; ++n) acc[a][b][m][n] = (f32x4){0.f, 0.f, 0.f, 0.f};
        }
        cur = nxt; cA = nA; cB = nB; ++ui;
        if constexpr (ALIGN_EPI) { if (wr == 1) PG8_BAR; }
    }
    PG8_WAIT_V(0);
    if constexpr (!ALIGN_EPI) { if (wr == 0) PG8_BAR; }
    PG8_BAR;
#undef PG8_SA
#undef PG8_SB
#undef PG8_STAGE
#undef PG8_LDA
#undef PG8_LDB
#undef PG8_MMA
#undef PG8_WAIT_V
#undef PG8_WAIT_L
#undef PG8_BAR
#undef PG8_SCHED
}
}
constexpr int BATCH = 4, SEQ = 4096, DM = 1024, M_ROWS = BATCH * SEQ;
constexpr int NH = 16, HD = 64, NKV = 4, HPG = 4, KVW = 1536;
constexpr int IN_DIM = 6704, NPROJ = 6912;
constexpr int DFF = 2816, NGU = 2 * DFF;
constexpr int NCMP = 255, NCP = 256;
constexpr float EPS = 1e-6f;
constexpr float LOG2E = 1.4426950408889634f;

__device__ __forceinline__ float fast_sigmoid(float x) { return __builtin_amdgcn_rcpf(1.f + __builtin_amdgcn_exp2f(-LOG2E * x)); }
__device__ __forceinline__ float gelu_tanh(float x) { return x * fast_sigmoid(x * (1.5957691216f + 0.0713548163f * x * x)); }

namespace pg8 {
struct SchedSimple {
    TileOrder T; const char* A; const char* B; size_t tA, tB;
    __device__ __forceinline__ bool next(int i, Unit& u) const { u.kind = 0; u.half = 0; const bool ok = T.tile(i, u.pm, u.pn); u.r0 = u.pm * BM; return ok; }
    __device__ __forceinline__ const char* abase(const Unit& u) const { return A + (size_t)u.pm * tA; }
    __device__ __forceinline__ const char* bbase(const Unit& u) const { return B + (size_t)u.pn * tB; }
};
struct SchedHalfTail {
    TileOrder T; const char* A; const char* B; size_t tA, tB; int full;
    __device__ __forceinline__ bool next(int i, Unit& u) const {
        u.kind = 0;
        if (i < full) { u.half = 0; const bool ok = T.tile(i, u.pm, u.pn); u.r0 = u.pm * BM; return ok; }
        if (i > full) return false;
        const int idx = T.c >> 3, lab = T.c & 7;
        const bool ok = T.tileL((long)full * T.G + 8 * (idx >> 1) + lab, u.pm, u.pn); u.half = 1; u.r0 = u.pm * BM + (idx & 1) * HALF; return ok;
    }
    __device__ __forceinline__ const char* abase(const Unit& u) const { return A + (size_t)u.r0 * (tA / BM); }
    __device__ __forceinline__ const char* bbase(const Unit& u) const { return B + (size_t)u.pn * tB; }
};
struct SchedMerge {
    TileOrder T; const char* A0; const char* A1; const char* B0; const char* B1; size_t tA, tB;
    __device__ __forceinline__ bool next(int i, Unit& u) const { u.kind = i & 1; u.half = 0; const bool ok = T.tile(i >> 1, u.pm, u.pn); u.r0 = u.pm * BM; return ok; }
    __device__ __forceinline__ const char* abase(const Unit& u) const { return (u.kind ? A1 : A0) + (size_t)u.pm * tA; }
    __device__ __forceinline__ const char* bbase(const Unit& u) const { return (u.kind ? B1 : B0) + (size_t)u.pn * tB; }
};

typedef f32x4 Acc[2][2][4][2];
#define EPI_ROW(ai, m) (u.r0 + (ai) * HALF + wr * 64 + (m) * 16 + fr)
#define EPI_CT(bj) ((bj) * HALF + wc * 32 + 8 * fq)

__device__ __forceinline__ u32x4 pack8(f32x4 a, f32x4 b) { u32x4 w; w.x = cvt_pk_bf16(a[0], a[1]); w.y = cvt_pk_bf16(a[2], a[3]); w.z = cvt_pk_bf16(b[0], b[1]); w.w = cvt_pk_bf16(b[2], b[3]); return w; }

struct EpiProj {
    static constexpr bool PERM = true;
    const float* rstd; bf16_t *QB, *KVB, *NG, *LX, *LGG, *MG;
    __device__ __forceinline__ bool operator()(Acc& acc, const Unit& u, int wr, int wc, int fr, int fq) const {
        const int pn = u.pn; bf16_t* dst; int ld, c0, act = 0, lim = 256;
        if (pn < 4) { dst = QB; ld = DM; c0 = pn * 256; }
        else if (pn < 10) { dst = KVB; ld = KVW; c0 = (pn - 4) * 256; }
        else if (pn == 10) { dst = NG; ld = 48; c0 = 0; act = 1; lim = 48; }
        else if (pn < 15) { dst = LX; ld = DM; c0 = (pn - 11) * 256; act = 3; }
        else if (pn < 19) { dst = LGG; ld = DM; c0 = (pn - 15) * 256; act = 2; }
        else {
            bf16_t* MGp = MG + (pn - 19) * 128;
#pragma unroll
            for (int ai = 0; ai < 2; ++ai)
#pragma unroll
                for (int m = 0; m < 4; ++m) {
                    const int row = EPI_ROW(ai, m); const float rs = rstd[row];
                    f32x4 a0 = acc[ai][0][m][0] * rs, a1 = acc[ai][0][m][1] * rs, b0 = acc[ai][1][m][0] * rs, b1 = acc[ai][1][m][1] * rs;
#pragma unroll
                    for (int e = 0; e < 4; ++e) { a0[e] = fast_sigmoid(a0[e]); a1[e] = fast_sigmoid(a1[e]); b0[e] = fast_sigmoid(b0[e]); b1[e] = fast_sigmoid(b1[e]); }
                    const u32x4 w1 = pack8(b0, b1);
                    b0[0] = __uint_as_float(w1.x << 16); b0[1] = __uint_as_float(w1.x & 0xffff0000u); b0[2] = __uint_as_float(w1.y << 16); b0[3] = __uint_as_float(w1.y & 0xffff0000u);
                    b1[0] = __uint_as_float(w1.z << 16); b1[1] = __uint_as_float(w1.z & 0xffff0000u); b1[2] = __uint_as_float(w1.w << 16); b1[3] = __uint_as_float(w1.w & 0xffff0000u);
#pragma unroll
                    for (int e = 0; e < 4; ++e) { a0[e] *= __builtin_amdgcn_rcpf(fmaxf(b0[e], 8.6736174e-19f)); a1[e] *= __builtin_amdgcn_rcpf(fmaxf(b1[e], 8.6736174e-19f)); }
                    bf16_t* q = MGp + (size_t)row * (2 * DM) + wc * 32 + 8 * fq;
                    *(u32x4*)q = pack8(a0, a1); *(u32x4*)(q + DM) = w1;
                }
            return false;
        }
#pragma unroll
        for (int ai = 0; ai < 2; ++ai)
#pragma unroll
            for (int m = 0; m < 4; ++m) {
                const int row = EPI_ROW(ai, m); const float rs = rstd[row];
#pragma unroll
                for (int bj = 0; bj < 2; ++bj) {
                    const int ct = EPI_CT(bj);
                    f32x4 v0 = acc[ai][bj][m][0] * rs, v1 = acc[ai][bj][m][1] * rs;
                    if (act == 1) {
#pragma unroll
                        for (int e = 0; e < 4; ++e) { v0[e] = fast_sigmoid(v0[e]); v1[e] = fast_sigmoid(v1[e]); }
                    } else if (act == 2) {
#pragma unroll
                        for (int e = 0; e < 4; ++e) { v0[e] = gelu_tanh(v0[e]); v1[e] = gelu_tanh(v1[e]); }
                    }
                    u32x4 pk;
                    if (act == 3) { pk.x = __builtin_bit_cast(unsigned, __builtin_amdgcn_cvt_pkrtz(v0[0], v0[1])); pk.y = __builtin_bit_cast(unsigned, __builtin_amdgcn_cvt_pkrtz(v0[2], v0[3]));
                                    pk.z = __builtin_bit_cast(unsigned, __builtin_amdgcn_cvt_pkrtz(v1[0], v1[1])); pk.w = __builtin_bit_cast(unsigned, __builtin_amdgcn_cvt_pkrtz(v1[2], v1[3])); }
                    else pk = pack8(v0, v1);
                    if (ct + 8 <= lim) *(u32x4*)(dst + (size_t)row * ld + c0 + ct) = pk;
                }
            }
        return false;
    }
};

struct EpiMerge {
    static constexpr bool PERM = true;
    const bf16_t* MG; bf16_t* MRG;
    __device__ __forceinline__ bool operator()(Acc& acc, const Unit& u, int wr, int wc, int fr, int fq) const {
        const bf16_t* MGp = MG; bf16_t* MRGp = MRG;
        asm volatile("" : "+s"(MGp), "+s"(MRGp));
#pragma unroll
        for (int ai = 0; ai < 2; ++ai)
#pragma unroll
            for (int m = 0; m < 4; ++m) {
                const int row = EPI_ROW(ai, m);
#pragma unroll
                for (int bj = 0; bj < 2; ++bj) {
                    const int col = u.pn * BM + EPI_CT(bj);
                    if (u.kind == 0) {
                        const u32x4 w0 = *(const u32x4*)(MGp + (size_t)row * (2 * DM) + col);
                        f32x4 a0, a1;
                        a0[0] = __uint_as_float(w0.x << 16); a0[1] = __uint_as_float(w0.x & 0xffff0000u); a0[2] = __uint_as_float(w0.y << 16); a0[3] = __uint_as_float(w0.y & 0xffff0000u);
                        a1[0] = __uint_as_float(w0.z << 16); a1[1] = __uint_as_float(w0.z & 0xffff0000u); a1[2] = __uint_as_float(w0.w << 16); a1[3] = __uint_as_float(w0.w & 0xffff0000u);
                        acc[ai][bj][m][0] *= a0; acc[ai][bj][m][1] *= a1;
                    } else {
                        const u32x4 w1 = *(const u32x4*)(MGp + (size_t)row * (2 * DM) + DM + col);
                        f32x4 b0, b1;
                        b0[0] = __uint_as_float(w1.x << 16); b0[1] = __uint_as_float(w1.x & 0xffff0000u); b0[2] = __uint_as_float(w1.y << 16); b0[3] = __uint_as_float(w1.y & 0xffff0000u);
                        b1[0] = __uint_as_float(w1.z << 16); b1[1] = __uint_as_float(w1.z & 0xffff0000u); b1[2] = __uint_as_float(w1.w << 16); b1[3] = __uint_as_float(w1.w & 0xffff0000u);
#pragma unroll
                        for (int e = 0; e < 4; ++e) { b0[e] = fmaxf(b0[e], 8.6736174e-19f); b1[e] = fmaxf(b1[e], 8.6736174e-19f); }
                        *(u32x4*)(MRGp + (size_t)row * DM + col) = pack8(acc[ai][bj][m][0] * b0, acc[ai][bj][m][1] * b1);
                    }
                }
                asm volatile("" ::: "memory");
            }
        return u.kind == 0;
    }
};

struct EpiWout {
    static constexpr bool PERM = true;
    const float* x; float* out; bf16_t* X1B; float* ssq;
    __device__ __forceinline__ bool operator()(Acc& acc, const Unit& u, int wr, int wc, int fr, int fq) const {
#pragma unroll
        for (int ai = 0; ai < 2; ++ai)
#pragma unroll
            for (int m = 0; m < 4; ++m) {
                const int row = EPI_ROW(ai, m); float s = 0.f;
#pragma unroll
                for (int bj = 0; bj < 2; ++bj) {
                    const int col = u.pn * BM + EPI_CT(bj); const size_t off = (size_t)row * DM + col;
                    const f32x4 v0 = *(const f32x4*)(x + off) + acc[ai][bj][m][0], v1 = *(const f32x4*)(x + off + 4) + acc[ai][bj][m][1];
                    *(u32x4*)(X1B + off) = pack8(v0, v1);
                    s += (v0[0] * v0[0] + v0[1] * v0[1]) + (v0[2] * v0[2] + v0[3] * v0[3]) + (v1[0] * v1[0] + v1[1] * v1[1]) + (v1[2] * v1[2] + v1[3] * v1[3]);
                }
                s += __shfl_xor(s, 16); s += __shfl_xor(s, 32);
                if (fq == 0) ssq[(size_t)row * 16 + u.pn * 4 + wc] = s;
            }
        return false;
    }
};

struct EpiGU {
    static constexpr bool PERM = true;
    const float* ssq; bf16_t* FF;
    __device__ __forceinline__ bool operator()(Acc& acc, const Unit& u, int wr, int wc, int fr, int fq) const {
#pragma unroll
        for (int ai = 0; ai < 2; ++ai)
            if (ai == 0 || !u.half)
#pragma unroll
            for (int m = 0; m < 4; ++m) {
                const int row = EPI_ROW(ai, m);
                const f32x4* sp = (const f32x4*)(ssq + (size_t)row * 16);
                const f32x4 s0 = sp[0], s1 = sp[1], s2 = sp[2], s3 = sp[3];
                const float tot = ((s0[0] + s0[1]) + (s0[2] + s0[3])) + ((s1[0] + s1[1]) + (s1[2] + s1[3])) + ((s2[0] + s2[1]) + (s2[2] + s2[3])) + ((s3[0] + s3[1]) + (s3[2] + s3[3]));
                const float rs = __builtin_amdgcn_rsqf(tot * (1.f / DM) + EPS);
                f32x4 o[2];
#pragma unroll
                for (int n = 0; n < 2; ++n)
#pragma unroll
                    for (int e = 0; e < 4; ++e) { const float g = acc[ai][0][m][n][e] * rs, up = acc[ai][1][m][n][e] * rs; o[n][e] = g * fast_sigmoid(g) * up; }
                *(u32x4*)(FF + (size_t)row * DFF + u.pn * HALF + wc * 32 + 8 * fq) = pack8(o[0], o[1]);
            }
        return false;
    }
};

struct EpiDown {
    static constexpr bool PERM = true;
    float* out; const bf16_t* X1B;
    __device__ __forceinline__ bool operator()(Acc& acc, const Unit& u, int wr, int wc, int fr, int fq) const {
#pragma unroll
        for (int ai = 0; ai < 2; ++ai)
#pragma unroll
            for (int m = 0; m < 4; ++m) {
                const int row = EPI_ROW(ai, m);
#pragma unroll
                for (int bj = 0; bj < 2; ++bj) {
                    const size_t off = (size_t)row * DM + u.pn * BM + EPI_CT(bj);
                    const u32x4 xw = *(const u32x4*)(X1B + off);
                    f32x4 x0, x1;
                    x0[0] = __uint_as_float(xw.x << 16); x0[1] = __uint_as_float(xw.x & 0xffff0000u); x0[2] = __uint_as_float(xw.y << 16); x0[3] = __uint_as_float(xw.y & 0xffff0000u);
                    x1[0] = __uint_as_float(xw.z << 16); x1[1] = __uint_as_float(xw.z & 0xffff0000u); x1[2] = __uint_as_float(xw.w << 16); x1[3] = __uint_as_float(xw.w & 0xffff0000u);
                    *(f32x4*)(out + off) = x0 + acc[ai][bj][m][0]; *(f32x4*)(out + off + 4) = x1 + acc[ai][bj][m][1];
                }
            }
        return false;
    }
};
#undef EPI_ROW
#undef EPI_CT
}
constexpr size_t MiB = 1u << 20;
constexpr size_t WS_CTL = 0, CTL_ZERO_BYTES = 1 * MiB;
constexpr size_t WS_NG = 1 * MiB;
constexpr size_t WS_RSTD1 = 3 * MiB;
constexpr size_t WS_SSQ = 4 * MiB;
constexpr size_t WS_KC = 5 * MiB;
constexpr size_t WS_VC = 5 * MiB + 512 * 1024;
constexpr size_t WS_LSUM = 6 * MiB;
constexpr size_t WS_CW2 = 7 * MiB;
constexpr size_t WS_LW = 7 * MiB + 256 * 1024;
constexpr size_t WS_HID = 8 * MiB;
constexpr size_t WS_CW1 = 12 * MiB;
constexpr size_t WS_WOA = 14 * MiB, WS_WOL = 16 * MiB, WS_WOUT = 18 * MiB;
constexpr size_t WS_WDN = 20 * MiB;
constexpr size_t WS_WGU = 26 * MiB;
constexpr size_t WS_WIN = 37 * MiB;
constexpr size_t WS_XB = 51 * MiB;
constexpr size_t WS_HL = 51 * MiB;
constexpr size_t WS_PC0 = 227 * MiB;
constexpr size_t WS_PC3 = 37 * MiB;
constexpr size_t WS_QB = 83 * MiB;
constexpr size_t WS_KVB = 115 * MiB;
constexpr size_t WS_LX = 163 * MiB;
constexpr size_t WS_LGG = 195 * MiB;
constexpr size_t WS_MRGF = 83 * MiB;
constexpr size_t WS_FF = 83 * MiB;
constexpr size_t WS_END = 251 * MiB;

constexpr int CW_BAR = 4096;
constexpr int CW_QUEUE = 16384;

constexpr int RING_BYTES = 131072;
constexpr int LDSCTL_OFF = RING_BYTES, MISC_OFF = LDSCTL_OFF + 320;
constexpr int LDS_BYTES = 147456;
constexpr int NWAVES = 8;

#define GAS __attribute__((address_space(1)))
#define LAS __attribute__((address_space(3)))
typedef unsigned short bf16;
typedef unsigned v4u __attribute__((ext_vector_type(4)));
typedef unsigned v2u __attribute__((ext_vector_type(2)));
typedef float f32x4 __attribute__((ext_vector_type(4)));
typedef short bf16x8 __attribute__((ext_vector_type(8)));
typedef GAS unsigned gu32;
#define RLX_AGENT __ATOMIC_RELAXED, __HIP_MEMORY_SCOPE_AGENT
#define LDS_WAIT() asm volatile("s_waitcnt lgkmcnt(0)" ::: "memory")
#define VM_WAIT() asm volatile("s_waitcnt vmcnt(0)" ::: "memory")
__device__ __forceinline__ unsigned f2bf(float f) { unsigned u = __builtin_bit_cast(unsigned, f); return (u + 0x7fffu + ((u >> 16) & 1u)) >> 16; }
__device__ __forceinline__ unsigned pk2(float lo, float hi) { return f2bf(lo) | (f2bf(hi) << 16); }
__device__ __forceinline__ float bf2f(unsigned short h) { return __uint_as_float((unsigned)h << 16); }
__device__ __forceinline__ float bflo(unsigned w) { return __uint_as_float(w << 16); }
__device__ __forceinline__ float bfhi(unsigned w) { return __uint_as_float(w & 0xffff0000u); }

#define XB_TMO      128
#define XB_XCNT(j)  (256  + 64 * (j))
#define XB_XSUB(j)  (1280 + 64 * (j))
#define XB_XGEN(j)  (2304 + 64 * (j))
#define XB_TOP      3328
#define XB_TOPGEN   3392
#define XCD_BAR_WORDS 3456
#define XB_SPIN_CAP (1u << 20)
__device__ __forceinline__ unsigned xb_ld(unsigned* p)              { return __hip_atomic_load(p, __ATOMIC_RELAXED, __HIP_MEMORY_SCOPE_AGENT); }
__device__ __forceinline__ unsigned xb_add(unsigned* p, unsigned v) { return __hip_atomic_fetch_add(p, v, __ATOMIC_RELAXED, __HIP_MEMORY_SCOPE_AGENT); }
__device__ __forceinline__ unsigned xb_xcc_id() { return (unsigned)__builtin_amdgcn_s_getreg((3 << 11) | 20) & 0xFu; }
#define XB_SPIN(cond, bar) do { unsigned _sp = 0; while (cond) { __builtin_amdgcn_s_sleep(1); \
    if ((++_sp & 255u) == 0u) { if (xb_ld(&(bar)[XB_TMO])) break; if (_sp > XB_SPIN_CAP) { atomicAdd(&(bar)[XB_TMO], 1u); break; } } } } while (0)
struct XcdBarrier { unsigned* bar; unsigned x; volatile LAS unsigned* st; };
__device__ __forceinline__ XcdBarrier xcd_barrier_post(unsigned* bar, volatile LAS unsigned* st) {
    XcdBarrier b; b.bar = bar; b.x = xb_xcc_id(); b.st = st;
    if (threadIdx.x == 0) (void)xb_add(&bar[XB_XCNT(b.x)], 1u);
    return b;
}
__device__ __forceinline__ void xcd_barrier_complete(unsigned* bar, unsigned x, unsigned& nloc, unsigned& nx) {
    const unsigned G = gridDim.x * gridDim.y * gridDim.z;
    unsigned sum, cnt, mine, sp = 0u;
    for (;;) {
        sum = 0u; cnt = 0u; mine = 0u;
#pragma unroll
        for (unsigned j = 0; j < 16; ++j) { const unsigned c = xb_ld(&bar[XB_XCNT(j)]); sum += c; cnt += (c > 0u) ? 1u : 0u; mine = (j == x) ? c : mine; }
        if (sum == G) break;
        __builtin_amdgcn_s_sleep(1);
        if ((++sp & 255u) == 0u) { if (xb_ld(&bar[XB_TMO])) break; if (sp > XB_SPIN_CAP) { atomicAdd(&bar[XB_TMO], 1u); break; } }
    }
    nloc = mine > 0u ? mine : 1u; nx = cnt > 0u ? cnt : 1u;
}
__device__ __forceinline__ void xcd_barrier(const XcdBarrier& b) {
    asm volatile("s_waitcnt vmcnt(0)" ::: "memory");
    __syncthreads();
    if (threadIdx.x == 0) {
        unsigned* bar = b.bar;
        __builtin_amdgcn_s_waitcnt(0);
        unsigned nloc = b.st[0], nx = b.st[1];
        if (nloc == 0u) { xcd_barrier_complete(bar, b.x, nloc, nx); b.st[0] = nloc; b.st[1] = nx; }
        const unsigned old = xb_add(&bar[XB_XSUB(b.x)], 1u);
        const unsigned gen = old / nloc;
        if (old + 1u == (gen + 1u) * nloc) {
            __builtin_amdgcn_fence(__ATOMIC_RELEASE, "agent");
            asm volatile("s_waitcnt vmcnt(0)" ::: "memory");
            const unsigned og = xb_add(&bar[XB_TOP], 1u);
            const unsigned tg = og / nx;
            if (og + 1u == (tg + 1u) * nx) xb_add(&bar[XB_TOPGEN], 1u);
            else XB_SPIN(xb_ld(&bar[XB_TOPGEN]) == tg, bar);
            __builtin_amdgcn_fence(__ATOMIC_ACQUIRE, "agent");
            xb_add(&bar[XB_XGEN(b.x)], 1u);
            asm volatile("s_waitcnt vmcnt(0)" ::: "memory");
        } else {
            XB_SPIN(xb_ld(&bar[XB_XGEN(b.x)]) == gen, bar);
            __builtin_amdgcn_fence(__ATOMIC_ACQUIRE, "agent");
            asm volatile("s_waitcnt vmcnt(0)" ::: "memory");
        }
    }
    __syncthreads();
}

struct Frame {
    LAS unsigned char* lds;
    volatile LAS unsigned* MISC;
    gu32* ctl;
    int tid, lane, wave, vcu, G, grp;
    float* out; unsigned char* ws;
};
struct Args { const float* in[29]; float* out; unsigned char* ws; int ph_lo, ph_hi; };
__device__ __forceinline__ float wave_sum(float v) {
#pragma unroll
    for (int o = 1; o < 64; o <<= 1) v += __shfl_xor(v, o);
    return v;
}

struct ConvItem { const float* W; const float* gk; bf16* WT; int ldw, k0, nsrc, nvalid, ldt, ndst, fragmajor; };
constexpr int I_IN = (NPROJ / 32) * 16, I_SQ = 32 * 16, I_GU = (DFF / 32) * 16, I_DN = 32 * (DFF / 64), I_C1 = 8 * 32, I_C2 = 2 * 4, I_LW = 16 * 2;
constexpr int I_EARLY = I_IN + 2 * I_C1 + 2 * I_C2 + 2 * I_LW + I_GU, I_LATE = I_GU + 3 * I_SQ + I_DN;
__device__ __forceinline__ ConvItem p0_item(const Args& A, unsigned char* ws, int r) {
    ConvItem d; d.gk = nullptr; d.nvalid = 32; d.fragmajor = 0;
    if (r < I_IN) { const int nb = r % (NPROJ / 32), kb = r / (NPROJ / 32); int nsrc, nv = 32;
        if (nb < 80) nsrc = 32 * nb; else if (nb < 88) { nsrc = 2560 + 32 * (nb - 80); nv = 48 - 32 * (nb - 80); nv = nv < 0 ? 0 : (nv > 32 ? 32 : nv); } else if (nb < 152) nsrc = 2608 + 32 * (nb - 88);
        else { const int dc = 32 * (nb - 152), j = dc >> 8, w = dc & 255; nsrc = 2608 + 2048 + (w >> 7) * 1024 + 128 * j + (w & 127); }
        d.W = A.in[2]; d.ldw = IN_DIM; d.k0 = 64 * kb; d.nsrc = nsrc; d.nvalid = nv; d.WT = (bf16*)(ws + WS_WIN); d.ldt = DM; d.ndst = 32 * nb; d.gk = A.in[1]; return d; }
    r -= I_IN;
    if (r < 2 * I_C1) { const int w = r / I_C1, q = r % I_C1, nb = q % 8, kb = q / 8;
        d.W = w == 0 ? A.in[6] : A.in[11]; d.ldw = 256; d.k0 = 64 * kb; d.nsrc = 32 * nb; d.WT = (bf16*)(ws + WS_CW1) + (size_t)w * 256 * 2048; d.ldt = 2048; d.ndst = 32 * nb; d.fragmajor = 1; return d; }
    r -= 2 * I_C1;
    if (r < 2 * I_C2) { const int w = r / I_C2, q = r % I_C2, nb = q % 2, kb = q / 2;
        d.W = w == 0 ? A.in[8] : A.in[13]; d.ldw = 64; d.k0 = 64 * kb; d.nsrc = 32 * nb; d.WT = (bf16*)(ws + WS_CW2) + (size_t)w * 64 * 256; d.ldt = 256; d.ndst = 32 * nb; return d; }
    r -= 2 * I_C2;
    if (r < 2 * I_LW) { const int w = r / I_LW, q = r % I_LW, nb = q % 2, blk = q / 2;
        d.W = (w == 0 ? A.in[17] : A.in[19]) + (size_t)blk * 4096; d.ldw = 64; d.k0 = 0; d.nsrc = 32 * nb; d.WT = (bf16*)(ws + WS_LW) + (size_t)(w * 16 + blk) * 4096; d.ldt = 64; d.ndst = 32 * nb; return d; }
    r -= 2 * I_LW;
    if (r < 2 * I_GU) { const int w = r / I_GU, q = r % I_GU, nb = q % (DFF / 32), kb = q / (DFF / 32); const int c = 32 * nb;
        d.W = w == 0 ? A.in[26] : A.in[27]; d.ldw = DFF; d.k0 = 64 * kb; d.nsrc = c; d.WT = (bf16*)(ws + WS_WGU); d.ldt = DM; d.ndst = 256 * (c / 128) + (c % 128) + 128 * w; d.gk = A.in[25]; return d; }
    r -= 2 * I_GU;
    if (r < 3 * I_SQ) { const int w = r / I_SQ, q = r % I_SQ, nb = q % 32, kb = q / 32;
        d.W = w == 0 ? A.in[22] : (w == 1 ? A.in[23] : A.in[24]); d.WT = (bf16*)(ws + (w == 0 ? WS_WOA : (w == 1 ? WS_WOL : WS_WOUT)));
        d.ldw = DM; d.k0 = 64 * kb; d.nsrc = 32 * nb; d.ldt = DM; d.ndst = 32 * nb; return d; }
    r -= 3 * I_SQ;
    { const int nb = r % 32, kb = r / 32;
        d.W = A.in[28]; d.ldw = DM; d.k0 = 64 * kb; d.nsrc = 32 * nb; d.WT = (bf16*)(ws + WS_WDN); d.ldt = DFF; d.ndst = 32 * nb; return d; }
}
__device__ __forceinline__ void p0_item_load(const ConvItem& d, f32x4* v, int lane) {
    const int kr = lane >> 3, cc = lane & 7; const bool ok = 4 * cc < d.nvalid;
    const float* wp = d.W + (size_t)(d.k0 + kr) * d.ldw + d.nsrc + (ok ? 4 * cc : 0);
#pragma unroll
    for (int i = 0; i < 8; ++i) v[i] = __builtin_nontemporal_load((const f32x4*)(wp + (size_t)(8 * i) * d.ldw));
}
__device__ __forceinline__ void p0_item_finish(const ConvItem& d, const f32x4* v, LAS float* scr, int lane) {
    { const int kr = lane >> 3, cc = lane & 7; const bool ok = 4 * cc < d.nvalid;
#pragma unroll
      for (int i = 0; i < 8; ++i) { const int kk = 8 * i + kr; f32x4 x = ok ? v[i] : (f32x4){0.f, 0.f, 0.f, 0.f}; if (d.gk) x = x * d.gk[d.k0 + kk];
          LAS float* q = scr + kk * 33 + 4 * cc; q[0] = x[0]; q[1] = x[1]; q[2] = x[2]; q[3] = x[3]; } }
    LDS_WAIT(); asm volatile("" ::: "memory");
    const int c = lane & 7;
#pragma unroll
    for (int j = 0; j < 4; ++j) { const int n = (lane >> 3) + 8 * j; const LAS float* s = scr + (8 * c) * 33 + n;
        v4u o; o.x = pk2(s[0 * 33], s[1 * 33]); o.y = pk2(s[2 * 33], s[3 * 33]); o.z = pk2(s[4 * 33], s[5 * 33]); o.w = pk2(s[6 * 33], s[7 * 33]);
        if (d.fragmajor) { const int nn = d.ndst + n, k8 = (d.k0 >> 3) + c;
            *(GAS v4u*)(d.WT + ((((size_t)(nn >> 5) * (d.ldt >> 4) + (k8 >> 1)) * 64 + (k8 & 1) * 32 + (nn & 31)) << 3)) = o; }
        else *(GAS v4u*)(d.WT + (size_t)(d.ndst + n) * d.ldt + d.k0 + 8 * c) = o; }
    LDS_WAIT(); asm volatile("" ::: "memory");
}
template <bool LATE>
__device__ __forceinline__ void p0_prologue(Frame& F, const Args& A, int hrank = 0, int nhelp = 0) {
    LAS float* scr = (LAS float*)(F.lds + F.wave * 16384);
    const int gw = LATE ? hrank * NWAVES + F.wave : F.vcu * NWAVES + F.wave, NGW = LATE ? nhelp * NWAVES : F.G * NWAVES;
    unsigned char* ws = F.ws;
    const int NITEMS = LATE ? I_LATE : I_EARLY, ibase = LATE ? I_EARLY : 0;
    if (gw < NITEMS) {
        f32x4 v[8]; ConvItem cur = p0_item(A, ws, ibase + gw); p0_item_load(cur, v, F.lane);
        for (int it = gw; it < NITEMS; it += NGW) {
            const int nx = it + NGW; f32x4 vn[8]; ConvItem nxt = cur;
            if (nx < NITEMS) nxt = p0_item(A, ws, ibase + nx);
            p0_item_load(nxt, vn, F.lane);
            p0_item_finish(cur, v, scr, F.lane);
            cur = nxt;
#pragma unroll
            for (int i = 0; i < 8; ++i) v[i] = vn[i];
        }
    }
    if (LATE) return;
    const float* x = A.in[0]; bf16* XB = (bf16*)(ws + WS_XB); float* rstd = (float*)(ws + WS_RSTD1);
    for (int rep_ = 0; rep_ < (REP_PHASE == 31 ? 2 : 1); ++rep_)
    for (int m0 = gw; m0 < M_ROWS; m0 += 4 * NGW) {
        f32x4 v[4][4];
#pragma unroll
        for (int r = 0; r < 4; ++r) { const int m = m0 + r * NGW < M_ROWS ? m0 + r * NGW : m0; const GAS f32x4* xr = (const GAS f32x4*)(x + (size_t)m * DM) + 2 * F.lane;
#pragma unroll
            for (int j = 0; j < 4; ++j) v[r][j] = __builtin_nontemporal_load(xr + 128 * (j >> 1) + (j & 1)); }
#pragma unroll
        for (int r = 0; r < 4; ++r) { const int m = m0 + r * NGW; if (m < M_ROWS) {
            float s = 0.f;
#pragma unroll
            for (int j = 0; j < 4; ++j) s += (v[r][j].x * v[r][j].x + v[r][j].y * v[r][j].y) + (v[r][j].z * v[r][j].z + v[r][j].w * v[r][j].w);
            s = wave_sum(s);
            if (F.lane == 0) rstd[m] = 1.0f / sqrtf(s * (1.f / DM) + EPS);
            GAS v4u* o16 = (GAS v4u*)(XB + (size_t)m * DM) + F.lane;
#pragma unroll
            for (int hf = 0; hf < 2; ++hf) { v4u o; o.x = pk2(v[r][2 * hf].x, v[r][2 * hf].y); o.y = pk2(v[r][2 * hf].z, v[r][2 * hf].w); o.z = pk2(v[r][2 * hf + 1].x, v[r][2 * hf + 1].y); o.w = pk2(v[r][2 * hf + 1].z, v[r][2 * hf + 1].w);
                o16[64 * hf] = o; } } }
    }
}
typedef float f32x16 __attribute__((ext_vector_type(16)));
typedef short s16x4 __attribute__((ext_vector_type(4)));
__device__ __forceinline__ int crow(int r, int hi) { return (r & 3) + 8 * (r >> 2) + 4 * hi; }
__device__ __forceinline__ unsigned cvtpk(float lo, float hi) { unsigned r; asm volatile("v_cvt_pk_bf16_f32 %0, %1, %2" : "=v"(r) : "v"(lo), "v"(hi)); return r; }
__device__ __forceinline__ bf16x8 pack_bf8(const float* v) { v4u w; w.x = cvtpk(v[0], v[1]); w.y = cvtpk(v[2], v[3]); w.z = cvtpk(v[4], v[5]); w.w = cvtpk(v[6], v[7]); return __builtin_bit_cast(bf16x8, w); }
__device__ __forceinline__ void unpack_bf8(v4u w, float* v) { v[0] = bflo(w.x); v[1] = bfhi(w.x); v[2] = bflo(w.y); v[3] = bfhi(w.y); v[4] = bflo(w.z); v[5] = bfhi(w.z); v[6] = bflo(w.w); v[7] = bfhi(w.w); }

__device__ __forceinline__ void p2_knorm(Frame& F, const Args& A) {
    const int idx = F.vcu * 512 + F.tid;
    for (int it = idx; it < M_ROWS * 8; it += F.G * 512) {
        const int m = it >> 3, s = (it >> 2) & 1, g = it & 3, set = s ? 4 : 2;
        bf16* p = (bf16*)(F.ws + WS_KVB) + (size_t)m * KVW + set * 256 + g * 64; const float* gw = A.in[4] + (s ? 2 : 1) * 64;
        v4u w[8]; float ss = 0.f;
#pragma unroll
        for (int c = 0; c < 8; ++c) { w[c] = *(const v4u*)(p + 8 * c); float v[8]; unpack_bf8(w[c], v);
#pragma unroll
            for (int e = 0; e < 8; ++e) ss += v[e] * v[e]; }
        const float r = 1.0f / sqrtf(ss * (1.f / 64) + EPS);
#pragma unroll
        for (int c = 0; c < 8; ++c) { float v[8]; unpack_bf8(w[c], v); const f32x4 g0 = *(const f32x4*)(gw + 8 * c), g1 = *(const f32x4*)(gw + 8 * c + 4);
            v[0] *= r * g0[0]; v[1] *= r * g0[1]; v[2] *= r * g0[2]; v[3] *= r * g0[3]; v[4] *= r * g1[0]; v[5] *= r * g1[1]; v[6] *= r * g1[2]; v[7] *= r * g1[3];
            *(bf16x8*)(p + 8 * c) = pack_bf8(v); }
    }
}

constexpr int HID_LD = 264, CMP_A_OFF = 0, CMP_POS_OFF = 528 * 128, CMP_HID_OFF = 113664;
__device__ __forceinline__ void p2_compress(Frame& F, const Args& A, int unit) {
    const int set = unit >> 7, bg = (unit >> 3) & 15, oct = unit & 7, b = bg >> 2, g = bg & 3;
    const int lane = F.lane, w = F.wave, r32 = lane & 31, hi = lane >> 5, n0 = oct * 32;
    LAS unsigned char* lds = F.lds;
    { const bf16* kvb = (const bf16*)(F.ws + WS_KVB) + (size_t)(b * SEQ + 16 * n0) * KVW + set * 256 + g * 64;
      for (int q = w; q < 66; q += NWAVES) { const int R = 8 * q + (lane >> 3), c = (lane & 7) ^ ((R >> 4) & 7);
          __builtin_amdgcn_global_load_lds((const unsigned*)(kvb + (size_t)R * KVW + c * 8), (LAS unsigned*)(lds + CMP_A_OFF + q * 1024), 16, 0, 0); } }
    { const float* pos = set ? A.in[10] : A.in[5]; const f32x4 p = *(const f32x4*)(pos + 4 * F.tid); v2u pk; pk.x = cvtpk(p[0], p[1]); pk.y = cvtpk(p[2], p[3]);
      *(LAS v2u*)(lds + CMP_POS_OFF + 8 * F.tid) = pk; }
    const bf16* w1f = (const bf16*)(F.ws + WS_CW1) + ((size_t)(set * 8 + w) * 128 * 64 + lane) * 8;
    bf16x8 bq[8];
#pragma unroll
    for (int i = 0; i < 8; ++i) bq[i] = *(const bf16x8*)(w1f + (size_t)i * 512);
    asm volatile("s_waitcnt vmcnt(8)" ::: "memory");
    __syncthreads();
    f32x16 acc, acc2;
#pragma unroll
    for (int i = 0; i < 16; ++i) { acc[i] = 0.f; acc2[i] = 0.f; }
    const LAS unsigned char* arow = lds + CMP_A_OFF + r32 * 2048;
    const LAS unsigned char* prow = lds + CMP_POS_OFF + 16 * hi;
#pragma unroll 1
    for (int k8 = 0; k8 < 16; ++k8) {
        bf16x8 bn[8];
        const int kn = k8 < 15 ? k8 + 1 : 15;
#pragma unroll
        for (int i = 0; i < 8; ++i) bn[i] = *(const bf16x8*)(w1f + (size_t)(kn * 8 + i) * 512);
#pragma unroll
        for (int i = 0; i < 8; ++i) {
            const int lt = 2 * k8 + (i >> 2), kq = i & 3;
            const int key = (r32 + (k8 >> 3)) & 7;
            const bf16x8 af = *(const LAS bf16x8*)(arow + lt * 128 + (((2 * kq + hi) ^ key) << 4));
            const bf16x8 pf = *(const LAS bf16x8*)(prow + lt * 128 + kq * 32);
            acc = __builtin_amdgcn_mfma_f32_32x32x16_bf16(af, bq[i], acc, 0, 0, 0);
            acc2 = __builtin_amdgcn_mfma_f32_32x32x16_bf16(pf, bq[i], acc2, 0, 0, 0);
        }
#pragma unroll
        for (int i = 0; i < 8; ++i) bq[i] = bn[i];
    }
    LAS bf16* hid = (LAS bf16*)(lds + CMP_HID_OFF);
    { const float b1 = (set ? A.in[12] : A.in[7])[w * 32 + r32];
#pragma unroll
      for (int r = 0; r < 16; ++r) hid[crow(r, hi) * HID_LD + w * 32 + r32] = (bf16)f2bf(gelu_tanh(acc[r] + acc2[r] + b1)); }
    __syncthreads();
    if (w == 0) {
        const bf16* w2t = (const bf16*)(F.ws + WS_CW2) + (size_t)set * 64 * 256;
        f32x16 o[2];
#pragma unroll
        for (int mt = 0; mt < 2; ++mt)
#pragma unroll
            for (int i = 0; i < 16; ++i) o[mt][i] = 0.f;
#pragma unroll
        for (int k4 = 0; k4 < 4; ++k4) {
            bf16x8 wa[4][2];
#pragma unroll
            for (int i = 0; i < 4; ++i)
#pragma unroll
                for (int mt = 0; mt < 2; ++mt) wa[i][mt] = *(const bf16x8*)(w2t + (size_t)(32 * mt + r32) * 256 + 16 * (4 * k4 + i) + 8 * hi);
#pragma unroll
            for (int i = 0; i < 4; ++i) {
                const bf16x8 hb = *(const LAS bf16x8*)(hid + r32 * HID_LD + 16 * (4 * k4 + i) + 8 * hi);
#pragma unroll
                for (int mt = 0; mt < 2; ++mt) o[mt] = __builtin_amdgcn_mfma_f32_32x32x16_bf16(wa[i][mt], hb, o[mt], 0, 0, 0);
            }
        }
        const float* b2 = set ? A.in[14] : A.in[9]; float ss = 0.f;
#pragma unroll
        for (int mt = 0; mt < 2; ++mt)
#pragma unroll
            for (int r = 0; r < 16; ++r) { o[mt][r] += b2[32 * mt + crow(r, hi)]; ss += o[mt][r] * o[mt][r]; }
        ss += __shfl_xor(ss, 32);
        const float rs = 1.0f / sqrtf(ss * (1.f / 64) + EPS);
        const int n = n0 + r32;
        bf16* dst = (bf16*)(F.ws + (set ? WS_VC : WS_KC)) + ((size_t)bg * NCP + n) * 64;
#pragma unroll
        for (int mt = 0; mt < 2; ++mt)
#pragma unroll
            for (int a = 0; a < 4; ++a) { float v[4];
#pragma unroll
                for (int e = 0; e < 4; ++e) { const int d = 32 * mt + 8 * a + 4 * hi + e; float x = o[mt][4 * a + e]; if (set == 0) x *= rs * A.in[4][d]; if (n >= NCMP) x = 0.f; v[e] = x; }
                v2u pk; pk.x = cvtpk(v[0], v[1]); pk.y = cvtpk(v[2], v[3]);
                *(v2u*)(dst + 32 * mt + 8 * a + 4 * hi) = pk; }
    }
}

typedef _Float16 h8v __attribute__((ext_vector_type(8)));
typedef _Float16 h2v __attribute__((ext_vector_type(2)));
__device__ __forceinline__ unsigned pkh(float a, float b) { return __builtin_bit_cast(unsigned, __builtin_amdgcn_cvt_pkrtz(a, b)); }
constexpr int LRU_SEG = 128, LRU_NSEG = SEQ / LRU_SEG, LRU_BW_OFF = 0, LRU_CW_OFF = 16384, LRU_X_OFF = 20480;
__device__ __forceinline__ void lru_wg(Frame& F, const Args& A, int item) {
    const int n = item & 15, b = (item >> 4) & 3, seg = (item >> 6) * 8 + F.wave;
    int lane = F.lane, tid = F.tid; asm volatile("" : "+v"(lane), "+v"(tid));
    const int r32 = lane & 31, hi = lane >> 5;
    LAS v4u* BWL = (LAS v4u*)(F.lds + LRU_BW_OFF); LAS _Float16* cwH = (LAS _Float16*)(F.lds + LRU_CW_OFF);
    { const bf16* lw = (const bf16*)(F.ws + WS_LW);
      for (int e = tid; e < 1024; e += NWAVES * 64) { const int fr = e >> 6, ln = e & 63, gt = fr >> 3, nt = (fr >> 2) & 1, ks = fr & 3;
          const v4u w = *(const v4u*)(lw + ((size_t)(gt * 16 + n) * 64 + 32 * nt + (ln & 31)) * 64 + 16 * ks + 8 * (ln >> 5));
          float wv[8]; unpack_bf8(w, wv);
#pragma unroll
          for (int i = 0; i < 8; ++i) wv[i] *= -LOG2E;
          v4u o; o.x = pkh(wv[0], wv[1]); o.y = pkh(wv[2], wv[3]); o.z = pkh(wv[4], wv[5]); o.w = pkh(wv[6], wv[7]);
          BWL[e] = o; }
      if (tid < 320) { const int tap = tid >> 6, ln = tid & 63; cwH[tid] = (_Float16)(tap < 4 ? A.in[15][tap * 1024 + n * 64 + ln] : A.in[16][n * 64 + ln]); } }
    __syncthreads();
    bf16x8 ID0, ID1;
    { const bool mine = (hi == ((r32 >> 3) & 1));
#pragma unroll
      for (int j = 0; j < 8; ++j) { const short one = (mine && j == (r32 & 7)) ? (short)0x3C00 : (short)0; ID0[j] = (r32 < 16) ? one : (short)0; ID1[j] = (r32 >= 16) ? one : (short)0; } }
    float L2A[2], bar_[2], bi_[2], carry[2], Aseg[2];
#pragma unroll
    for (int nt = 0; nt < 2; ++nt) { const int cj = n * 64 + 32 * nt + r32; const float lam = A.in[21][cj];
        L2A[nt] = -8.0f * log1pf(expf(-lam)) * LOG2E; bar_[nt] = -LOG2E * A.in[18][cj]; bi_[nt] = -LOG2E * A.in[20][cj]; carry[nt] = 0.f; Aseg[nt] = 1.f; }
    const bf16* LXb = (const bf16*)(F.ws + WS_LX) + (size_t)b * SEQ * DM + n * 64; _Float16* HL = (_Float16*)(F.ws + WS_HL); _Float16* PC = (_Float16*)(F.ws + (b < 3 ? WS_PC0 : WS_PC3)) - (size_t)(b < 3 ? 0 : 3) * (SEQ / 32) * 16 * 2 * 1024;
    LAS unsigned char* xbuf = F.lds + LRU_X_OFF + F.wave * 10240;
#define LRU_DMA(tile_) do { const bf16* p_ = LXb + ((long)(seg * LRU_SEG + (tile_) * 32 + (lane >> 3)) - 3) * DM + (((lane & 7) ^ ((lane >> 3) & 7)) << 3); \
        _Pragma("unroll") for (int q = 0; q < 5; ++q) __builtin_amdgcn_global_load_lds((const unsigned*)(p_ + (size_t)q * 8 * DM), (LAS unsigned*)(xbuf + ((tile_) & 1) * 5120 + q * 1024), 16, 0, 0); } while (0)
    LRU_DMA(0);
#pragma unroll 1
    for (int tile = 0; tile < LRU_SEG / 32; ++tile) {
        const int t0 = seg * LRU_SEG + tile * 32, t = t0 + r32;
        asm volatile("s_waitcnt vmcnt(0)" ::: "memory");
        if (tile + 1 < LRU_SEG / 32) LRU_DMA(tile + 1);
        const LAS unsigned char* xb = xbuf + (tile & 1) * 5120;


        h8v AX[4];
        v4u xw[4][4]; v4u wv[4][5];
#pragma unroll
        for (int ks = 0; ks < 4; ++ks) {
#pragma unroll
            for (int tap = 0; tap < 4; ++tap) { const int Rl = r32 + tap; xw[ks][tap] = *(const LAS v4u*)(xb + Rl * 128 + (((2 * ks + hi) ^ (Rl & 7)) << 4)); }
#pragma unroll
            for (int tap = 0; tap < 5; ++tap) wv[ks][tap] = *(const LAS v4u*)(cwH + tap * 64 + 16 * ks + 8 * hi);
        }
        __builtin_amdgcn_sched_barrier(0);
#pragma unroll
        for (int ks = 0; ks < 4; ++ks) {
            h8v acc = __builtin_bit_cast(h8v, wv[ks][4]);
#pragma unroll
            for (int tap = 0; tap < 4; ++tap) {
                v4u x4 = xw[ks][tap];
                if (t - 3 + tap < 0) x4 = (v4u){0u, 0u, 0u, 0u};
                acc = __builtin_bit_cast(h8v, wv[ks][tap]) * __builtin_bit_cast(h8v, x4) + acc;
            }
            AX[ks] = acc;
        }
#pragma unroll
        for (int nt = 0; nt < 2; ++nt) {
            f32x16 ar, ai, xq;
#pragma unroll
            for (int i = 0; i < 16; ++i) { ar[i] = 0.f; ai[i] = 0.f; xq[i] = 0.f; }
            h8v bwr[4], bwi[4];
#pragma unroll
            for (int ks = 0; ks < 4; ++ks) { bwr[ks] = __builtin_bit_cast(h8v, BWL[((0 * 2 + nt) * 4 + ks) * 64 + lane]); bwi[ks] = __builtin_bit_cast(h8v, BWL[((1 * 2 + nt) * 4 + ks) * 64 + lane]); }
            __builtin_amdgcn_sched_barrier(0);
#pragma unroll
            for (int ks = 0; ks < 4; ++ks) { ar = __builtin_amdgcn_mfma_f32_32x32x16_f16(AX[ks], bwr[ks], ar, 0, 0, 0); ai = __builtin_amdgcn_mfma_f32_32x32x16_f16(AX[ks], bwi[ks], ai, 0, 0, 0); }
            xq = __builtin_amdgcn_mfma_f32_32x32x16_f16(AX[2 * nt], __builtin_bit_cast(h8v, ID0), xq, 0, 0, 0);
            xq = __builtin_amdgcn_mfma_f32_32x32x16_f16(AX[2 * nt + 1], __builtin_bit_cast(h8v, ID1), xq, 0, 0, 0);
            float av[16], bv[16];
#pragma unroll
            for (int r = 0; r < 16; ++r) {
                const float ea = 1.f + __builtin_amdgcn_exp2f(ar[r] + bar_[nt]), eb = 1.f + __builtin_amdgcn_exp2f(ai[r] + bi_[nt]);
                const float rc = __builtin_amdgcn_rcpf(ea * eb), rr = rc * eb, ii = rc * ea;
                const float a = __builtin_amdgcn_exp2f(rr * L2A[nt]);
                av[r] = a; bv[r] = __builtin_amdgcn_sqrtf(fmaxf(1.f - a * a, 0.f)) * (ii * xq[r]);
            }
            float Ag[4], Bg[4];
#pragma unroll
            for (int a = 0; a < 4; ++a) { Ag[a] = (av[4 * a] * av[4 * a + 1]) * (av[4 * a + 2] * av[4 * a + 3]);
                Bg[a] = ((bv[4 * a] * av[4 * a + 1] + bv[4 * a + 1]) * av[4 * a + 2] + bv[4 * a + 2]) * av[4 * a + 3] + bv[4 * a + 3]; }
            float st = carry[nt], pr = Aseg[nt], hst[4], pst[4];
#pragma unroll
            for (int a = 0; a < 4; ++a) {
                const float Ap = __shfl_xor(Ag[a], 32), Bp = __shfl_xor(Bg[a], 32);
                const float Alo = hi ? Ap : Ag[a], Blo = hi ? Bp : Bg[a], Ahi = hi ? Ag[a] : Ap, Bhi = hi ? Bg[a] : Bp;
                const float s_lo = st; st = Alo * st + Blo; const float s_hi = st; st = Ahi * st + Bhi;
                const float p_lo = pr; pr *= Alo; const float p_hi = pr; pr *= Ahi;
                hst[a] = hi ? s_hi : s_lo; pst[a] = hi ? p_hi : p_lo;
            }
            carry[nt] = st; Aseg[nt] = pr;
            {
                float hv[16], pv[16];
#pragma unroll
                for (int a = 0; a < 4; ++a) { float h = hst[a], p = pst[a];
#pragma unroll
                    for (int e = 0; e < 4; ++e) { const int r = 4 * a + e; h = av[r] * h + bv[r]; p *= av[r]; hv[r] = h; pv[r] = p; } }
                const size_t toff = ((size_t)((b * (SEQ / 32) + seg * (LRU_SEG / 32) + tile) * 16 + n) * 2 + nt) * 1024 + lane * 16;
                v4u w0, w1;
                w0.x = pkh(hv[0], hv[1]); w0.y = pkh(hv[2], hv[3]); w0.z = pkh(hv[4], hv[5]); w0.w = pkh(hv[6], hv[7]); w1.x = pkh(hv[8], hv[9]); w1.y = pkh(hv[10], hv[11]); w1.z = pkh(hv[12], hv[13]); w1.w = pkh(hv[14], hv[15]);
                *(v4u*)(HL + toff) = w0; *(v4u*)(HL + toff + 8) = w1;
                w0.x = pkh(pv[0], pv[1]); w0.y = pkh(pv[2], pv[3]); w0.z = pkh(pv[4], pv[5]); w0.w = pkh(pv[6], pv[7]); w1.x = pkh(pv[8], pv[9]); w1.y = pkh(pv[10], pv[11]); w1.z = pkh(pv[12], pv[13]); w1.w = pkh(pv[14], pv[15]);
                *(v4u*)(PC + toff) = w0; *(v4u*)(PC + toff + 8) = w1;
            }
        }
    }
#undef LRU_DMA
    if (hi == 0) {
        float* ls = (float*)(F.ws + WS_LSUM);
#pragma unroll
        for (int nt = 0; nt < 2; ++nt) *(float2*)(ls + ((size_t)(b * LRU_NSEG + seg) * 1024 + n * 64 + 32 * nt + r32) * 2) = make_float2(Aseg[nt], carry[nt]);
    }
}

__device__ __forceinline__ void lru_pass2(Frame& F, const Args& A, int item) {
    const int half = item & 1, seg = (item >> 1) & 31, b = item >> 6, lane = F.lane, r32 = lane & 31, hi = lane >> 5;
    LAS float* hin = (LAS float*)F.lds;
    { const float* ls = (const float*)(F.ws + WS_LSUM) + ((size_t)b * LRU_NSEG * 1024 + half * 512 + F.tid) * 2; float h = 0.f;
      for (int s0 = 0; s0 < seg; s0 += 8) {
          float2 ab[8];
#pragma unroll
          for (int i = 0; i < 8; ++i) { const int s = (s0 + i < seg) ? s0 + i : seg - 1; ab[i] = *(const float2*)(ls + (size_t)s * 2048); }
#pragma unroll
          for (int i = 0; i < 8; ++i) if (s0 + i < seg) h = ab[i].x * h + ab[i].y;
      }
      hin[F.tid] = h; }
    __syncthreads();
    const int n = half * 8 + F.wave;
    const float h0 = hin[F.wave * 64 + r32], h1 = hin[F.wave * 64 + 32 + r32];
    LAS unsigned char* tb = F.lds + 4096 + F.wave * 4608;
    const _Float16* HL = (const _Float16*)(F.ws + WS_HL); const _Float16* PC = (const _Float16*)(F.ws + (b < 3 ? WS_PC0 : WS_PC3)) - (size_t)(b < 3 ? 0 : 3) * (SEQ / 32) * 16 * 2 * 1024;
    bf16* LR = (bf16*)(F.ws + WS_LGG);
    typedef _Float16 hh8 __attribute__((ext_vector_type(8)));
#pragma unroll 1
    for (int tile = 0; tile < LRU_SEG / 32; ++tile) {
        const int t0 = seg * LRU_SEG + tile * 32;
        const size_t toff = ((size_t)((b * (SEQ / 32) + seg * (LRU_SEG / 32) + tile) * 16 + n) * 2) * 1024 + lane * 16;
        hh8 hq[2][2], pq[2][2];
#pragma unroll
        for (int nt = 0; nt < 2; ++nt) { hq[nt][0] = *(const hh8*)(HL + toff + nt * 1024); hq[nt][1] = *(const hh8*)(HL + toff + nt * 1024 + 8); pq[nt][0] = *(const hh8*)(PC + toff + nt * 1024); pq[nt][1] = *(const hh8*)(PC + toff + nt * 1024 + 8); }
        v4u gw[4];
#pragma unroll
        for (int i = 0; i < 4; ++i) { const int q = lane + 64 * i; gw[i] = *(const v4u*)(LR + (size_t)(b * SEQ + t0 + (q >> 3)) * DM + n * 64 + 8 * (q & 7)); }
#pragma unroll
        for (int nt = 0; nt < 2; ++nt) { const float hc = nt ? h1 : h0;
#pragma unroll
            for (int r = 0; r < 16; ++r) { const float s = (float)hq[nt][r >> 3][r & 7] + (float)pq[nt][r >> 3][r & 7] * hc;
                *(LAS _Float16*)(tb + crow(r, hi) * 144 + (32 * nt + r32) * 2) = (_Float16)s; } }
        asm volatile("s_waitcnt lgkmcnt(0)" ::: "memory");
#pragma unroll
        for (int i = 0; i < 4; ++i) { const int q = lane + 64 * i;
            const hh8 sv = *(const LAS hh8*)(tb + (q >> 3) * 144 + 16 * (q & 7)); float g[8], o[8]; unpack_bf8(gw[i], g);
#pragma unroll
            for (int k = 0; k < 8; ++k) o[k] = (float)sv[k] * g[k];
            *(bf16x8*)(LR + (size_t)(b * SEQ + t0 + (q >> 3)) * DM + n * 64 + 8 * (q & 7)) = pack_bf8(o); }
        asm volatile("s_waitcnt lgkmcnt(0)" ::: "memory");
    }
    __syncthreads();
}

__device__ __forceinline__ void phase2(Frame& F, const Args& A) {
    p2_knorm(F, A);
    for (int rep = 0; rep < (REP_PHASE == 20 ? 2 : 1); ++rep)
    for (int u = F.vcu; u < 256; u += F.G) { p2_compress(F, A, u); __syncthreads(); }
    for (int rep = 0; rep < (REP_PHASE == 21 ? 2 : 1); ++rep)
    for (int it = F.vcu; it < 256; it += F.G) { lru_wg(F, A, it); __syncthreads(); }
}
namespace att {
constexpr int NSLOT = 4, SLOTB = 16384  , IMP_OFF = NSLOT * SLOTB, IMP_LD = 72, MSK_OFF = IMP_OFF + 4 * 64 * IMP_LD * 2, UNI_OFF = MSK_OFF + 512, SC_OFF = UNI_OFF + 16;
static_assert(SC_OFF + 4 * 64 * 4 * 4 <= RING_BYTES, "attention LDS map");
constexpr float NEGBIG = -1e30f, MREF0 = -8192.f, C2 = 0.125f * LOG2E, THR = 8.f;
constexpr int DIST = 2;

__device__ __forceinline__ void glds16(const void* gsrc, unsigned lds_dst) { unsigned keep;
    asm volatile("s_mov_b32 %0, m0\n\ts_mov_b32 m0, %2\n\ts_nop 0\n\tglobal_load_lds_dwordx4 %1, off\n\ts_mov_b32 m0, %0" : "=&s"(keep) : "v"(gsrc), "s"(lds_dst) : "memory"); }
#define ATT_WAIT_BAR(N) asm volatile("s_waitcnt vmcnt(" #N ") lgkmcnt(0)\n\ts_barrier" ::: "memory")
#define ATT_WAIT_BAR_NOVM() asm volatile("s_waitcnt lgkmcnt(0)\n\ts_barrier" ::: "memory")
__device__ __forceinline__ float fadd_s(float a, float b) { float r; asm("v_add_f32_e32 %0, %1, %2" : "=v"(r) : "v"(a), "v"(b)); return r; }
__device__ __forceinline__ float max3f(float a, float b, float c) { float r; asm("v_max3_f32 %0, %1, %2, %3" : "=v"(r) : "v"(a), "v"(b), "v"(c)); return r; }

#define ATT_SB() __builtin_amdgcn_sched_barrier(0)
__device__ __forceinline__ void qk_tile(const LAS unsigned char* kslot, const bf16x8* qf, float slk  , float base0, f32x16& p0, f32x16& p1, int r32, int hi) {
    const LAS unsigned char* kp = kslot + r32 * 128; const int kx = (r32 >> 1) & 7;
    bf16x8 kf[8];
#pragma unroll
    for (int d0 = 0; d0 < 4; ++d0) { const int so = ((2 * d0 + hi) ^ kx) << 4; kf[2 * d0] = *(const LAS bf16x8*)(kp + so); kf[2 * d0 + 1] = *(const LAS bf16x8*)(kp + 4096 + so); }
    ATT_SB();
    const float bl = base0 + slk * (float)(4 * hi), bh = bl + slk * 32.f;
#pragma unroll
    for (int r = 0; r < 16; ++r) { const float c = (float)((r & 3) + 8 * (r >> 2)); p0[r] = __builtin_fmaf(slk, c, bl); p1[r] = __builtin_fmaf(slk, c, bh); }
    ATT_SB();
    __builtin_amdgcn_s_setprio(1);
#pragma unroll
    for (int d0 = 0; d0 < 4; ++d0) {
        p0 = __builtin_amdgcn_mfma_f32_32x32x16_bf16(kf[2 * d0], qf[d0], p0, 0, 0, 0);
        p1 = __builtin_amdgcn_mfma_f32_32x32x16_bf16(kf[2 * d0 + 1], qf[d0], p1, 0, 0, 0);
    }
    __builtin_amdgcn_s_setprio(0);
    ATT_SB();
}
template <bool LE> __device__ __forceinline__ void mask_tile(f32x16& p0, f32x16& p1, int bound, int hi) {
    const int bb = bound - 4 * hi;
#pragma unroll
    for (int r = 0; r < 16; ++r) { const int c = (r & 3) + 8 * (r >> 2);
        if (LE) { if (c > bb) p0[r] = NEGBIG; if (c + 32 > bb) p1[r] = NEGBIG; }
        else { if (c < bb) p0[r] = NEGBIG; if (c + 32 < bb) p1[r] = NEGBIG; } }
}
__device__ __forceinline__ float row_max(const f32x16& p0, const f32x16& p1) {
    float a = max3f(p0[0], p0[1], p1[0]), b = max3f(p0[2], p0[3], p1[1]); a = max3f(a, p1[2], p1[3]);
#pragma unroll
    for (int r = 4; r < 16; r += 4) { a = max3f(a, p0[r], p0[r + 1]); b = max3f(b, p0[r + 2], p0[r + 3]); a = max3f(a, p1[r], p1[r + 1]); b = max3f(b, p1[r + 2], p1[r + 3]); }
    a = fmaxf(a, b);
    return fmaxf(a, __shfl_xor(a, 32));
}
__device__ __forceinline__ s16x4 vtr(const LAS unsigned char* p) { typedef short v4i16_t __attribute__((ext_vector_type(4))); return __builtin_bit_cast(s16x4, __builtin_amdgcn_ds_read_tr16_b64_v4i16((LAS v4i16_t*)p)); }
__device__ __forceinline__ void v_load(const LAS unsigned char* vslot, int d0, bf16x8* vf, int lane, int hi) {
    const int q4 = (lane & 15) >> 2, p4 = lane & 3, g2 = (lane >> 4) & 1;
    const LAS unsigned char* vp = vslot + (4 * hi + q4) * 128 + ((((4 * d0 + 2 * g2 + (p4 >> 1)) ^ ((q4 >> 1) << 2))) << 4) + 8 * (p4 & 1);
#pragma unroll
    for (int i = 0; i < 4; ++i) {
        const s16x4 lo = vtr(vp + i * 2048), hh = vtr(vp + i * 2048 + 1024);
        vf[i] = (bf16x8){lo[0], lo[1], lo[2], lo[3], hh[0], hh[1], hh[2], hh[3]};
    }
    ATT_SB();
}
__device__ __forceinline__ void pack_p(const f32x16& p0, const f32x16& p1, bf16x8* pa) {
    float t[8];
#pragma unroll
    for (int i = 0; i < 8; ++i) t[i] = p0[i];
    pa[0] = pack_bf8(t);
#pragma unroll
    for (int i = 0; i < 8; ++i) t[i] = p0[8 + i];
    pa[1] = pack_bf8(t);
#pragma unroll
    for (int i = 0; i < 8; ++i) t[i] = p1[i];
    pa[2] = pack_bf8(t);
#pragma unroll
    for (int i = 0; i < 8; ++i) t[i] = p1[8 + i];
    pa[3] = pack_bf8(t);
}
__device__ __forceinline__ void pv_mma_packed(const LAS unsigned char* vslot, const bf16x8* vf0, const bf16x8* pa, f32x16* o, int lane, int hi) {
    bf16x8 vf1[4]; v_load(vslot, 1, vf1, lane, hi);
    __builtin_amdgcn_s_setprio(1);
#pragma unroll
    for (int ks = 0; ks < 4; ++ks) o[0] = __builtin_amdgcn_mfma_f32_32x32x16_bf16(vf0[ks], pa[ks], o[0], 0, 0, 0);
#pragma unroll
    for (int ks = 0; ks < 4; ++ks) o[1] = __builtin_amdgcn_mfma_f32_32x32x16_bf16(vf1[ks], pa[ks], o[1], 0, 0, 0);
    __builtin_amdgcn_s_setprio(0);
    ATT_SB();
}
__device__ __forceinline__ void pv_mma(const LAS unsigned char* vslot, const bf16x8* vf0, const f32x16& p0, const f32x16& p1, f32x16* o, int lane, int hi) {
    bf16x8 pa[4]; pack_p(p0, p1, pa); ATT_SB();
    pv_mma_packed(vslot, vf0, pa, o, lane, hi);
}
__device__ __forceinline__ float softmax_exp(f32x16& p0, f32x16& p1, float& mref, float& l, f32x16* o, bool has_o) {
    const float rm = row_max(p0, p1); float fac = 1.f;
    if (__any(rm > THR)) {
        const float d = fmaxf(rm, 0.f), alpha = __builtin_amdgcn_exp2f(-d); mref += d; l *= alpha; fac = alpha;
#pragma unroll
        for (int r = 0; r < 16; ++r) { p0[r] -= d; p1[r] -= d; }
        if (has_o) {
#pragma unroll
            for (int r = 0; r < 16; ++r) { o[0][r] *= alpha; o[1][r] *= alpha; }
        }
    }
#pragma unroll
    for (int r = 0; r < 16; ++r) { p0[r] = __builtin_amdgcn_exp2f(p0[r]); p1[r] = __builtin_amdgcn_exp2f(p1[r]); }
    return fac;
}
__device__ __forceinline__ void softmax_sum(const f32x16& p0, const f32x16& p1, float& l) {
    float s0 = 0.f, s1 = 0.f;
#pragma unroll
    for (int r = 0; r < 16; ++r) { s0 += p0[r]; s1 += p1[r]; }
    l += s0 + s1;
}
__device__ __forceinline__ float softmax_step(f32x16& p0, f32x16& p1, float& mref, float& l, f32x16* o, bool has_o) { const float f = softmax_exp(p0, p1, mref, l, o, has_o); softmax_sum(p0, p1, l); return f; }

__device__ __forceinline__ void attn_unit(Frame& F, const Args& A, int bg, int qt) {
    int lane = F.lane; asm volatile("" : "+v"(lane));
    const int b = bg >> 2, g = bg & 3, wid = F.wave, r32 = lane & 31, hi = lane >> 5;
    const int hh = wid & 3, qh = wid >> 2, head = g * 4 + hh;
    const int t0 = qt * 64, u = 32 * qh + r32, t = t0 + u; const size_t m = (size_t)b * SEQ + t;
    LAS unsigned char* lds = F.lds;
    const unsigned lds0 = (unsigned)(uintptr_t)lds;
    unsigned char* ws = F.ws;
    if (F.tid == 0) { *(LAS unsigned*)(lds + UNI_OFF) = 0u; *(LAS unsigned*)(lds + UNI_OFF + 4) = 0u; }
    const bf16* KCb = (const bf16*)(ws + WS_KC) + (size_t)bg * NCP * 64; const bf16* VCb = (const bf16*)(ws + WS_VC) + (size_t)bg * NCP * 64;
    const bf16* KVb = (const bf16*)(ws + WS_KVB) + (size_t)b * SEQ * KVW + g * 64;
    const int rowl = 8 * wid + (lane >> 3), kch = (lane & 7) ^ ((rowl >> 1) & 7), vch = (lane & 7) ^ (((rowl >> 1) & 1) << 2);
    const int kofC = rowl * 64 + kch * 8, vofC = rowl * 64 + vch * 8;
    const int kofT = rowl * KVW + kch * 8, vofT = rowl * KVW + vch * 8;
    const int nct = (((t0 + 32) >> 4) >> 6) + 1;
    const int jlast = qt >= 8 ? qt - 8 : 0, nw = qt - jlast + 1;
    const int sW = nct, sS = sW + nw;
    int total = sS;
    int ipos = 0;
    unsigned long long iss_uni = 0ull;
    const unsigned kdst = lds0 + wid * 1024, vdst = lds0 + 8192 + wid * 1024;
#define ATT_ISSUE() do { if (ipos < total) { const unsigned so = (unsigned)(ipos & (NSLOT - 1)) * SLOTB; \
        if (ipos < sW) { const int row = 64 * ipos; glds16(KCb + row * 64 + kofC, (unsigned)__builtin_amdgcn_readfirstlane(kdst + so)); glds16(VCb + row * 64 + vofC, (unsigned)__builtin_amdgcn_readfirstlane(vdst + so)); } \
        else { int j; const bf16* kb_; if (ipos < sS) { j = qt - (ipos - sW); kb_ = KVb + 4 * 256; } else { j = 63 - __builtin_clzll(iss_uni); iss_uni &= ~(1ull << j); kb_ = KVb + 2 * 256; } \
               const bf16* p_ = kb_ + (size_t)j * 64 * KVW; glds16(p_ + kofT, (unsigned)__builtin_amdgcn_readfirstlane(kdst + so)); glds16(p_ + 256 + vofT, (unsigned)__builtin_amdgcn_readfirstlane(vdst + so)); } \
        ++ipos; } } while (0)
#define ATT_STEP_END(cpos) do { const int ahead = ipos - (cpos) - 2; if (ahead >= 2) ATT_WAIT_BAR(4); else if (ahead == 1) ATT_WAIT_BAR(2); else ATT_WAIT_BAR(0); } while (0)
    ATT_ISSUE(); ATT_ISSUE();
    bf16x8 qf[4];
    {
        const bf16* qp = (const bf16*)(ws + WS_QB) + m * DM + head * 64 + 8 * hi; const float* qng = A.in[3] + 8 * hi;
        v4u w[4]; float ss = 0.f;
#pragma unroll
        for (int ks = 0; ks < 4; ++ks) { w[ks] = *(const v4u*)(qp + 16 * ks); float v[8]; unpack_bf8(w[ks], v);
#pragma unroll
            for (int e = 0; e < 8; ++e) ss += v[e] * v[e]; }
        ss += __shfl_xor(ss, 32);
        const float rs = C2 / sqrtf(ss * (1.f / 64) + EPS);
#pragma unroll
        for (int ks = 0; ks < 4; ++ks) { float v[8]; unpack_bf8(w[ks], v);
#pragma unroll
            for (int e = 0; e < 8; ++e) v[e] *= rs * qng[16 * ks + e];
            qf[ks] = pack_bf8(v); }
    }
    const float sl2 = exp2f(-0.5f * (float)(head + 1)) * LOG2E;
    const bf16* NGp = (const bf16*)(ws + WS_NG) + m * 48 + head * 3;
    const float gate_c = bf2f(NGp[0]), gate_s = bf2f(NGp[1]), gate_w = bf2f(NGp[2]);
    f32x16 o[2];
    unsigned oaccp[2][8];
#pragma unroll
    for (int i = 0; i < 8; ++i) { oaccp[0][i] = 0u; oaccp[1][i] = 0u; }
#define ATT_FOLD(sc_) do { _Pragma("unroll") for (int d_ = 0; d_ < 2; ++d_) _Pragma("unroll") for (int i_ = 0; i_ < 8; ++i_) { \
        const float a_ = bflo(oaccp[d_][i_]) + (sc_) * o[d_][2 * i_], b_ = bfhi(oaccp[d_][i_]) + (sc_) * o[d_][2 * i_ + 1]; oaccp[d_][i_] = cvtpk(a_, b_); } } while (0)
    ATT_WAIT_BAR(0);
    int cpos = 0;
#if PROBE_ID
    unsigned* pc = (unsigned*)(ws + WS_CTL) + 8192; unsigned long long ts0 = __builtin_amdgcn_s_memtime();
#define PROBE_MARK(k) do { const unsigned long long ts1 = __builtin_amdgcn_s_memtime(); if (F.tid == 0) atomicAdd(pc + (k), (unsigned)((ts1 - ts0) >> 4)); ts0 = ts1; } while (0)
#else
#define PROBE_MARK(k) do {} while (0)
#endif
#define ATT_K(cpos) (lds + (unsigned)((cpos) & (NSLOT - 1)) * SLOTB)
#define ATT_V(cpos) (lds + (unsigned)((cpos) & (NSLOT - 1)) * SLOTB + 8192)
    {
        const int nmax = (t - 31) >> 4;
        float mref = MREF0, l = 0.f, mk[4] = {0.f, 0.f, 0.f, 0.f};
#pragma unroll
        for (int r = 0; r < 16; ++r) { o[0][r] = 0.f; o[1][r] = 0.f; }
        LAS _Float16* impw = (LAS _Float16*)(lds + IMP_OFF) + (hh * 64 + u) * IMP_LD;
        float ecarry = 0.f;
#pragma unroll
        for (int kt = 0; kt < 4; ++kt) {
            if (kt < nct) {
                ATT_ISSUE();
                f32x16 p0, p1;
                qk_tile(ATT_K(cpos), qf, sl2 * 16.f, sl2 * (float)(1024 * kt + 31 - t0) - mref, p0, p1, r32, hi);
                bf16x8 vf[4]; v_load(ATT_V(cpos), 0, vf, lane, hi);
                mask_tile<true>(p0, p1, nmax - 64 * kt, hi);
                ecarry *= softmax_step(p0, p1, mref, l, o, true);
                mk[kt] = mref;
                float Eo[2][4];
#pragma unroll
                for (int a4 = 0; a4 < 4; ++a4) { Eo[0][a4] = __shfl_xor(p0[4 * a4 + 3], 32); Eo[1][a4] = __shfl_xor(p1[4 * a4 + 3], 32); }
#pragma unroll
                for (int s = 0; s < 2; ++s)
#pragma unroll
                    for (int a4 = 0; a4 < 4; ++a4) {
                        const float G = s == 0 ? (p0[4 * a4] + p0[4 * a4 + 1]) + (p0[4 * a4 + 2] + p0[4 * a4 + 3]) : (p1[4 * a4] + p1[4 * a4 + 1]) + (p1[4 * a4 + 2] + p1[4 * a4 + 3]);
                        const float prev = a4 >= 1 ? Eo[s][a4 - 1] : (s == 1 ? Eo[0][3] : ecarry);
                        impw[16 * kt + 8 * s + 2 * a4 + hi] = (_Float16)(G + (hi ? Eo[s][a4] : prev));
                    }
                ecarry = Eo[1][3];
                pv_mma(ATT_V(cpos), vf, p0, p1, o, lane, hi);
                ATT_STEP_END(cpos); ++cpos;
            }
        }
        l += __shfl_xor(l, 32);
        const float inv = l > 0.f ? 1.0f / l : 0.f;
        if (hi == 0) { f32x4 sc; sc[0] = __builtin_amdgcn_exp2f(mk[0] - mref) * inv; sc[1] = __builtin_amdgcn_exp2f(mk[1] - mref) * inv; sc[2] = __builtin_amdgcn_exp2f(mk[2] - mref) * inv; sc[3] = __builtin_amdgcn_exp2f(mk[3] - mref) * inv;
            *(LAS f32x4*)(lds + SC_OFF + (hh * 64 + u) * 16) = sc; }
        const float gsc = gate_c * inv;
        ATT_FOLD(gsc);
        asm volatile("s_waitcnt lgkmcnt(0)\n\ts_barrier" ::: "memory");
    }
    PROBE_MARK(0);
    {
        const int q = lane >> 3, kg = lane & 7, uq = 8 * wid + q, tq = t0 + uq;
        float v[8];
#pragma unroll
        for (int i = 0; i < 8; ++i) v[i] = 0.f;
#pragma unroll
        for (int h4 = 0; h4 < 4; ++h4) { typedef _Float16 h8 __attribute__((ext_vector_type(8)));
            const h8 x = *(const LAS h8*)(lds + IMP_OFF + ((h4 * 64 + uq) * IMP_LD + 8 * kg) * 2);
            const float sc = *(const LAS float*)(lds + SC_OFF + (h4 * 64 + uq) * 16 + 4 * (kg >> 1));
#pragma unroll
            for (int i = 0; i < 8; ++i) v[i] += (float)x[i] * sc; }
        unsigned key[8];
#pragma unroll
        for (int i = 0; i < 8; ++i) { const int j = 8 * kg + i; const bool valid = (64 * j <= tq), forced = (j == 0) || (j == qt) || (j == qt - 1);
            const float val = v[i] + (forced ? 1e4f : 0.f);
            key[i] = valid ? (((__float_as_uint(val) >> 16) << 6) | (unsigned)(63 - j)) : 0u; }
        unsigned thr = 0u;
#pragma unroll 1
        for (int bit = 20; bit >= 0; --bit) {
            const unsigned cand = thr | (1u << bit); int c = 0;
#pragma unroll
            for (int i = 0; i < 8; ++i) c += (key[i] >= cand) ? 1 : 0;
            c += __builtin_amdgcn_update_dpp(0, c, 0xB1, 0xF, 0xF, true);
            c += __builtin_amdgcn_update_dpp(0, c, 0x4E, 0xF, 0xF, true);
            c += __builtin_amdgcn_update_dpp(0, c, 0x141, 0xF, 0xF, true);
            thr = c >= 16 ? cand : thr;
        }
        unsigned m8 = 0u;
#pragma unroll
        for (int i = 0; i < 8; ++i) m8 |= ((key[i] != 0u && key[i] >= thr) ? 1u : 0u) << i;
        *(LAS unsigned char*)(lds + MSK_OFF + 8 * uq + kg) = (unsigned char)m8;
        __hip_atomic_fetch_or((LAS unsigned*)(lds + UNI_OFF + 4 * (kg >> 2)), m8 << (8 * (kg & 3)), __ATOMIC_RELAXED, __HIP_MEMORY_SCOPE_WORKGROUP);
        asm volatile("s_waitcnt lgkmcnt(0)\n\ts_barrier" ::: "memory");
    }
    const unsigned mlo = *(const LAS unsigned*)(lds + MSK_OFF + 8 * u), mhi = *(const LAS unsigned*)(lds + MSK_OFF + 8 * u + 4);
    const unsigned long long mymask = ((unsigned long long)mhi << 32) | mlo;
    unsigned long long cmp_uni = ((unsigned long long)(unsigned)__builtin_amdgcn_readfirstlane((int)*(const LAS unsigned*)(lds + UNI_OFF + 4)) << 32) | (unsigned)__builtin_amdgcn_readfirstlane((int)*(const LAS unsigned*)(lds + UNI_OFF));
    iss_uni = cmp_uni; total = sS + __builtin_popcountll(cmp_uni);
    PROBE_MARK(1);
#if PROBE_ID
    if (F.tid == 0) { atomicAdd(pc + 4, (unsigned)__builtin_popcountll(cmp_uni)); atomicAdd(pc + 5, (unsigned)(2 * nct + nw)); }
#endif
#define ATT_WS_LOOP(DEFER) { \
        float mref = MREF0, l = 0.f; \
        _Pragma("unroll") for (int r = 0; r < 16; ++r) { o[0][r] = 0.f; o[1][r] = 0.f; } \
        bf16x8 pa[4]; \
        const int nsteps = nw + __builtin_popcountll(cmp_uni); \
        for (int st = 0; st < nsteps; ++st, ++cpos) { \
            int j; bool win; \
            if (st < nw) { j = qt - st; win = true; } else { j = 63 - __builtin_clzll(cmp_uni); cmp_uni &= ~(1ull << j); win = false; } \
            if (DEFER && st > 0) { bf16x8 vf[4]; v_load(ATT_V(cpos - 1), 0, vf, lane, hi); pv_mma_packed(ATT_V(cpos - 1), vf, pa, o, lane, hi); } \
            if (st == nw) { \
                PROBE_MARK(2); \
                l += __shfl_xor(l, 32); \
                const float sc = l > 0.f ? gate_w / l : 0.f; \
                ATT_FOLD(sc); \
                _Pragma("unroll") for (int r = 0; r < 16; ++r) { o[0][r] = 0.f; o[1][r] = 0.f; } \
                mref = MREF0; l = 0.f; \
            } \
            ATT_ISSUE(); \
            f32x16 p0, p1; \
            const float selb = (win || ((mymask >> j) & 1ull)) ? 0.f : NEGBIG; \
            qk_tile(ATT_K(cpos), qf, sl2, sl2 * (float)(64 * j - t0) - mref + selb, p0, p1, r32, hi); \
            if (!DEFER) { \
                bf16x8 vf[4]; v_load(ATT_V(cpos), 0, vf, lane, hi); \
                if (j == qt) mask_tile<true>(p0, p1, u, hi); \
                if (win && j == qt - 8) mask_tile<false>(p0, p1, u + 1, hi); \
                softmax_step(p0, p1, mref, l, o, true); \
                pv_mma(ATT_V(cpos), vf, p0, p1, o, lane, hi); \
            } else { \
                if (j == qt) mask_tile<true>(p0, p1, u, hi); \
                if (win && j == qt - 8) mask_tile<false>(p0, p1, u + 1, hi); \
                softmax_step(p0, p1, mref, l, o, true); \
                pack_p(p0, p1, pa); \
            } \
            ATT_STEP_END(cpos); \
        } \
        if (DEFER) { bf16x8 vf[4]; v_load(ATT_V(cpos - 1), 0, vf, lane, hi); pv_mma_packed(ATT_V(cpos - 1), vf, pa, o, lane, hi); } \
        l += __shfl_xor(l, 32); \
        const float sc = l > 0.f ? gate_s / l : 0.f; \
        ATT_FOLD(sc); \
    }
    if (F.grp != 0) ATT_WS_LOOP(true) else ATT_WS_LOOP(false)
#undef ATT_WS_LOOP
    PROBE_MARK(3);
    bf16* op = (bf16*)(ws + WS_QB) + m * DM + head * 64 + 4 * hi;
#pragma unroll
    for (int d0 = 0; d0 < 2; ++d0)
#pragma unroll
        for (int a = 0; a < 4; ++a) { v2u pk; pk.x = oaccp[d0][2 * a]; pk.y = oaccp[d0][2 * a + 1]; *(v2u*)(op + 32 * d0 + 8 * a) = pk; }
#undef ATT_FOLD
#undef ATT_ISSUE
#undef ATT_STEP_END
#undef ATT_K
#undef ATT_V
}
#undef ATT_WAIT_BAR
#undef ATT_WAIT_BAR_NOVM
#undef ATT_SB
}

__device__ __forceinline__ void phase3(Frame& F, const Args& A) {
    for (int it = F.vcu; it < 256; it += F.G) lru_pass2(F, A, it);
#if FAST_ATTN
    __syncthreads();
    {
        const bool lab8 = (F.G % 8) == 0; const int nq = lab8 ? 8 : 1, lab = lab8 ? (int)(blockIdx.x & 7) : 0, per = 1024 / nq;
        unsigned* head = (unsigned*)(F.ws + WS_CTL) + CW_QUEUE + 64 * lab;
        volatile LAS unsigned* slotw = (volatile LAS unsigned*)(F.lds + MISC_OFF + 96);
        for (;;) {
            if (F.tid == 0) *slotw = __hip_atomic_fetch_add(head, 1u, __ATOMIC_RELAXED, __HIP_MEMORY_SCOPE_AGENT);
            __syncthreads();
            const int i = (int)*slotw;
            __syncthreads();
            if (i >= per) break;
            const int nbg = 16 / nq, bg = lab * nbg + (i % nbg), qt = 63 - i / nbg;
            att::attn_unit(F, A, bg, qt);
            __syncthreads();
        }
    }
#endif
}
constexpr int N_PHASES = 8;

__global__ void __launch_bounds__(NWAVES * 64, 2) fwd_kernel(Args args) {
    extern __shared__ __attribute__((aligned(16))) unsigned char lds[];
    Frame F;
    F.lds = (LAS unsigned char*)lds;
    F.MISC = (volatile LAS unsigned*)(F.lds + MISC_OFF);
    F.tid = threadIdx.x; F.lane = F.tid & 63; F.wave = __builtin_amdgcn_readfirstlane(F.tid >> 6);
    F.G = gridDim.x; { const int bx = blockIdx.x; F.vcu = (F.G % 8 == 0) ? (bx % 8) * (F.G / 8) + bx / 8 : bx; }
    F.out = args.out; F.ws = args.ws; unsigned char* ws = args.ws;
    F.ctl = (gu32*)(ws + WS_CTL);
    for (int u = F.tid; u < (LDS_BYTES - LDSCTL_OFF) / 4; u += NWAVES * 64) ((LAS unsigned*)(F.lds + LDSCTL_OFF))[u] = 0u;
    __syncthreads();
    { const unsigned simd = ((unsigned)__builtin_amdgcn_s_getreg((1 << 11) | (4 << 6) | 4)) & 3u;
      int slot = 0; if (F.lane == 0) slot = (int)__hip_atomic_fetch_add((LAS unsigned*)(F.lds + MISC_OFF + 64 + 4 * simd), 1u, __ATOMIC_RELAXED, __HIP_MEMORY_SCOPE_WORKGROUP);
      F.grp = __builtin_amdgcn_readfirstlane(slot) & 1; }
    const int lo = args.ph_lo, hi = args.ph_hi;
    const bool multi = (hi - lo) > 1;
    XcdBarrier bar; bar.bar = (unsigned*)(F.ctl + CW_BAR); bar.x = 0; bar.st = nullptr;
    if (multi) bar = xcd_barrier_post((unsigned*)(F.ctl + CW_BAR), F.MISC + 8);
#ifdef ONLY
#define IN(k) ((k) == ONLY && lo <= (k) && (k) < hi)
#else
#define IN(k) (lo <= (k) && (k) < hi)
#endif
#if PROBE_ID >= 10
#define STAMP(k) do { if (blockIdx.x == 0 && F.tid == 0) F.MISC[12 + (k)] = (unsigned)__builtin_amdgcn_s_memrealtime(); } while (0)
#else
#define STAMP(k) do {} while (0)
#endif
#define SEAM(k) do { if (IN(k) && IN((k) + 1)) xcd_barrier(bar); STAMP((k) + 1); } while (0)
    using namespace pg8;
    PG8_LAS unsigned char* ring = (PG8_LAS unsigned char*)lds;

#ifndef REP_PHASE
#define REP_PHASE -1
#endif
#define NREP(k) ((k) == REP_PHASE ? 2 : 1)
    STAMP(0);
    if (IN(0)) { p0_prologue<false>(F, args); SEAM(0); }

    if (IN(1)) {
        Gemm g{2 * DM, 128, 2 * DM, 128, DM / 64};
        SchedSimple S; S.T.init(M_ROWS, NPROJ, F.G, (int)blockIdx.x); S.A = (const char*)(ws + WS_XB); S.B = (const char*)(ws + WS_WIN); S.tA = (size_t)256 * 2 * DM; S.tB = (size_t)256 * 2 * DM;
        EpiProj E{(const float*)(ws + WS_RSTD1), (bf16_t*)(ws + WS_QB), (bf16_t*)(ws + WS_KVB), (bf16_t*)(ws + WS_NG), (bf16_t*)(ws + WS_LX), (bf16_t*)(ws + WS_LGG), (bf16_t*)F.out};
        gemm_phase<EpiProj, SchedSimple, GEMM_ALIGN_P1>(ring, g, S, E);
        {
            const int nwg = S.T.nwg, G = F.G, rem = nwg % G, c = (int)blockIdx.x;
            if (rem == 0) p0_prologue<true>(F, args, c, G);
            else if (c >= rem) p0_prologue<true>(F, args, c - rem, G - rem);
        }
        SEAM(1);
    }
    if (IN(2)) { phase2(F, args); SEAM(2); }
    if (IN(3)) { phase3(F, args); SEAM(3); }
    if (IN(4)) {
        Gemm g{2 * DM, 128, 2 * DM, 128, DM / 64};
        SchedMerge S; S.T.init(M_ROWS, DM, F.G, (int)blockIdx.x); S.A0 = (const char*)(ws + WS_QB); S.A1 = (const char*)(ws + WS_LGG); S.B0 = (const char*)(ws + WS_WOA); S.B1 = (const char*)(ws + WS_WOL);
        S.tA = (size_t)256 * 2 * DM; S.tB = (size_t)256 * 2 * DM;
        EpiMerge E{(const bf16_t*)F.out, (bf16_t*)(ws + WS_LX)};
        for (int rep = 0; rep < NREP(4); ++rep) gemm_phase<EpiMerge, SchedMerge>(ring, g, S, E);
        SEAM(4);
    }
    if (IN(5)) {
        Gemm g{2 * DM, 128, 2 * DM, 128, DM / 64};
        SchedSimple S; S.T.init(M_ROWS, DM, F.G, (int)blockIdx.x); S.A = (const char*)(ws + WS_LX); S.B = (const char*)(ws + WS_WOUT); S.tA = (size_t)256 * 2 * DM; S.tB = (size_t)256 * 2 * DM;
        EpiWout E{args.in[0], F.out, (bf16_t*)(ws + WS_XB), (float*)(ws + WS_SSQ)};
        for (int rep = 0; rep < NREP(5); ++rep) gemm_phase<EpiWout, SchedSimple>(ring, g, S, E);
        SEAM(5);
    }
    if (IN(6)) {
        Gemm g{2 * DM, 128, 2 * DM, 128, DM / 64};
        SchedHalfTail S; S.T.init(M_ROWS, NGU, F.G, (int)blockIdx.x); S.A = (const char*)(ws + WS_XB); S.B = (const char*)(ws + WS_WGU); S.tA = (size_t)256 * 2 * DM; S.tB = (size_t)256 * 2 * DM;
        S.full = (F.G % 8 == 0 && 2 * (S.T.nwg % F.G) <= F.G) ? S.T.nwg / F.G : (S.T.nwg + F.G - 1) / F.G;
        EpiGU E{(const float*)(ws + WS_SSQ), (bf16_t*)(ws + WS_FF)};
        for (int rep = 0; rep < NREP(6); ++rep) gemm_phase<EpiGU, SchedHalfTail, GEMM_ALIGN_P6>(ring, g, S, E);
        SEAM(6);
    }
    if (IN(7)) {
        Gemm g{2 * DFF, 128, 2 * DFF, 128, DFF / 64};
        SchedSimple S; S.T.init(M_ROWS, DM, F.G, (int)blockIdx.x); S.A = (const char*)(ws + WS_FF); S.B = (const char*)(ws + WS_WDN); S.tA = (size_t)256 * 2 * DFF; S.tB = (size_t)256 * 2 * DFF;
        EpiDown E{F.out, (const bf16_t*)(ws + WS_XB)};
        gemm_phase<EpiDown, SchedSimple>(ring, g, S, E);
#if PROBE_ID
        const unsigned now_ = (unsigned)__builtin_amdgcn_s_memrealtime();
        xcd_barrier(bar);
        if (blockIdx.x == 0 && F.tid == 0) { const unsigned* pc = (const unsigned*)(ws + WS_CTL) + 8192; float v = 0.f;
            const float c0 = (float)__hip_atomic_load(pc + 0, RLX_AGENT), c1 = (float)__hip_atomic_load(pc + 1, RLX_AGENT), c2 = (float)__hip_atomic_load(pc + 2, RLX_AGENT), c3 = (float)__hip_atomic_load(pc + 3, RLX_AGENT);
            const float c4 = (float)__hip_atomic_load(pc + 4, RLX_AGENT), c5 = (float)__hip_atomic_load(pc + 5, RLX_AGENT);
            if (PROBE_ID == 1) v = c4 / 1024.f;
            if (PROBE_ID == 2) v = 100.f * c0 / (c0 + c1 + c2 + c3);
            if (PROBE_ID == 3) v = 100.f * c1 / (c0 + c1 + c2 + c3);
            if (PROBE_ID == 4) v = 100.f * c2 / (c0 + c1 + c2 + c3);
            if (PROBE_ID == 5) v = 100.f * c3 / (c0 + c1 + c2 + c3);
            if (PROBE_ID == 6) v = 16.f * (c0 + c2 + c3) / (c4 + c5) / 100.f;
            if (PROBE_ID == 7) v = 16.f * c1 / 1024.f / 100.f;
            if (PROBE_ID >= 20 && PROBE_ID < 27) { float tot = 0.f, mine = 0.f;
                for (int i = 0; i < 7; ++i) { const float ci = (float)__hip_atomic_load(pc + 8 + i, RLX_AGENT); tot += ci; if (i == PROBE_ID - 20) mine = ci; }
                v = 100.f * mine / tot; }
            if (PROBE_ID >= 10 && PROBE_ID < 18) { const unsigned now = now_; const int k = PROBE_ID - 10;
                const unsigned t1 = k == 7 ? now : F.MISC[12 + k + 1], t0_ = F.MISC[12 + k]; v = (float)(t1 - t0_) * 0.01f; if (PROBE_ID == 10 || PROBE_ID == 16) v = 10.f + floorf(v / 20.f); if (PROBE_ID == 13) v = floorf(v * 0.5f) - 80.f; }
            const float y0 = __hip_atomic_load(F.out, RLX_AGENT); F.out[0] = y0 + v; }
#endif
    }
#undef IN
#undef SEAM
}

extern "C" void kernel_launch(void* const* d_in, const int* in_sizes, int n_in, void* d_out, int out_size, void* d_ws, size_t ws_size, hipStream_t stream) {
    static int grid = 0;
    if (grid == 0) {
        if (n_in != 29 || out_size != M_ROWS * DM || ws_size < WS_END) { fprintf(stderr, "kernel_launch: unexpected problem (n_in %d, out %d, ws %zu)\n", n_in, out_size, ws_size); grid = -1; return; }
        int dev = 0, cus = 0, per_cu = 0;
        if (hipGetDevice(&dev) != hipSuccess || hipDeviceGetAttribute(&cus, hipDeviceAttributeMultiprocessorCount, dev) != hipSuccess) { grid = -1; return; }
        if (hipFuncSetAttribute((const void*)fwd_kernel, hipFuncAttributeMaxDynamicSharedMemorySize, LDS_BYTES) != hipSuccess) { fprintf(stderr, "kernel_launch: hipFuncSetAttribute failed\n"); grid = -1; return; }
        if (hipOccupancyMaxActiveBlocksPerMultiprocessor(&per_cu, (const void*)fwd_kernel, NWAVES * 64, LDS_BYTES) != hipSuccess || per_cu < 1) { fprintf(stderr, "kernel_launch: occupancy query says %d blocks per CU\n", per_cu); grid = -1; return; }
        (void)hipGetLastError();
        grid = cus;
        if (grid > 256) grid = 256;
    }
    if (grid < 0) return;
    (void)hipMemsetAsync((char*)d_ws + WS_CTL, 0, CTL_ZERO_BYTES, stream);
    Args a{};
    for (int i = 0; i < 29; ++i) a.in[i] = (const float*)d_in[i];
    a.out = (float*)d_out; a.ws = (unsigned char*)d_ws;
#if N_LAUNCHES == 1
    a.ph_lo = 0; a.ph_hi = N_PHASES;
    hipLaunchKernelGGL(fwd_kernel, dim3(grid), dim3(NWAVES * 64), LDS_BYTES, stream, a);
#else
    for (int p = 0; p < N_PHASES; ++p) {
        a.ph_lo = p; a.ph_hi = p + 1;
        hipLaunchKernelGGL(fwd_kernel, dim3(grid), dim3(NWAVES * 64), LDS_BYTES, stream, a);
    }
#endif
}
```

```cpp
#include <hip/hip_runtime.h>
#include <cstdio>
#include <cstdint>
#ifndef N_LAUNCHES
#define N_LAUNCHES 1
#endif
#define NAIVE_P2 0
#define NAIVE_ATTN 0
#define FAST_ATTN 1
#define USE_NAIVE 0
#ifndef REP_PHASE
#define REP_PHASE -1
#endif
#ifndef PROBE_ID
#define PROBE_ID 0
#endif
#ifndef GEMM_ALIGN_P1
#define GEMM_ALIGN_P1 true
#endif
#ifndef GEMM_ALIGN_P6
#define GEMM_ALIGN_P6 true
#endif
namespace pg8 {
#define PG8_LAS __attribute__((address_space(3)))
typedef unsigned short bf16_t;
typedef short bf16x8 __attribute__((ext_vector_type(8)));
typedef float f32x4 __attribute__((ext_vector_type(4)));
typedef float f32x2 __attribute__((ext_vector_type(2)));
typedef unsigned u32x4 __attribute__((ext_vector_type(4)));
typedef unsigned u32x2 __attribute__((ext_vector_type(2)));
constexpr int BM = 256, BK = 64, HALF = 128, HTB = HALF * BK * 2  , STAGE_BYTES = 8 * HTB, NXCD = 8, WGM = 8;

__host__ __device__ __forceinline__ int lds_byte(int r, int c) { const int st = (r >> 4) * 2 + (c >> 5), rr = r & 15, cc = c & 31, ob = rr * 64 + cc * 2; return st * 1024 + (ob ^ (((ob >> 9) & 1) << 5)); }
__host__ __device__ __forceinline__ void stage_rc(int b, int& R, int& C) { const int st = b / 1024, sb = b % 1024, swz = sb ^ (((sb >> 9) & 1) << 5); R = (st >> 1) * 16 + swz / 64; C = (st & 1) * 32 + (swz % 64) / 2; }
__host__ __device__ __forceinline__ int perm32(int rho) { const int n = rho >> 4, i = rho & 15; return 8 * (i >> 2) + 4 * n + (i & 3); }

struct Unit { int pm, pn, kind, r0, half; };
struct Gemm { int rowA, kstepA, rowB, kstepB, nt; };

struct TileOrder {
    int nM, nN, nwg, G, c;
    __device__ void init(int M, int N, int G_, int c_) { nM = M / BM; nN = N / BM; nwg = nM * nN; G = G_; c = c_; }
    __device__ bool tile(int i, int& pm, int& pn) const { return tileL((long)i * G + c, pm, pn); }
    __device__ bool tileL(long L, int& pm, int& pn) const {
        if (L >= nwg) return false;
        int wgid = (int)L; { const int q = nwg / NXCD, r = nwg % NXCD, xcd = wgid % NXCD, off = wgid / NXCD; wgid = (xcd < r ? xcd * (q + 1) : r * (q + 1) + (xcd - r) * q) + off; }
        const int nig = WGM * nN, gid = wgid / nig, fm = gid * WGM, gsz = (nM - fm) < WGM ? (nM - fm) : WGM;
        pm = fm + ((wgid % nig) % gsz); pn = (wgid % nig) / gsz; return true;
    }
};

__device__ __forceinline__ unsigned cvt_pk_bf16(float lo, float hi) { unsigned r; asm volatile("v_cvt_pk_bf16_f32 %0, %1, %2" : "=v"(r) : "v"(lo), "v"(hi)); return r; }

template <class Epi, class Sched, bool ALIGN_EPI = true>
__device__ __forceinline__ void gemm_phase(PG8_LAS unsigned char* lds, const Gemm g, const Sched& S, const Epi& E) {
    const int tid = threadIdx.x, wid = __builtin_amdgcn_readfirstlane(tid >> 6), lane = tid & 63, wr = wid >> 2, wc = wid & 3, fr = lane & 15, fq = lane >> 4;
    const int nt = g.nt;
    unsigned voffA[2], voffB[2];
#pragma unroll
    for (int i = 0; i < 2; ++i) { int R, C; stage_rc(tid * 16 + i * 8192, R, C); const int Rb = Epi::PERM ? ((R & ~31) + perm32(R & 31)) : R;
        voffA[i] = (unsigned)(R * g.rowA + C * 2); voffB[i] = (unsigned)(Rb * g.rowB + C * 2); }
    const size_t kstepA = (size_t)g.kstepA, kstepB = (size_t)g.kstepB;
    const size_t hstepA = (size_t)HALF * g.rowA, hstepB = (size_t)HALF * g.rowB;
    const unsigned ldsw = (unsigned)wid * 1024u;
    const int aoff = lds_byte(wr * 64 + fr, fq * 8), boff = lds_byte(wc * 32 + fr, fq * 8);
#define PG8_SA(b, h) (((b) * 2 + (h)) * HTB)
#define PG8_SB(b, h) ((4 + (b) * 2 + (h)) * HTB)
#define PG8_STAGE(bufoff, gbase, voff) do { _Pragma("unroll") for (int _i = 0; _i < 2; ++_i) \
        __builtin_amdgcn_global_load_lds((const unsigned*)((const char*)(gbase) + (voff)[_i]), (PG8_LAS unsigned*)(lds + (bufoff) + ldsw + _i * 8192), 16, 0, 0); } while (0)
#define PG8_LDA(dst, b, h) do { _Pragma("unroll") for (int m = 0; m < 4; ++m) _Pragma("unroll") for (int k = 0; k < 2; ++k) dst[m][k] = *(const PG8_LAS bf16x8*)(lds + PG8_SA(b, h) + aoff + m * 2048 + k * 1024); } while (0)
#define PG8_LDB(dst, b, h) do { _Pragma("unroll") for (int n = 0; n < 2; ++n) _Pragma("unroll") for (int k = 0; k < 2; ++k) dst[n][k] = *(const PG8_LAS bf16x8*)(lds + PG8_SB(b, h) + boff + n * 2048 + k * 1024); } while (0)
#define PG8_MMA(ai, bj, At, Bt) do { __builtin_amdgcn_s_setprio(1); _Pragma("unroll") for (int m = 0; m < 4; ++m) _Pragma("unroll") for (int n = 0; n < 2; ++n) _Pragma("unroll") for (int k = 0; k < 2; ++k) \
        acc[ai][bj][m][n] = __builtin_amdgcn_mfma_f32_16x16x32_bf16(Bt[n][k], At[m][k], acc[ai][bj][m][n], 0, 0, 0); __builtin_amdgcn_s_setprio(0); } while (0)
#define PG8_WAIT_V(n) asm volatile("s_waitcnt vmcnt(" #n ")" ::: "memory")
#define PG8_WAIT_L(n) asm volatile("s_waitcnt lgkmcnt(" #n ")" ::: "memory")
#define PG8_BAR __builtin_amdgcn_s_barrier()
#define PG8_SCHED __builtin_amdgcn_sched_barrier(0)
    Unit cur, nxt; int ui = 0;
    if (!S.next(0, cur)) return;
    f32x4 acc[2][2][4][2];
#pragma unroll
    for (int a = 0; a < 2; ++a)
#pragma unroll
        for (int b = 0; b < 2; ++b)
#pragma unroll
            for (int m = 0; m < 4; ++m)
#pragma unroll
                for (int n = 0; n < 2; ++n) acc[a][b][m][n] = (f32x4){0.f, 0.f, 0.f, 0.f};
    bf16x8 At[4][2], B0[2][2], B1[2][2];
    const char* cA = S.abase(cur); const char* cB = S.bbase(cur);
    PG8_STAGE(PG8_SB(0, 0), cB, voffB); PG8_STAGE(PG8_SB(0, 1), cB + hstepB, voffB); PG8_STAGE(PG8_SA(0, 0), cA, voffA); PG8_STAGE(PG8_SA(0, 1), cA + hstepA, voffA);
    if (wr == 1) PG8_BAR;
    PG8_WAIT_V(2); PG8_BAR;
    PG8_STAGE(PG8_SB(1, 0), cB + kstepB, voffB); PG8_STAGE(PG8_SA(1, 0), cA + kstepA, voffA); PG8_STAGE(PG8_SB(1, 1), cB + hstepB + kstepB, voffB);
    PG8_WAIT_V(6); PG8_BAR;
    for (;;) {
        const bool has_next = S.next(ui + 1, nxt);
        const char* nA = has_next ? S.abase(nxt) : cA; const char* nB = has_next ? S.bbase(nxt) : cB;
        asm volatile(".p2align 8\n\ts_nop 0\n\ts_nop 0\n\ts_nop 0\n\ts_nop 0\n\ts_nop 0\n\ts_nop 0");
        for (int t = 0; t < nt; t += 2) {
            const bool last = (t == nt - 2);
            const char* a1 = cA + (size_t)(t + 1) * kstepA;
            const char* a2 = last ? nA : cA + (size_t)(t + 2) * kstepA; const char* b2 = last ? nB : cB + (size_t)(t + 2) * kstepB;
            const char* a3 = a2 + kstepA; const char* b3 = b2 + kstepB;
            PG8_LDB(B0, 0, 0); PG8_LDB(B1, 0, 1); PG8_SCHED; PG8_LDA(At, 0, 0); PG8_STAGE(PG8_SA(1, 1), a1 + hstepA, voffA);
            PG8_WAIT_V(8); PG8_WAIT_L(0); PG8_BAR; PG8_MMA(0, 0, At, B0); PG8_MMA(0, 1, At, B1); PG8_BAR; PG8_SCHED;
            PG8_LDA(At, 0, 1); PG8_STAGE(PG8_SB(0, 0), b2, voffB); PG8_STAGE(PG8_SB(0, 1), b2 + hstepB, voffB); PG8_STAGE(PG8_SA(0, 0), a2, voffA);
            PG8_WAIT_V(8); PG8_WAIT_L(0); PG8_BAR; if (!cur.half) { PG8_MMA(1, 0, At, B0); PG8_MMA(1, 1, At, B1); } PG8_BAR; PG8_SCHED;
            PG8_LDB(B0, 1, 0); PG8_LDB(B1, 1, 1); PG8_SCHED; PG8_LDA(At, 1, 0); PG8_STAGE(PG8_SA(0, 1), a2 + hstepA, voffA);
            PG8_WAIT_V(8); PG8_WAIT_L(0); PG8_BAR; PG8_MMA(0, 0, At, B0); PG8_MMA(0, 1, At, B1); PG8_BAR; PG8_SCHED;
            PG8_LDA(At, 1, 1); PG8_STAGE(PG8_SB(1, 0), b3, voffB); PG8_STAGE(PG8_SB(1, 1), b3 + hstepB, voffB); PG8_STAGE(PG8_SA(1, 0), a3, voffA);
            PG8_WAIT_V(8); PG8_WAIT_L(0); PG8_BAR; if (!cur.half) { PG8_MMA(1, 0, At, B0); PG8_MMA(1, 1, At, B1); } PG8_BAR; PG8_SCHED;
        }
        if constexpr (ALIGN_EPI) { if (wr == 0) PG8_BAR; }
        const bool keep = E(acc, cur, wr, wc, fr, fq);
        if (!has_next) break;
        if (!keep) {
#pragma unroll
        for (int a = 0; a < 2; ++a)
#pragma unroll
            for (int b = 0; b < 2; ++b)
#pragma unroll
                for (int m = 0; m < 4; ++m)
#pragma unroll
                    for (int n = 0; n < 2; ++n) acc[a][b][m][n] = (f32x4){0.f, 0.f, 0.f, 0.f};
        }
        cur = nxt; cA = nA; cB = nB; ++ui;
        if constexpr (ALIGN_EPI) { if (wr == 1) PG8_BAR; }
    }
    PG8_WAIT_V(0);
    if constexpr (!ALIGN_EPI) { if (wr == 0) PG8_BAR; }
    PG8_BAR;
#undef PG8_SA
#undef PG8_SB
#undef PG8_STAGE
#undef PG8_LDA
#undef PG8_LDB
#undef PG8_MMA
#undef PG8_WAIT_V
#undef PG8_WAIT_L
#undef PG8_BAR
#undef PG8_SCHED
}
}
constexpr int BATCH = 4, SEQ = 4096, DM = 1024, M_ROWS = BATCH * SEQ;
constexpr int NH = 16, HD = 64, NKV = 4, HPG = 4, KVW = 1536;
constexpr int IN_DIM = 6704, NPROJ = 6912;
constexpr int DFF = 2816, NGU = 2 * DFF;
constexpr int NCMP = 255, NCP = 256;
constexpr float EPS = 1e-6f;
constexpr float LOG2E = 1.4426950408889634f;

__device__ __forceinline__ float fast_sigmoid(float x) { return __builtin_amdgcn_rcpf(1.f + __builtin_amdgcn_exp2f(-LOG2E * x)); }
__device__ __forceinline__ float gelu_tanh(float x) { return x * fast_sigmoid(x * (1.5957691216f + 0.0713548163f * x * x)); }

namespace pg8 {
struct SchedSimple {
    TileOrder T; const char* A; const char* B; size_t tA, tB;
    __device__ __forceinline__ bool next(int i, Unit& u) const { u.kind = 0; u.half = 0; const bool ok = T.tile(i, u.pm, u.pn); u.r0 = u.pm * BM; return ok; }
    __device__ __forceinline__ const char* abase(const Unit& u) const { return A + (size_t)u.pm * tA; }
    __device__ __forceinline__ const char* bbase(const Unit& u) const { return B + (size_t)u.pn * tB; }
};
struct SchedHalfTail {
    TileOrder T; const char* A; const char* B; size_t tA, tB; int full;
    __device__ __forceinline__ bool next(int i, Unit& u) const {
        u.kind = 0;
        if (i < full) { u.half = 0; const bool ok = T.tile(i, u.pm, u.pn); u.r0 = u.pm * BM; return ok; }
        if (i > full) return false;
        const int idx = T.c >> 3, lab = T.c & 7;
        const bool ok = T.tileL((long)full * T.G + 8 * (idx >> 1) + lab, u.pm, u.pn); u.half = 1; u.r0 = u.pm * BM + (idx & 1) * HALF; return ok;
    }
    __device__ __forceinline__ const char* abase(const Unit& u) const { return A + (size_t)u.r0 * (tA / BM); }
    __device__ __forceinline__ const char* bbase(const Unit& u) const { return B + (size_t)u.pn * tB; }
};
struct SchedMerge {
    TileOrder T; const char* A0; const char* A1; const char* B0; const char* B1; size_t tA, tB;
    __device__ __forceinline__ bool next(int i, Unit& u) const { u.kind = i & 1; u.half = 0; const bool ok = T.tile(i >> 1, u.pm, u.pn); u.r0 = u.pm * BM; return ok; }
    __device__ __forceinline__ const char* abase(const Unit& u) const { return (u.kind ? A1 : A0) + (size_t)u.pm * tA; }
    __device__ __forceinline__ const char* bbase(const Unit& u) const { return (u.kind ? B1 : B0) + (size_t)u.pn * tB; }
};

typedef f32x4 Acc[2][2][4][2];
#define EPI_ROW(ai, m) (u.r0 + (ai) * HALF + wr * 64 + (m) * 16 + fr)
#define EPI_CT(bj) ((bj) * HALF + wc * 32 + 8 * fq)

__device__ __forceinline__ u32x4 pack8(f32x4 a, f32x4 b) { u32x4 w; w.x = cvt_pk_bf16(a[0], a[1]); w.y = cvt_pk_bf16(a[2], a[3]); w.z = cvt_pk_bf16(b[0], b[1]); w.w = cvt_pk_bf16(b[2], b[3]); return w; }

struct EpiProj {
    static constexpr bool PERM = true;
    const float* rstd; bf16_t *QB, *KVB, *NG, *LX, *LGG, *MG;
    __device__ __forceinline__ bool operator()(Acc& acc, const Unit& u, int wr, int wc, int fr, int fq) const {
        const int pn = u.pn; bf16_t* dst; int ld, c0, act = 0, lim = 256;
        if (pn < 4) { dst = QB; ld = DM; c0 = pn * 256; }
        else if (pn < 10) { dst = KVB; ld = KVW; c0 = (pn - 4) * 256; }
        else if (pn == 10) { dst = NG; ld = 48; c0 = 0; act = 1; lim = 48; }
        else if (pn < 15) { dst = LX; ld = DM; c0 = (pn - 11) * 256; act = 3; }
        else if (pn < 19) { dst = LGG; ld = DM; c0 = (pn - 15) * 256; act = 2; }
        else {
            bf16_t* MGp = MG + (pn - 19) * 128;
#pragma unroll
            for (int ai = 0; ai < 2; ++ai)
#pragma unroll
                for (int m = 0; m < 4; ++m) {
                    const int row = EPI_ROW(ai, m); const float rs = rstd[row];
                    f32x4 a0 = acc[ai][0][m][0] * rs, a1 = acc[ai][0][m][1] * rs, b0 = acc[ai][1][m][0] * rs, b1 = acc[ai][1][m][1] * rs;
#pragma unroll
                    for (int e = 0; e < 4; ++e) { a0[e] = fast_sigmoid(a0[e]); a1[e] = fast_sigmoid(a1[e]); b0[e] = fast_sigmoid(b0[e]); b1[e] = fast_sigmoid(b1[e]); }
                    const u32x4 w1 = pack8(b0, b1);
                    b0[0] = __uint_as_float(w1.x << 16); b0[1] = __uint_as_float(w1.x & 0xffff0000u); b0[2] = __uint_as_float(w1.y << 16); b0[3] = __uint_as_float(w1.y & 0xffff0000u);
                    b1[0] = __uint_as_float(w1.z << 16); b1[1] = __uint_as_float(w1.z & 0xffff0000u); b1[2] = __uint_as_float(w1.w << 16); b1[3] = __uint_as_float(w1.w & 0xffff0000u);
#pragma unroll
                    for (int e = 0; e < 4; ++e) { a0[e] *= __builtin_amdgcn_rcpf(fmaxf(b0[e], 8.6736174e-19f)); a1[e] *= __builtin_amdgcn_rcpf(fmaxf(b1[e], 8.6736174e-19f)); }
                    bf16_t* q = MGp + (size_t)row * (2 * DM) + wc * 32 + 8 * fq;
                    *(u32x4*)q = pack8(a0, a1); *(u32x4*)(q + DM) = w1;
                }
            return false;
        }
#pragma unroll
        for (int ai = 0; ai < 2; ++ai)
#pragma unroll
            for (int m = 0; m < 4; ++m) {
                const int row = EPI_ROW(ai, m); const float rs = rstd[row];
#pragma unroll
                for (int bj = 0; bj < 2; ++bj) {
                    const int ct = EPI_CT(bj);
                    f32x4 v0 = acc[ai][bj][m][0] * rs, v1 = acc[ai][bj][m][1] * rs;
                    if (act == 1) {
#pragma unroll
                        for (int e = 0; e < 4; ++e) { v0[e] = fast_sigmoid(v0[e]); v1[e] = fast_sigmoid(v1[e]); }
                    } else if (act == 2) {
#pragma unroll
                        for (int e = 0; e < 4; ++e) { v0[e] = gelu_tanh(v0[e]); v1[e] = gelu_tanh(v1[e]); }
                    }
                    u32x4 pk;
                    if (act == 3) { pk.x = __builtin_bit_cast(unsigned, __builtin_amdgcn_cvt_pkrtz(v0[0], v0[1])); pk.y = __builtin_bit_cast(unsigned, __builtin_amdgcn_cvt_pkrtz(v0[2], v0[3]));
                                    pk.z = __builtin_bit_cast(unsigned, __builtin_amdgcn_cvt_pkrtz(v1[0], v1[1])); pk.w = __builtin_bit_cast(unsigned, __builtin_amdgcn_cvt_pkrtz(v1[2], v1[3])); }
                    else pk = pack8(v0, v1);
                    if (ct + 8 <= lim) *(u32x4*)(dst + (size_t)row * ld + c0 + ct) = pk;
                }
            }
        return false;
    }
};

struct EpiMerge {
    static constexpr bool PERM = true;
    const bf16_t* MG; bf16_t* MRG;
    __device__ __forceinline__ bool operator()(Acc& acc, const Unit& u, int wr, int wc, int fr, int fq) const {
        const bf16_t* MGp = MG; bf16_t* MRGp = MRG;
        asm volatile("" : "+s"(MGp), "+s"(MRGp));
#pragma unroll
        for (int ai = 0; ai < 2; ++ai)
#pragma unroll
            for (int m = 0; m < 4; ++m) {
                const int row = EPI_ROW(ai, m);
#pragma unroll
                for (int bj = 0; bj < 2; ++bj) {
                    const int col = u.pn * BM + EPI_CT(bj);
                    if (u.kind == 0) {
                        const u32x4 w0 = *(const u32x4*)(MGp + (size_t)row * (2 * DM) + col);
                        f32x4 a0, a1;
                        a0[0] = __uint_as_float(w0.x << 16); a0[1] = __uint_as_float(w0.x & 0xffff0000u); a0[2] = __uint_as_float(w0.y << 16); a0[3] = __uint_as_float(w0.y & 0xffff0000u);
                        a1[0] = __uint_as_float(w0.z << 16); a1[1] = __uint_as_float(w0.z & 0xffff0000u); a1[2] = __uint_as_float(w0.w << 16); a1[3] = __uint_as_float(w0.w & 0xffff0000u);
                        acc[ai][bj][m][0] *= a0; acc[ai][bj][m][1] *= a1;
                    } else {
                        const u32x4 w1 = *(const u32x4*)(MGp + (size_t)row * (2 * DM) + DM + col);
                        f32x4 b0, b1;
                        b0[0] = __uint_as_float(w1.x << 16); b0[1] = __uint_as_float(w1.x & 0xffff0000u); b0[2] = __uint_as_float(w1.y << 16); b0[3] = __uint_as_float(w1.y & 0xffff0000u);
                        b1[0] = __uint_as_float(w1.z << 16); b1[1] = __uint_as_float(w1.z & 0xffff0000u); b1[2] = __uint_as_float(w1.w << 16); b1[3] = __uint_as_float(w1.w & 0xffff0000u);
#pragma unroll
                        for (int e = 0; e < 4; ++e) { b0[e] = fmaxf(b0[e], 8.6736174e-19f); b1[e] = fmaxf(b1[e], 8.6736174e-19f); }
                        *(u32x4*)(MRGp + (size_t)row * DM + col) = pack8(acc[ai][bj][m][0] * b0, acc[ai][bj][m][1] * b1);
                    }
                }
                asm volatile("" ::: "memory");
            }
        return u.kind == 0;
    }
};

struct EpiWout {
    static constexpr bool PERM = true;
    const float* x; float* out; bf16_t* X1B; float* ssq;
    __device__ __forceinline__ bool operator()(Acc& acc, const Unit& u, int wr, int wc, int fr, int fq) const {
#pragma unroll
        for (int ai = 0; ai < 2; ++ai)
#pragma unroll
            for (int m = 0; m < 4; ++m) {
                const int row = EPI_ROW(ai, m); float s = 0.f;
#pragma unroll
                for (int bj = 0; bj < 2; ++bj) {
                    const int col = u.pn * BM + EPI_CT(bj); const size_t off = (size_t)row * DM + col;
                    const f32x4 v0 = *(const f32x4*)(x + off) + acc[ai][bj][m][0], v1 = *(const f32x4*)(x + off + 4) + acc[ai][bj][m][1];
                    *(u32x4*)(X1B + off) = pack8(v0, v1);
                    s += (v0[0] * v0[0] + v0[1] * v0[1]) + (v0[2] * v0[2] + v0[3] * v0[3]) + (v1[0] * v1[0] + v1[1] * v1[1]) + (v1[2] * v1[2] + v1[3] * v1[3]);
                }
                s += __shfl_xor(s, 16); s += __shfl_xor(s, 32);
                if (fq == 0) ssq[(size_t)row * 16 + u.pn * 4 + wc] = s;
            }
        return false;
    }
};

struct EpiGU {
    static constexpr bool PERM = true;
    const float* ssq; bf16_t* FF;
    __device__ __forceinline__ bool operator()(Acc& acc, const Unit& u, int wr, int wc, int fr, int fq) const {
#pragma unroll
        for (int ai = 0; ai < 2; ++ai)
            if (ai == 0 || !u.half)
#pragma unroll
            for (int m = 0; m < 4; ++m) {
                const int row = EPI_ROW(ai, m);
                const f32x4* sp = (const f32x4*)(ssq + (size_t)row * 16);
                const f32x4 s0 = sp[0], s1 = sp[1], s2 = sp[2], s3 = sp[3];
                const float tot = ((s0[0] + s0[1]) + (s0[2] + s0[3])) + ((s1[0] + s1[1]) + (s1[2] + s1[3])) + ((s2[0] + s2[1]) + (s2[2] + s2[3])) + ((s3[0] + s3[1]) + (s3[2] + s3[3]));
                const float rs = __builtin_amdgcn_rsqf(tot * (1.f / DM) + EPS);
                f32x4 o[2];
#pragma unroll
                for (int n = 0; n < 2; ++n)
#pragma unroll
                    for (int e = 0; e < 4; ++e) { const float g = acc[ai][0][m][n][e] * rs, up = acc[ai][1][m][n][e] * rs; o[n][e] = g * fast_sigmoid(g) * up; }
                *(u32x4*)(FF + (size_t)row * DFF + u.pn * HALF + wc * 32 + 8 * fq) = pack8(o[0], o[1]);
            }
        return false;
    }
};

struct EpiDown {
    static constexpr bool PERM = true;
    float* out; const bf16_t* X1B;
    __device__ __forceinline__ bool operator()(Acc& acc, const Unit& u, int wr, int wc, int fr, int fq) const {
#pragma unroll
        for (int ai = 0; ai < 2; ++ai)
#pragma unroll
            for (int m = 0; m < 4; ++m) {
                const int row = EPI_ROW(ai, m);
#pragma unroll
                for (int bj = 0; bj < 2; ++bj) {
                    const size_t off = (size_t)row * DM + u.pn * BM + EPI_CT(bj);
                    const u32x4 xw = *(const u32x4*)(X1B + off);
                    f32x4 x0, x1;
                    x0[0] = __uint_as_float(xw.x << 16); x0[1] = __uint_as_float(xw.x & 0xffff0000u); x0[2] = __uint_as_float(xw.y << 16); x0[3] = __uint_as_float(xw.y & 0xffff0000u);
                    x1[0] = __uint_as_float(xw.z << 16); x1[1] = __uint_as_float(xw.z & 0xffff0000u); x1[2] = __uint_as_float(xw.w << 16); x1[3] = __uint_as_float(xw.w & 0xffff0000u);
                    *(f32x4*)(out + off) = x0 + acc[ai][bj][m][0]; *(f32x4*)(out + off + 4) = x1 + acc[ai][bj][m][1];
                }
            }
        return false;
    }
};
#undef EPI_ROW
#undef EPI_CT
}
constexpr size_t MiB = 1u << 20;
constexpr size_t WS_CTL = 0, CTL_ZERO_BYTES = 1 * MiB;
constexpr size_t WS_NG = 1 * MiB;
constexpr size_t WS_RSTD1 = 3 * MiB;
constexpr size_t WS_SSQ = 4 * MiB;
constexpr size_t WS_KC = 5 * MiB;
constexpr size_t WS_VC = 5 * MiB + 512 * 1024;
constexpr size_t WS_LSUM = 6 * MiB;
constexpr size_t WS_CW2 = 7 * MiB;
constexpr size_t WS_LW = 7 * MiB + 256 * 1024;
constexpr size_t WS_HID = 8 * MiB;
constexpr size_t WS_CW1 = 12 * MiB;
constexpr size_t WS_WOA = 14 * MiB, WS_WOL = 16 * MiB, WS_WOUT = 18 * MiB;
constexpr size_t WS_WDN = 20 * MiB;
constexpr size_t WS_WGU = 26 * MiB;
constexpr size_t WS_WIN = 37 * MiB;
constexpr size_t WS_XB = 51 * MiB;
constexpr size_t WS_HL = 51 * MiB;
constexpr size_t WS_PC0 = 227 * MiB;
constexpr size_t WS_PC3 = 37 * MiB;
constexpr size_t WS_QB = 83 * MiB;
constexpr size_t WS_KVB = 115 * MiB;
constexpr size_t WS_LX = 163 * MiB;
constexpr size_t WS_LGG = 195 * MiB;
constexpr size_t WS_MRGF = 83 * MiB;
constexpr size_t WS_FF = 83 * MiB;
constexpr size_t WS_END = 251 * MiB;

constexpr int CW_BAR = 4096;
constexpr int CW_QUEUE = 16384;

constexpr int RING_BYTES = 131072;
constexpr int LDSCTL_OFF = RING_BYTES, MISC_OFF = LDSCTL_OFF + 320;
constexpr int LDS_BYTES = 147456;
constexpr int NWAVES = 8;

#define GAS __attribute__((address_space(1)))
#define LAS __attribute__((address_space(3)))
typedef unsigned short bf16;
typedef unsigned v4u __attribute__((ext_vector_type(4)));
typedef unsigned v2u __attribute__((ext_vector_type(2)));
typedef float f32x4 __attribute__((ext_vector_type(4)));
typedef short bf16x8 __attribute__((ext_vector_type(8)));
typedef GAS unsigned gu32;
#define RLX_AGENT __ATOMIC_RELAXED, __HIP_MEMORY_SCOPE_AGENT
#define LDS_WAIT() asm volatile("s_waitcnt lgkmcnt(0)" ::: "memory")
#define VM_WAIT() asm volatile("s_waitcnt vmcnt(0)" ::: "memory")
__device__ __forceinline__ unsigned f2bf(float f) { unsigned u = __builtin_bit_cast(unsigned, f); return (u + 0x7fffu + ((u >> 16) & 1u)) >> 16; }
__device__ __forceinline__ unsigned pk2(float lo, float hi) { return f2bf(lo) | (f2bf(hi) << 16); }
__device__ __forceinline__ float bf2f(unsigned short h) { return __uint_as_float((unsigned)h << 16); }
__device__ __forceinline__ float bflo(unsigned w) { return __uint_as_float(w << 16); }
__device__ __forceinline__ float bfhi(unsigned w) { return __uint_as_float(w & 0xffff0000u); }

#define XB_TMO      128
#define XB_XCNT(j)  (256  + 64 * (j))
#define XB_XSUB(j)  (1280 + 64 * (j))
#define XB_XGEN(j)  (2304 + 64 * (j))
#define XB_TOP      3328
#define XB_TOPGEN   3392
#define XCD_BAR_WORDS 3456
#define XB_SPIN_CAP (1u << 20)
__device__ __forceinline__ unsigned xb_ld(unsigned* p)              { return __hip_atomic_load(p, __ATOMIC_RELAXED, __HIP_MEMORY_SCOPE_AGENT); }
__device__ __forceinline__ unsigned xb_add(unsigned* p, unsigned v) { return __hip_atomic_fetch_add(p, v, __ATOMIC_RELAXED, __HIP_MEMORY_SCOPE_AGENT); }
__device__ __forceinline__ unsigned xb_xcc_id() { return (unsigned)__builtin_amdgcn_s_getreg((3 << 11) | 20) & 0xFu; }
#define XB_SPIN(cond, bar) do { unsigned _sp = 0; while (cond) { __builtin_amdgcn_s_sleep(1); \
    if ((++_sp & 255u) == 0u) { if (xb_ld(&(bar)[XB_TMO])) break; if (_sp > XB_SPIN_CAP) { atomicAdd(&(bar)[XB_TMO], 1u); break; } } } } while (0)
struct XcdBarrier { unsigned* bar; unsigned x; volatile LAS unsigned* st; };
__device__ __forceinline__ XcdBarrier xcd_barrier_post(unsigned* bar, volatile LAS unsigned* st) {
    XcdBarrier b; b.bar = bar; b.x = xb_xcc_id(); b.st = st;
    if (threadIdx.x == 0) (void)xb_add(&bar[XB_XCNT(b.x)], 1u);
    return b;
}
__device__ __forceinline__ void xcd_barrier_complete(unsigned* bar, unsigned x, unsigned& nloc, unsigned& nx) {
    const unsigned G = gridDim.x * gridDim.y * gridDim.z;
    unsigned sum, cnt, mine, sp = 0u;
    for (;;) {
        sum = 0u; cnt = 0u; mine = 0u;
#pragma unroll
        for (unsigned j = 0; j < 16; ++j) { const unsigned c = xb_ld(&bar[XB_XCNT(j)]); sum += c; cnt += (c > 0u) ? 1u : 0u; mine = (j == x) ? c : mine; }
        if (sum == G) break;
        __builtin_amdgcn_s_sleep(1);
        if ((++sp & 255u) == 0u) { if (xb_ld(&bar[XB_TMO])) break; if (sp > XB_SPIN_CAP) { atomicAdd(&bar[XB_TMO], 1u); break; } }
    }
    nloc = mine > 0u ? mine : 1u; nx = cnt > 0u ? cnt : 1u;
}
__device__ __forceinline__ void xcd_barrier(const XcdBarrier& b) {
    asm volatile("s_waitcnt vmcnt(0)" ::: "memory");
    __syncthreads();
    if (threadIdx.x == 0) {
        unsigned* bar = b.bar;
        __builtin_amdgcn_s_waitcnt(0);
        unsigned nloc = b.st[0], nx = b.st[1];
        if (nloc == 0u) { xcd_barrier_complete(bar, b.x, nloc, nx); b.st[0] = nloc; b.st[1] = nx; }
        const unsigned old = xb_add(&bar[XB_XSUB(b.x)], 1u);
        const unsigned gen = old / nloc;
        if (old + 1u == (gen + 1u) * nloc) {
            __builtin_amdgcn_fence(__ATOMIC_RELEASE, "agent");
            asm volatile("s_waitcnt vmcnt(0)" ::: "memory");
            const unsigned og = xb_add(&bar[XB_TOP], 1u);
            const unsigned tg = og / nx;
            if (og + 1u == (tg + 1u) * nx) xb_add(&bar[XB_TOPGEN], 1u);
            else XB_SPIN(xb_ld(&bar[XB_TOPGEN]) == tg, bar);
            __builtin_amdgcn_fence(__ATOMIC_ACQUIRE, "agent");
            xb_add(&bar[XB_XGEN(b.x)], 1u);
            asm volatile("s_waitcnt vmcnt(0)" ::: "memory");
        } else {
            XB_SPIN(xb_ld(&bar[XB_XGEN(b.x)]) == gen, bar);
            __builtin_amdgcn_fence(__ATOMIC_ACQUIRE, "agent");
            asm volatile("s_waitcnt vmcnt(0)" ::: "memory");
        }
    }
    __syncthreads();
}

struct Frame {
    LAS unsigned char* lds;
    volatile LAS unsigned* MISC;
    gu32* ctl;
    int tid, lane, wave, vcu, G, grp;
    float* out; unsigned char* ws;
};
struct Args { const float* in[29]; float* out; unsigned char* ws; int ph_lo, ph_hi; };
__device__ __forceinline__ float wave_sum(float v) {
#pragma unroll
    for (int o = 1; o < 64; o <<= 1) v += __shfl_xor(v, o);
    return v;
}

struct ConvItem { const float* W; const float* gk; bf16* WT; int ldw, k0, nsrc, nvalid, ldt, ndst, fragmajor; };
constexpr int I_IN = (NPROJ / 32) * 16, I_SQ = 32 * 16, I_GU = (DFF / 32) * 16, I_DN = 32 * (DFF / 64), I_C1 = 8 * 32, I_C2 = 2 * 4, I_LW = 16 * 2;
constexpr int I_EARLY = I_IN + 2 * I_C1 + 2 * I_C2 + 2 * I_LW + I_GU, I_LATE = I_GU + 3 * I_SQ + I_DN;
__device__ __forceinline__ ConvItem p0_item(const Args& A, unsigned char* ws, int r) {
    ConvItem d; d.gk = nullptr; d.nvalid = 32; d.fragmajor = 0;
    if (r < I_IN) { const int nb = r % (NPROJ / 32), kb = r / (NPROJ / 32); int nsrc, nv = 32;
        if (nb < 80) nsrc = 32 * nb; else if (nb < 88) { nsrc = 2560 + 32 * (nb - 80); nv = 48 - 32 * (nb - 80); nv = nv < 0 ? 0 : (nv > 32 ? 32 : nv); } else if (nb < 152) nsrc = 2608 + 32 * (nb - 88);
        else { const int dc = 32 * (nb - 152), j = dc >> 8, w = dc & 255; nsrc = 2608 + 2048 + (w >> 7) * 1024 + 128 * j + (w & 127); }
        d.W = A.in[2]; d.ldw = IN_DIM; d.k0 = 64 * kb; d.nsrc = nsrc; d.nvalid = nv; d.WT = (bf16*)(ws + WS_WIN); d.ldt = DM; d.ndst = 32 * nb; d.gk = A.in[1]; return d; }
    r -= I_IN;
    if (r < 2 * I_C1) { const int w = r / I_C1, q = r % I_C1, nb = q % 8, kb = q / 8;
        d.W = w == 0 ? A.in[6] : A.in[11]; d.ldw = 256; d.k0 = 64 * kb; d.nsrc = 32 * nb; d.WT = (bf16*)(ws + WS_CW1) + (size_t)w * 256 * 2048; d.ldt = 2048; d.ndst = 32 * nb; d.fragmajor = 1; return d; }
    r -= 2 * I_C1;
    if (r < 2 * I_C2) { const int w = r / I_C2, q = r % I_C2, nb = q % 2, kb = q / 2;
        d.W = w == 0 ? A.in[8] : A.in[13]; d.ldw = 64; d.k0 = 64 * kb; d.nsrc = 32 * nb; d.WT = (bf16*)(ws + WS_CW2) + (size_t)w * 64 * 256; d.ldt = 256; d.ndst = 32 * nb; return d; }
    r -= 2 * I_C2;
    if (r < 2 * I_LW) { const int w = r / I_LW, q = r % I_LW, nb = q % 2, blk = q / 2;
        d.W = (w == 0 ? A.in[17] : A.in[19]) + (size_t)blk * 4096; d.ldw = 64; d.k0 = 0; d.nsrc = 32 * nb; d.WT = (bf16*)(ws + WS_LW) + (size_t)(w * 16 + blk) * 4096; d.ldt = 64; d.ndst = 32 * nb; return d; }
    r -= 2 * I_LW;
    if (r < 2 * I_GU) { const int w = r / I_GU, q = r % I_GU, nb = q % (DFF / 32), kb = q / (DFF / 32); const int c = 32 * nb;
        d.W = w == 0 ? A.in[26] : A.in[27]; d.ldw = DFF; d.k0 = 64 * kb; d.nsrc = c; d.WT = (bf16*)(ws + WS_WGU); d.ldt = DM; d.ndst = 256 * (c / 128) + (c % 128) + 128 * w; d.gk = A.in[25]; return d; }
    r -= 2 * I_GU;
    if (r < 3 * I_SQ) { const int w = r / I_SQ, q = r % I_SQ, nb = q % 32, kb = q / 32;
        d.W = w == 0 ? A.in[22] : (w == 1 ? A.in[23] : A.in[24]); d.WT = (bf16*)(ws + (w == 0 ? WS_WOA : (w == 1 ? WS_WOL : WS_WOUT)));
        d.ldw = DM; d.k0 = 64 * kb; d.nsrc = 32 * nb; d.ldt = DM; d.ndst = 32 * nb; return d; }
    r -= 3 * I_SQ;
    { const int nb = r % 32, kb = r / 32;
        d.W = A.in[28]; d.ldw = DM; d.k0 = 64 * kb; d.nsrc = 32 * nb; d.WT = (bf16*)(ws + WS_WDN); d.ldt = DFF; d.ndst = 32 * nb; return d; }
}
__device__ __forceinline__ void p0_item_load(const ConvItem& d, f32x4* v, int lane) {
    const int kr = lane >> 3, cc = lane & 7; const bool ok = 4 * cc < d.nvalid;
    const float* wp = d.W + (size_t)(d.k0 + kr) * d.ldw + d.nsrc + (ok ? 4 * cc : 0);
#pragma unroll
    for (int i = 0; i < 8; ++i) v[i] = __builtin_nontemporal_load((const f32x4*)(wp + (size_t)(8 * i) * d.ldw));
}
__device__ __forceinline__ void p0_item_finish(const ConvItem& d, const f32x4* v, LAS float* scr, int lane) {
    { const int kr = lane >> 3, cc = lane & 7; const bool ok = 4 * cc < d.nvalid;
#pragma unroll
      for (int i = 0; i < 8; ++i) { const int kk = 8 * i + kr; f32x4 x = ok ? v[i] : (f32x4){0.f, 0.f, 0.f, 0.f}; if (d.gk) x = x * d.gk[d.k0 + kk];
          LAS float* q = scr + kk * 33 + 4 * cc; q[0] = x[0]; q[1] = x[1]; q[2] = x[2]; q[3] = x[3]; } }
    LDS_WAIT(); asm volatile("" ::: "memory");
    const int c = lane & 7;
#pragma unroll
    for (int j = 0; j < 4; ++j) { const int n = (lane >> 3) + 8 * j; const LAS float* s = scr + (8 * c) * 33 + n;
        v4u o; o.x = pk2(s[0 * 33], s[1 * 33]); o.y = pk2(s[2 * 33], s[3 * 33]); o.z = pk2(s[4 * 33], s[5 * 33]); o.w = pk2(s[6 * 33], s[7 * 33]);
        if (d.fragmajor) { const int nn = d.ndst + n, k8 = (d.k0 >> 3) + c;
            *(GAS v4u*)(d.WT + ((((size_t)(nn >> 5) * (d.ldt >> 4) + (k8 >> 1)) * 64 + (k8 & 1) * 32 + (nn & 31)) << 3)) = o; }
        else *(GAS v4u*)(d.WT + (size_t)(d.ndst + n) * d.ldt + d.k0 + 8 * c) = o; }
    LDS_WAIT(); asm volatile("" ::: "memory");
}
template <bool LATE>
__device__ __forceinline__ void p0_prologue(Frame& F, const Args& A, int hrank = 0, int nhelp = 0) {
    LAS float* scr = (LAS float*)(F.lds + F.wave * 16384);
    const int gw = LATE ? hrank * NWAVES + F.wave : F.vcu * NWAVES + F.wave, NGW = LATE ? nhelp * NWAVES : F.G * NWAVES;
    unsigned char* ws = F.ws;
    const int NITEMS = LATE ? I_LATE : I_EARLY, ibase = LATE ? I_EARLY : 0;
    if (gw < NITEMS) {
        f32x4 v[8]; ConvItem cur = p0_item(A, ws, ibase + gw); p0_item_load(cur, v, F.lane);
        for (int it = gw; it < NITEMS; it += NGW) {
            const int nx = it + NGW; f32x4 vn[8]; ConvItem nxt = cur;
            if (nx < NITEMS) nxt = p0_item(A, ws, ibase + nx);
            p0_item_load(nxt, vn, F.lane);
            p0_item_finish(cur, v, scr, F.lane);
            cur = nxt;
#pragma unroll
            for (int i = 0; i < 8; ++i) v[i] = vn[i];
        }
    }
    if (LATE) return;
    const float* x = A.in[0]; bf16* XB = (bf16*)(ws + WS_XB); float* rstd = (float*)(ws + WS_RSTD1);
    for (int rep_ = 0; rep_ < (REP_PHASE == 31 ? 2 : 1); ++rep_)
    for (int m0 = gw; m0 < M_ROWS; m0 += 4 * NGW) {
        f32x4 v[4][4];
#pragma unroll
        for (int r = 0; r < 4; ++r) { const int m = m0 + r * NGW < M_ROWS ? m0 + r * NGW : m0; const GAS f32x4* xr = (const GAS f32x4*)(x + (size_t)m * DM) + 2 * F.lane;
#pragma unroll
            for (int j = 0; j < 4; ++j) v[r][j] = __builtin_nontemporal_load(xr + 128 * (j >> 1) + (j & 1)); }
#pragma unroll
        for (int r = 0; r < 4; ++r) { const int m = m0 + r * NGW; if (m < M_ROWS) {
            float s = 0.f;
#pragma unroll
            for (int j = 0; j < 4; ++j) s += (v[r][j].x * v[r][j].x + v[r][j].y * v[r][j].y) + (v[r][j].z * v[r][j].z + v[r][j].w * v[r][j].w);
            s = wave_sum(s);
            if (F.lane == 0) rstd[m] = 1.0f / sqrtf(s * (1.f / DM) + EPS);
            GAS v4u* o16 = (GAS v4u*)(XB + (size_t)m * DM) + F.lane;
#pragma unroll
            for (int hf = 0; hf < 2; ++hf) { v4u o; o.x = pk2(v[r][2 * hf].x, v[r][2 * hf].y); o.y = pk2(v[r][2 * hf].z, v[r][2 * hf].w); o.z = pk2(v[r][2 * hf + 1].x, v[r][2 * hf + 1].y); o.w = pk2(v[r][2 * hf + 1].z, v[r][2 * hf + 1].w);
                o16[64 * hf] = o; } } }
    }
}
typedef float f32x16 __attribute__((ext_vector_type(16)));
typedef short s16x4 __attribute__((ext_vector_type(4)));
__device__ __forceinline__ int crow(int r, int hi) { return (r & 3) + 8 * (r >> 2) + 4 * hi; }
__device__ __forceinline__ unsigned cvtpk(float lo, float hi) { unsigned r; asm volatile("v_cvt_pk_bf16_f32 %0, %1, %2" : "=v"(r) : "v"(lo), "v"(hi)); return r; }
__device__ __forceinline__ bf16x8 pack_bf8(const float* v) { v4u w; w.x = cvtpk(v[0], v[1]); w.y = cvtpk(v[2], v[3]); w.z = cvtpk(v[4], v[5]); w.w = cvtpk(v[6], v[7]); return __builtin_bit_cast(bf16x8, w); }
__device__ __forceinline__ void unpack_bf8(v4u w, float* v) { v[0] = bflo(w.x); v[1] = bfhi(w.x); v[2] = bflo(w.y); v[3] = bfhi(w.y); v[4] = bflo(w.z); v[5] = bfhi(w.z); v[6] = bflo(w.w); v[7] = bfhi(w.w); }

__device__ __forceinline__ void p2_knorm(Frame& F, const Args& A) {
    const int idx = F.vcu * 512 + F.tid;
    for (int it = idx; it < M_ROWS * 8; it += F.G * 512) {
        const int m = it >> 3, s = (it >> 2) & 1, g = it & 3, set = s ? 4 : 2;
        bf16* p = (bf16*)(F.ws + WS_KVB) + (size_t)m * KVW + set * 256 + g * 64; const float* gw = A.in[4] + (s ? 2 : 1) * 64;
        v4u w[8]; float ss = 0.f;
#pragma unroll
        for (int c = 0; c < 8; ++c) { w[c] = *(const v4u*)(p + 8 * c); float v[8]; unpack_bf8(w[c], v);
#pragma unroll
            for (int e = 0; e < 8; ++e) ss += v[e] * v[e]; }
        const float r = 1.0f / sqrtf(ss * (1.f / 64) + EPS);
#pragma unroll
        for (int c = 0; c < 8; ++c) { float v[8]; unpack_bf8(w[c], v); const f32x4 g0 = *(const f32x4*)(gw + 8 * c), g1 = *(const f32x4*)(gw + 8 * c + 4);
            v[0] *= r * g0[0]; v[1] *= r * g0[1]; v[2] *= r * g0[2]; v[3] *= r * g0[3]; v[4] *= r * g1[0]; v[5] *= r * g1[1]; v[6] *= r * g1[2]; v[7] *= r * g1[3];
            *(bf16x8*)(p + 8 * c) = pack_bf8(v); }
    }
}

constexpr int HID_LD = 264, CMP_A_OFF = 0, CMP_POS_OFF = 528 * 128, CMP_HID_OFF = 113664;
__device__ __forceinline__ void p2_compress(Frame& F, const Args& A, int unit) {
    const int set = unit >> 7, bg = (unit >> 3) & 15, oct = unit & 7, b = bg >> 2, g = bg & 3;
    const int lane = F.lane, w = F.wave, r32 = lane & 31, hi = lane >> 5, n0 = oct * 32;
    LAS unsigned char* lds = F.lds;
    { const bf16* kvb = (const bf16*)(F.ws + WS_KVB) + (size_t)(b * SEQ + 16 * n0) * KVW + set * 256 + g * 64;
      for (int q = w; q < 66; q += NWAVES) { const int R = 8 * q + (lane >> 3), c = (lane & 7) ^ ((R >> 4) & 7);
          __builtin_amdgcn_global_load_lds((const unsigned*)(kvb + (size_t)R * KVW + c * 8), (LAS unsigned*)(lds + CMP_A_OFF + q * 1024), 16, 0, 0); } }
    { const float* pos = set ? A.in[10] : A.in[5]; const f32x4 p = *(const f32x4*)(pos + 4 * F.tid); v2u pk; pk.x = cvtpk(p[0], p[1]); pk.y = cvtpk(p[2], p[3]);
      *(LAS v2u*)(lds + CMP_POS_OFF + 8 * F.tid) = pk; }
    const bf16* w1f = (const bf16*)(F.ws + WS_CW1) + ((size_t)(set * 8 + w) * 128 * 64 + lane) * 8;
    bf16x8 bq[8];
#pragma unroll
    for (int i = 0; i < 8; ++i) bq[i] = *(const bf16x8*)(w1f + (size_t)i * 512);
    asm volatile("s_waitcnt vmcnt(8)" ::: "memory");
    __syncthreads();
    f32x16 acc, acc2;
#pragma unroll
    for (int i = 0; i < 16; ++i) { acc[i] = 0.f; acc2[i] = 0.f; }
    const LAS unsigned char* arow = lds + CMP_A_OFF + r32 * 2048;
    const LAS unsigned char* prow = lds + CMP_POS_OFF + 16 * hi;
#pragma unroll 1
    for (int k8 = 0; k8 < 16; ++k8) {
        bf16x8 bn[8];
        const int kn = k8 < 15 ? k8 + 1 : 15;
#pragma unroll
        for (int i = 0; i < 8; ++i) bn[i] = *(const bf16x8*)(w1f + (size_t)(kn * 8 + i) * 512);
#pragma unroll
        for (int i = 0; i < 8; ++i) {
            const int lt = 2 * k8 + (i >> 2), kq = i & 3;
            const int key = (r32 + (k8 >> 3)) & 7;
            const bf16x8 af = *(const LAS bf16x8*)(arow + lt * 128 + (((2 * kq + hi) ^ key) << 4));
            const bf16x8 pf = *(const LAS bf16x8*)(prow + lt * 128 + kq * 32);
            acc = __builtin_amdgcn_mfma_f32_32x32x16_bf16(af, bq[i], acc, 0, 0, 0);
            acc2 = __builtin_amdgcn_mfma_f32_32x32x16_bf16(pf, bq[i], acc2, 0, 0, 0);
        }
#pragma unroll
        for (int i = 0; i < 8; ++i) bq[i] = bn[i];
    }
    LAS bf16* hid = (LAS bf16*)(lds + CMP_HID_OFF);
    { const float b1 = (set ? A.in[12] : A.in[7])[w * 32 + r32];
#pragma unroll
      for (int r = 0; r < 16; ++r) hid[crow(r, hi) * HID_LD + w * 32 + r32] = (bf16)f2bf(gelu_tanh(acc[r] + acc2[r] + b1)); }
    __syncthreads();
    if (w == 0) {
        const bf16* w2t = (const bf16*)(F.ws + WS_CW2) + (size_t)set * 64 * 256;
        f32x16 o[2];
#pragma unroll
        for (int mt = 0; mt < 2; ++mt)
#pragma unroll
            for (int i = 0; i < 16; ++i) o[mt][i] = 0.f;
#pragma unroll
        for (int k4 = 0; k4 < 4; ++k4) {
            bf16x8 wa[4][2];
#pragma unroll
            for (int i = 0; i < 4; ++i)
#pragma unroll
                for (int mt = 0; mt < 2; ++mt) wa[i][mt] = *(const bf16x8*)(w2t + (size_t)(32 * mt + r32) * 256 + 16 * (4 * k4 + i) + 8 * hi);
#pragma unroll
            for (int i = 0; i < 4; ++i) {
                const bf16x8 hb = *(const LAS bf16x8*)(hid + r32 * HID_LD + 16 * (4 * k4 + i) + 8 * hi);
#pragma unroll
                for (int mt = 0; mt < 2; ++mt) o[mt] = __builtin_amdgcn_mfma_f32_32x32x16_bf16(wa[i][mt], hb, o[mt], 0, 0, 0);
            }
        }
        const float* b2 = set ? A.in[14] : A.in[9]; float ss = 0.f;
#pragma unroll
        for (int mt = 0; mt < 2; ++mt)
#pragma unroll
            for (int r = 0; r < 16; ++r) { o[mt][r] += b2[32 * mt + crow(r, hi)]; ss += o[mt][r] * o[mt][r]; }
        ss += __shfl_xor(ss, 32);
        const float rs = 1.0f / sqrtf(ss * (1.f / 64) + EPS);
        const int n = n0 + r32;
        bf16* dst = (bf16*)(F.ws + (set ? WS_VC : WS_KC)) + ((size_t)bg * NCP + n) * 64;
#pragma unroll
        for (int mt = 0; mt < 2; ++mt)
#pragma unroll
            for (int a = 0; a < 4; ++a) { float v[4];
#pragma unroll
                for (int e = 0; e < 4; ++e) { const int d = 32 * mt + 8 * a + 4 * hi + e; float x = o[mt][4 * a + e]; if (set == 0) x *= rs * A.in[4][d]; if (n >= NCMP) x = 0.f; v[e] = x; }
                v2u pk; pk.x = cvtpk(v[0], v[1]); pk.y = cvtpk(v[2], v[3]);
                *(v2u*)(dst + 32 * mt + 8 * a + 4 * hi) = pk; }
    }
}

typedef _Float16 h8v __attribute__((ext_vector_type(8)));
typedef _Float16 h2v __attribute__((ext_vector_type(2)));
__device__ __forceinline__ unsigned pkh(float a, float b) { return __builtin_bit_cast(unsigned, __builtin_amdgcn_cvt_pkrtz(a, b)); }
constexpr int LRU_SEG = 128, LRU_NSEG = SEQ / LRU_SEG, LRU_BW_OFF = 0, LRU_CW_OFF = 16384, LRU_X_OFF = 20480;
__device__ __forceinline__ void lru_wg(Frame& F, const Args& A, int item) {
    const int n = item & 15, b = (item >> 4) & 3, seg = (item >> 6) * 8 + F.wave;
    int lane = F.lane, tid = F.tid; asm volatile("" : "+v"(lane), "+v"(tid));
    const int r32 = lane & 31, hi = lane >> 5;
    LAS v4u* BWL = (LAS v4u*)(F.lds + LRU_BW_OFF); LAS _Float16* cwH = (LAS _Float16*)(F.lds + LRU_CW_OFF);
    { const bf16* lw = (const bf16*)(F.ws + WS_LW);
      for (int e = tid; e < 1024; e += NWAVES * 64) { const int fr = e >> 6, ln = e & 63, gt = fr >> 3, nt = (fr >> 2) & 1, ks = fr & 3;
          const v4u w = *(const v4u*)(lw + ((size_t)(gt * 16 + n) * 64 + 32 * nt + (ln & 31)) * 64 + 16 * ks + 8 * (ln >> 5));
          float wv[8]; unpack_bf8(w, wv);
#pragma unroll
          for (int i = 0; i < 8; ++i) wv[i] *= -LOG2E;
          v4u o; o.x = pkh(wv[0], wv[1]); o.y = pkh(wv[2], wv[3]); o.z = pkh(wv[4], wv[5]); o.w = pkh(wv[6], wv[7]);
          BWL[e] = o; }
      if (tid < 320) { const int tap = tid >> 6, ln = tid & 63; cwH[tid] = (_Float16)(tap < 4 ? A.in[15][tap * 1024 + n * 64 + ln] : A.in[16][n * 64 + ln]); } }
    __syncthreads();
    bf16x8 ID0, ID1;
    { const bool mine = (hi == ((r32 >> 3) & 1));
#pragma unroll
      for (int j = 0; j < 8; ++j) { const short one = (mine && j == (r32 & 7)) ? (short)0x3C00 : (short)0; ID0[j] = (r32 < 16) ? one : (short)0; ID1[j] = (r32 >= 16) ? one : (short)0; } }
    float L2A[2], bar_[2], bi_[2], carry[2], Aseg[2];
#pragma unroll
    for (int nt = 0; nt < 2; ++nt) { const int cj = n * 64 + 32 * nt + r32; const float lam = A.in[21][cj];
        L2A[nt] = -8.0f * log1pf(expf(-lam)) * LOG2E; bar_[nt] = -LOG2E * A.in[18][cj]; bi_[nt] = -LOG2E * A.in[20][cj]; carry[nt] = 0.f; Aseg[nt] = 1.f; }
    const bf16* LXb = (const bf16*)(F.ws + WS_LX) + (size_t)b * SEQ * DM + n * 64; _Float16* HL = (_Float16*)(F.ws + WS_HL); _Float16* PC = (_Float16*)(F.ws + (b < 3 ? WS_PC0 : WS_PC3)) - (size_t)(b < 3 ? 0 : 3) * (SEQ / 32) * 16 * 2 * 1024;
    LAS unsigned char* xbuf = F.lds + LRU_X_OFF + F.wave * 10240;
#define LRU_DMA(tile_) do { const bf16* p_ = LXb + ((long)(seg * LRU_SEG + (tile_) * 32 + (lane >> 3)) - 3) * DM + (((lane & 7) ^ ((lane >> 3) & 7)) << 3); \
        _Pragma("unroll") for (int q = 0; q < 5; ++q) __builtin_amdgcn_global_load_lds((const unsigned*)(p_ + (size_t)q * 8 * DM), (LAS unsigned*)(xbuf + ((tile_) & 1) * 5120 + q * 1024), 16, 0, 0); } while (0)
    LRU_DMA(0);
#pragma unroll 1
    for (int tile = 0; tile < LRU_SEG / 32; ++tile) {
        const int t0 = seg * LRU_SEG + tile * 32, t = t0 + r32;
        asm volatile("s_waitcnt vmcnt(0)" ::: "memory");
        if (tile + 1 < LRU_SEG / 32) LRU_DMA(tile + 1);
        const LAS unsigned char* xb = xbuf + (tile & 1) * 5120;


        h8v AX[4];
        v4u xw[4][4]; v4u wv[4][5];
#pragma unroll
        for (int ks = 0; ks < 4; ++ks) {
#pragma unroll
            for (int tap = 0; tap < 4; ++tap) { const int Rl = r32 + tap; xw[ks][tap] = *(const LAS v4u*)(xb + Rl * 128 + (((2 * ks + hi) ^ (Rl & 7)) << 4)); }
#pragma unroll
            for (int tap = 0; tap < 5; ++tap) wv[ks][tap] = *(const LAS v4u*)(cwH + tap * 64 + 16 * ks + 8 * hi);
        }
        __builtin_amdgcn_sched_barrier(0);
#pragma unroll
        for (int ks = 0; ks < 4; ++ks) {
            h8v acc = __builtin_bit_cast(h8v, wv[ks][4]);
#pragma unroll
            for (int tap = 0; tap < 4; ++tap) {
                v4u x4 = xw[ks][tap];
                if (t - 3 + tap < 0) x4 = (v4u){0u, 0u, 0u, 0u};
                acc = __builtin_bit_cast(h8v, wv[ks][tap]) * __builtin_bit_cast(h8v, x4) + acc;
            }
            AX[ks] = acc;
        }
#pragma unroll
        for (int nt = 0; nt < 2; ++nt) {
            f32x16 ar, ai, xq;
#pragma unroll
            for (int i = 0; i < 16; ++i) { ar[i] = 0.f; ai[i] = 0.f; xq[i] = 0.f; }
            h8v bwr[4], bwi[4];
#pragma unroll
            for (int ks = 0; ks < 4; ++ks) { bwr[ks] = __builtin_bit_cast(h8v, BWL[((0 * 2 + nt) * 4 + ks) * 64 + lane]); bwi[ks] = __builtin_bit_cast(h8v, BWL[((1 * 2 + nt) * 4 + ks) * 64 + lane]); }
            __builtin_amdgcn_sched_barrier(0);
#pragma unroll
            for (int ks = 0; ks < 4; ++ks) { ar = __builtin_amdgcn_mfma_f32_32x32x16_f16(AX[ks], bwr[ks], ar, 0, 0, 0); ai = __builtin_amdgcn_mfma_f32_32x32x16_f16(AX[ks], bwi[ks], ai, 0, 0, 0); }
            xq = __builtin_amdgcn_mfma_f32_32x32x16_f16(AX[2 * nt], __builtin_bit_cast(h8v, ID0), xq, 0, 0, 0);
            xq = __builtin_amdgcn_mfma_f32_32x32x16_f16(AX[2 * nt + 1], __builtin_bit_cast(h8v, ID1), xq, 0, 0, 0);
            float av[16], bv[16];
#pragma unroll
            for (int r = 0; r < 16; ++r) {
                const float ea = 1.f + __builtin_amdgcn_exp2f(ar[r] + bar_[nt]), eb = 1.f + __builtin_amdgcn_exp2f(ai[r] + bi_[nt]);
                const float rc = __builtin_amdgcn_rcpf(ea * eb), rr = rc * eb, ii = rc * ea;
                const float a = __builtin_amdgcn_exp2f(rr * L2A[nt]);
                av[r] = a; bv[r] = __builtin_amdgcn_sqrtf(fmaxf(1.f - a * a, 0.f)) * (ii * xq[r]);
            }
            float Ag[4], Bg[4];
#pragma unroll
            for (int a = 0; a < 4; ++a) { Ag[a] = (av[4 * a] * av[4 * a + 1]) * (av[4 * a + 2] * av[4 * a + 3]);
                Bg[a] = ((bv[4 * a] * av[4 * a + 1] + bv[4 * a + 1]) * av[4 * a + 2] + bv[4 * a + 2]) * av[4 * a + 3] + bv[4 * a + 3]; }
            float st = carry[nt], pr = Aseg[nt], hst[4], pst[4];
#pragma unroll
            for (int a = 0; a < 4; ++a) {
                const float Ap = __shfl_xor(Ag[a], 32), Bp = __shfl_xor(Bg[a], 32);
                const float Alo = hi ? Ap : Ag[a], Blo = hi ? Bp : Bg[a], Ahi = hi ? Ag[a] : Ap, Bhi = hi ? Bg[a] : Bp;
                const float s_lo = st; st = Alo * st + Blo; const float s_hi = st; st = Ahi * st + Bhi;
                const float p_lo = pr; pr *= Alo; const float p_hi = pr; pr *= Ahi;
                hst[a] = hi ? s_hi : s_lo; pst[a] = hi ? p_hi : p_lo;
            }
            carry[nt] = st; Aseg[nt] = pr;
            {
                float hv[16], pv[16];
#pragma unroll
                for (int a = 0; a < 4; ++a) { float h = hst[a], p = pst[a];
#pragma unroll
                    for (int e = 0; e < 4; ++e) { const int r = 4 * a + e; h = av[r] * h + bv[r]; p *= av[r]; hv[r] = h; pv[r] = p; } }
                const size_t toff = ((size_t)((b * (SEQ / 32) + seg * (LRU_SEG / 32) + tile) * 16 + n) * 2 + nt) * 1024 + lane * 16;
                v4u w0, w1;
                w0.x = pkh(hv[0], hv[1]); w0.y = pkh(hv[2], hv[3]); w0.z = pkh(hv[4], hv[5]); w0.w = pkh(hv[6], hv[7]); w1.x = pkh(hv[8], hv[9]); w1.y = pkh(hv[10], hv[11]); w1.z = pkh(hv[12], hv[13]); w1.w = pkh(hv[14], hv[15]);
                *(v4u*)(HL + toff) = w0; *(v4u*)(HL + toff + 8) = w1;
                w0.x = pkh(pv[0], pv[1]); w0.y = pkh(pv[2], pv[3]); w0.z = pkh(pv[4], pv[5]); w0.w = pkh(pv[6], pv[7]); w1.x = pkh(pv[8], pv[9]); w1.y = pkh(pv[10], pv[11]); w1.z = pkh(pv[12], pv[13]); w1.w = pkh(pv[14], pv[15]);
                *(v4u*)(PC + toff) = w0; *(v4u*)(PC + toff + 8) = w1;
            }
        }
    }
#undef LRU_DMA
    if (hi == 0) {
        float* ls = (float*)(F.ws + WS_LSUM);
#pragma unroll
        for (int nt = 0; nt < 2; ++nt) *(float2*)(ls + ((size_t)(b * LRU_NSEG + seg) * 1024 + n * 64 + 32 * nt + r32) * 2) = make_float2(Aseg[nt], carry[nt]);
    }
}

__device__ __forceinline__ void lru_pass2(Frame& F, const Args& A, int item) {
    const int half = item & 1, seg = (item >> 1) & 31, b = item >> 6, lane = F.lane, r32 = lane & 31, hi = lane >> 5;
    LAS float* hin = (LAS float*)F.lds;
    { const float* ls = (const float*)(F.ws + WS_LSUM) + ((size_t)b * LRU_NSEG * 1024 + half * 512 + F.tid) * 2; float h = 0.f;
      for (int s0 = 0; s0 < seg; s0 += 8) {
          float2 ab[8];
#pragma unroll
          for (int i = 0; i < 8; ++i) { const int s = (s0 + i < seg) ? s0 + i : seg - 1; ab[i] = *(const float2*)(ls + (size_t)s * 2048); }
#pragma unroll
          for (int i = 0; i < 8; ++i) if (s0 + i < seg) h = ab[i].x * h + ab[i].y;
      }
      hin[F.tid] = h; }
    __syncthreads();
    const int n = half * 8 + F.wave;
    const float h0 = hin[F.wave * 64 + r32], h1 = hin[F.wave * 64 + 32 + r32];
    LAS unsigned char* tb = F.lds + 4096 + F.wave * 4608;
    const _Float16* HL = (const _Float16*)(F.ws + WS_HL); const _Float16* PC = (const _Float16*)(F.ws + (b < 3 ? WS_PC0 : WS_PC3)) - (size_t)(b < 3 ? 0 : 3) * (SEQ / 32) * 16 * 2 * 1024;
    bf16* LR = (bf16*)(F.ws + WS_LGG);
    typedef _Float16 hh8 __attribute__((ext_vector_type(8)));
#pragma unroll 1
    for (int tile = 0; tile < LRU_SEG / 32; ++tile) {
        const int t0 = seg * LRU_SEG + tile * 32;
        const size_t toff = ((size_t)((b * (SEQ / 32) + seg * (LRU_SEG / 32) + tile) * 16 + n) * 2) * 1024 + lane * 16;
        hh8 hq[2][2], pq[2][2];
#pragma unroll
        for (int nt = 0; nt < 2; ++nt) { hq[nt][0] = *(const hh8*)(HL + toff + nt * 1024); hq[nt][1] = *(const hh8*)(HL + toff + nt * 1024 + 8); pq[nt][0] = *(const hh8*)(PC + toff + nt * 1024); pq[nt][1] = *(const hh8*)(PC + toff + nt * 1024 + 8); }
        v4u gw[4];
#pragma unroll
        for (int i = 0; i < 4; ++i) { const int q = lane + 64 * i; gw[i] = *(const v4u*)(LR + (size_t)(b * SEQ + t0 + (q >> 3)) * DM + n * 64 + 8 * (q & 7)); }
#pragma unroll
        for (int nt = 0; nt < 2; ++nt) { const float hc = nt ? h1 : h0;
#pragma unroll
            for (int r = 0; r < 16; ++r) { const float s = (float)hq[nt][r >> 3][r & 7] + (float)pq[nt][r >> 3][r & 7] * hc;
                *(LAS _Float16*)(tb + crow(r, hi) * 144 + (32 * nt + r32) * 2) = (_Float16)s; } }
        asm volatile("s_waitcnt lgkmcnt(0)" ::: "memory");
#pragma unroll
        for (int i = 0; i < 4; ++i) { const int q = lane + 64 * i;
            const hh8 sv = *(const LAS hh8*)(tb + (q >> 3) * 144 + 16 * (q & 7)); float g[8], o[8]; unpack_bf8(gw[i], g);
#pragma unroll
            for (int k = 0; k < 8; ++k) o[k] = (float)sv[k] * g[k];
            *(bf16x8*)(LR + (size_t)(b * SEQ + t0 + (q >> 3)) * DM + n * 64 + 8 * (q & 7)) = pack_bf8(o); }
        asm volatile("s_waitcnt lgkmcnt(0)" ::: "memory");
    }
    __syncthreads();
}

__device__ __forceinline__ void phase2(Frame& F, const Args& A) {
    p2_knorm(F, A);
    for (int rep = 0; rep < (REP_PHASE == 20 ? 2 : 1); ++rep)
    for (int u = F.vcu; u < 256; u += F.G) { p2_compress(F, A, u); __syncthreads(); }
    for (int rep = 0; rep < (REP_PHASE == 21 ? 2 : 1); ++rep)
    for (int it = F.vcu; it < 256; it += F.G) { lru_wg(F, A, it); __syncthreads(); }
}
namespace att {
constexpr int NSLOT = 4, SLOTB = 16384  , IMP_OFF = NSLOT * SLOTB, IMP_LD = 72, MSK_OFF = IMP_OFF + 4 * 64 * IMP_LD * 2, UNI_OFF = MSK_OFF + 512, SC_OFF = UNI_OFF + 16;
static_assert(SC_OFF + 4 * 64 * 4 * 4 <= RING_BYTES, "attention LDS map");
constexpr float NEGBIG = -1e30f, MREF0 = -8192.f, C2 = 0.125f * LOG2E, THR = 8.f;
constexpr int DIST = 2;

__device__ __forceinline__ void glds16(const void* gsrc, unsigned lds_dst) { unsigned keep;
    asm volatile("s_mov_b32 %0, m0\n\ts_mov_b32 m0, %2\n\ts_nop 0\n\tglobal_load_lds_dwordx4 %1, off\n\ts_mov_b32 m0, %0" : "=&s"(keep) : "v"(gsrc), "s"(lds_dst) : "memory"); }
#define ATT_WAIT_BAR(N) asm volatile("s_waitcnt vmcnt(" #N ") lgkmcnt(0)\n\ts_barrier" ::: "memory")
#define ATT_WAIT_BAR_NOVM() asm volatile("s_waitcnt lgkmcnt(0)\n\ts_barrier" ::: "memory")
__device__ __forceinline__ float fadd_s(float a, float b) { float r; asm("v_add_f32_e32 %0, %1, %2" : "=v"(r) : "v"(a), "v"(b)); return r; }
__device__ __forceinline__ float max3f(float a, float b, float c) { float r; asm("v_max3_f32 %0, %1, %2, %3" : "=v"(r) : "v"(a), "v"(b), "v"(c)); return r; }

#define ATT_SB() __builtin_amdgcn_sched_barrier(0)
__device__ __forceinline__ void qk_tile(const LAS unsigned char* kslot, const bf16x8* qf, float slk  , float base0, f32x16& p0, f32x16& p1, int r32, int hi) {
    const LAS unsigned char* kp = kslot + r32 * 128; const int kx = (r32 >> 1) & 7;
    bf16x8 kf[8];
#pragma unroll
    for (int d0 = 0; d0 < 4; ++d0) { const int so = ((2 * d0 + hi) ^ kx) << 4; kf[2 * d0] = *(const LAS bf16x8*)(kp + so); kf[2 * d0 + 1] = *(const LAS bf16x8*)(kp + 4096 + so); }
    ATT_SB();
    const float bl = base0 + slk * (float)(4 * hi), bh = bl + slk * 32.f;
#pragma unroll
    for (int r = 0; r < 16; ++r) { const float c = (float)((r & 3) + 8 * (r >> 2)); p0[r] = __builtin_fmaf(slk, c, bl); p1[r] = __builtin_fmaf(slk, c, bh); }
    ATT_SB();
    __builtin_amdgcn_s_setprio(1);
#pragma unroll
    for (int d0 = 0; d0 < 4; ++d0) {
        p0 = __builtin_amdgcn_mfma_f32_32x32x16_bf16(kf[2 * d0], qf[d0], p0, 0, 0, 0);
        p1 = __builtin_amdgcn_mfma_f32_32x32x16_bf16(kf[2 * d0 + 1], qf[d0], p1, 0, 0, 0);
    }
    __builtin_amdgcn_s_setprio(0);
    ATT_SB();
}
template <bool LE> __device__ __forceinline__ void mask_tile(f32x16& p0, f32x16& p1, int bound, int hi) {
    const int bb = bound - 4 * hi;
#pragma unroll
    for (int r = 0; r < 16; ++r) { const int c = (r & 3) + 8 * (r >> 2);
        if (LE) { if (c > bb) p0[r] = NEGBIG; if (c + 32 > bb) p1[r] = NEGBIG; }
        else { if (c < bb) p0[r] = NEGBIG; if (c + 32 < bb) p1[r] = NEGBIG; } }
}
__device__ __forceinline__ float row_max(const f32x16& p0, const f32x16& p1) {
    float a = max3f(p0[0], p0[1], p1[0]), b = max3f(p0[2], p0[3], p1[1]); a = max3f(a, p1[2], p1[3]);
#pragma unroll
    for (int r = 4; r < 16; r += 4) { a = max3f(a, p0[r], p0[r + 1]); b = max3f(b, p0[r + 2], p0[r + 3]); a = max3f(a, p1[r], p1[r + 1]); b = max3f(b, p1[r + 2], p1[r + 3]); }
    a = fmaxf(a, b);
    return fmaxf(a, __shfl_xor(a, 32));
}
__device__ __forceinline__ s16x4 vtr(const LAS unsigned char* p) { typedef short v4i16_t __attribute__((ext_vector_type(4))); return __builtin_bit_cast(s16x4, __builtin_amdgcn_ds_read_tr16_b64_v4i16((LAS v4i16_t*)p)); }
__device__ __forceinline__ void v_load(const LAS unsigned char* vslot, int d0, bf16x8* vf, int lane, int hi) {
    const int q4 = (lane & 15) >> 2, p4 = lane & 3, g2 = (lane >> 4) & 1;
    const LAS unsigned char* vp = vslot + (4 * hi + q4) * 128 + ((((4 * d0 + 2 * g2 + (p4 >> 1)) ^ ((q4 >> 1) << 2))) << 4) + 8 * (p4 & 1);
#pragma unroll
    for (int i = 0; i < 4; ++i) {
        const s16x4 lo = vtr(vp + i * 2048), hh = vtr(vp + i * 2048 + 1024);
        vf[i] = (bf16x8){lo[0], lo[1], lo[2], lo[3], hh[0], hh[1], hh[2], hh[3]};
    }
    ATT_SB();
}
__device__ __forceinline__ void pack_p(const f32x16& p0, const f32x16& p1, bf16x8* pa) {
    float t[8];
#pragma unroll
    for (int i = 0; i < 8; ++i) t[i] = p0[i];
    pa[0] = pack_bf8(t);
#pragma unroll
    for (int i = 0; i < 8; ++i) t[i] = p0[8 + i];
    pa[1] = pack_bf8(t);
#pragma unroll
    for (int i = 0; i < 8; ++i) t[i] = p1[i];
    pa[2] = pack_bf8(t);
#pragma unroll
    for (int i = 0; i < 8; ++i) t[i] = p1[8 + i];
    pa[3] = pack_bf8(t);
}
__device__ __forceinline__ void pv_mma_packed(const LAS unsigned char* vslot, const bf16x8* vf0, const bf16x8* pa, f32x16* o, int lane, int hi) {
    bf16x8 vf1[4]; v_load(vslot, 1, vf1, lane, hi);
    __builtin_amdgcn_s_setprio(1);
#pragma unroll
    for (int ks = 0; ks < 4; ++ks) o[0] = __builtin_amdgcn_mfma_f32_32x32x16_bf16(vf0[ks], pa[ks], o[0], 0, 0, 0);
#pragma unroll
    for (int ks = 0; ks < 4; ++ks) o[1] = __builtin_amdgcn_mfma_f32_32x32x16_bf16(vf1[ks], pa[ks], o[1], 0, 0, 0);
    __builtin_amdgcn_s_setprio(0);
    ATT_SB();
}
__device__ __forceinline__ void pv_mma(const LAS unsigned char* vslot, const bf16x8* vf0, const f32x16& p0, const f32x16& p1, f32x16* o, int lane, int hi) {
    bf16x8 pa[4]; pack_p(p0, p1, pa); ATT_SB();
    pv_mma_packed(vslot, vf0, pa, o, lane, hi);
}
__device__ __forceinline__ float softmax_exp(f32x16& p0, f32x16& p1, float& mref, float& l, f32x16* o, bool has_o) {
    const float rm = row_max(p0, p1); float fac = 1.f;
    if (__any(rm > THR)) {
        const float d = fmaxf(rm, 0.f), alpha = __builtin_amdgcn_exp2f(-d); mref += d; l *= alpha; fac = alpha;
#pragma unroll
        for (int r = 0; r < 16; ++r) { p0[r] -= d; p1[r] -= d; }
        if (has_o) {
#pragma unroll
            for (int r = 0; r < 16; ++r) { o[0][r] *= alpha; o[1][r] *= alpha; }
        }
    }
#pragma unroll
    for (int r = 0; r < 16; ++r) { p0[r] = __builtin_amdgcn_exp2f(p0[r]); p1[r] = __builtin_amdgcn_exp2f(p1[r]); }
    return fac;
}
__device__ __forceinline__ void softmax_sum(const f32x16& p0, const f32x16& p1, float& l) {
    float s0 = 0.f, s1 = 0.f;
#pragma unroll
    for (int r = 0; r < 16; ++r) { s0 += p0[r]; s1 += p1[r]; }
    l += s0 + s1;
}
__device__ __forceinline__ float softmax_step(f32x16& p0, f32x16& p1, float& mref, float& l, f32x16* o, bool has_o) { const float f = softmax_exp(p0, p1, mref, l, o, has_o); softmax_sum(p0, p1, l); return f; }

__device__ __forceinline__ void attn_unit(Frame& F, const Args& A, int bg, int qt) {
    int lane = F.lane; asm volatile("" : "+v"(lane));
    const int b = bg >> 2, g = bg & 3, wid = F.wave, r32 = lane & 31, hi = lane >> 5;
    const int hh = wid & 3, qh = wid >> 2, head = g * 4 + hh;
    const int t0 = qt * 64, u = 32 * qh + r32, t = t0 + u; const size_t m = (size_t)b * SEQ + t;
    LAS unsigned char* lds = F.lds;
    const unsigned lds0 = (unsigned)(uintptr_t)lds;
    unsigned char* ws = F.ws;
    if (F.tid == 0) { *(LAS unsigned*)(lds + UNI_OFF) = 0u; *(LAS unsigned*)(lds + UNI_OFF + 4) = 0u; }
    const bf16* KCb = (const bf16*)(ws + WS_KC) + (size_t)bg * NCP * 64; const bf16* VCb = (const bf16*)(ws + WS_VC) + (size_t)bg * NCP * 64;
    const bf16* KVb = (const bf16*)(ws + WS_KVB) + (size_t)b * SEQ * KVW + g * 64;
    const int rowl = 8 * wid + (lane >> 3), kch = (lane & 7) ^ ((rowl >> 1) & 7), vch = (lane & 7) ^ (((rowl >> 1) & 1) << 2);
    const int kofC = rowl * 64 + kch * 8, vofC = rowl * 64 + vch * 8;
    const int kofT = rowl * KVW + kch * 8, vofT = rowl * KVW + vch * 8;
    const int nct = (((t0 + 32) >> 4) >> 6) + 1;
    const int jlast = qt >= 8 ? qt - 8 : 0, nw = qt - jlast + 1;
    const int sW = nct, sS = sW + nw;
    int total = sS;
    int ipos = 0;
    unsigned long long iss_uni = 0ull;
    const unsigned kdst = lds0 + wid * 1024, vdst = lds0 + 8192 + wid * 1024;
#define ATT_ISSUE() do { if (ipos < total) { const unsigned so = (unsigned)(ipos & (NSLOT - 1)) * SLOTB; \
        if (ipos < sW) { const int row = 64 * ipos; glds16(KCb + row * 64 + kofC, (unsigned)__builtin_amdgcn_readfirstlane(kdst + so)); glds16(VCb + row * 64 + vofC, (unsigned)__builtin_amdgcn_readfirstlane(vdst + so)); } \
        else { int j; const bf16* kb_; if (ipos < sS) { j = qt - (ipos - sW); kb_ = KVb + 4 * 256; } else { j = 63 - __builtin_clzll(iss_uni); iss_uni &= ~(1ull << j); kb_ = KVb + 2 * 256; } \
               const bf16* p_ = kb_ + (size_t)j * 64 * KVW; glds16(p_ + kofT, (unsigned)__builtin_amdgcn_readfirstlane(kdst + so)); glds16(p_ + 256 + vofT, (unsigned)__builtin_amdgcn_readfirstlane(vdst + so)); } \
        ++ipos; } } while (0)
#define ATT_STEP_END(cpos) do { const int ahead = ipos - (cpos) - 2; if (ahead >= 2) ATT_WAIT_BAR(4); else if (ahead == 1) ATT_WAIT_BAR(2); else ATT_WAIT_BAR(0); } while (0)
    ATT_ISSUE(); ATT_ISSUE();
    bf16x8 qf[4];
    {
        const bf16* qp = (const bf16*)(ws + WS_QB) + m * DM + head * 64 + 8 * hi; const float* qng = A.in[3] + 8 * hi;
        v4u w[4]; float ss = 0.f;
#pragma unroll
        for (int ks = 0; ks < 4; ++ks) { w[ks] = *(const v4u*)(qp + 16 * ks); float v[8]; unpack_bf8(w[ks], v);
#pragma unroll
            for (int e = 0; e < 8; ++e) ss += v[e] * v[e]; }
        ss += __shfl_xor(ss, 32);
        const float rs = C2 / sqrtf(ss * (1.f / 64) + EPS);
#pragma unroll
        for (int ks = 0; ks < 4; ++ks) { float v[8]; unpack_bf8(w[ks], v);
#pragma unroll
            for (int e = 0; e < 8; ++e) v[e] *= rs * qng[16 * ks + e];
            qf[ks] = pack_bf8(v); }
    }
    const float sl2 = exp2f(-0.5f * (float)(head + 1)) * LOG2E;
    const bf16* NGp = (const bf16*)(ws + WS_NG) + m * 48 + head * 3;
    const float gate_c = bf2f(NGp[0]), gate_s = bf2f(NGp[1]), gate_w = bf2f(NGp[2]);
    f32x16 o[2];
    unsigned oaccp[2][8];
#pragma unroll
    for (int i = 0; i < 8; ++i) { oaccp[0][i] = 0u; oaccp[1][i] = 0u; }
#define ATT_FOLD(sc_) do { _Pragma("unroll") for (int d_ = 0; d_ < 2; ++d_) _Pragma("unroll") for (int i_ = 0; i_ < 8; ++i_) { \
        const float a_ = bflo(oaccp[d_][i_]) + (sc_) * o[d_][2 * i_], b_ = bfhi(oaccp[d_][i_]) + (sc_) * o[d_][2 * i_ + 1]; oaccp[d_][i_] = cvtpk(a_, b_); } } while (0)
    ATT_WAIT_BAR(0);
    int cpos = 0;
#if PROBE_ID
    unsigned* pc = (unsigned*)(ws + WS_CTL) + 8192; unsigned long long ts0 = __builtin_amdgcn_s_memtime();
#define PROBE_MARK(k) do { const unsigned long long ts1 = __builtin_amdgcn_s_memtime(); if (F.tid == 0) atomicAdd(pc + (k), (unsigned)((ts1 - ts0) >> 4)); ts0 = ts1; } while (0)
#else
#define PROBE_MARK(k) do {} while (0)
#endif
#define ATT_K(cpos) (lds + (unsigned)((cpos) & (NSLOT - 1)) * SLOTB)
#define ATT_V(cpos) (lds + (unsigned)((cpos) & (NSLOT - 1)) * SLOTB + 8192)
    {
        const int nmax = (t - 31) >> 4;
        float mref = MREF0, l = 0.f, mk[4] = {0.f, 0.f, 0.f, 0.f};
#pragma unroll
        for (int r = 0; r < 16; ++r) { o[0][r] = 0.f; o[1][r] = 0.f; }
        LAS _Float16* impw = (LAS _Float16*)(lds + IMP_OFF) + (hh * 64 + u) * IMP_LD;
        float ecarry = 0.f;
#pragma unroll
        for (int kt = 0; kt < 4; ++kt) {
            if (kt < nct) {
                ATT_ISSUE();
                f32x16 p0, p1;
                qk_tile(ATT_K(cpos), qf, sl2 * 16.f, sl2 * (float)(1024 * kt + 31 - t0) - mref, p0, p1, r32, hi);
                bf16x8 vf[4]; v_load(ATT_V(cpos), 0, vf, lane, hi);
                mask_tile<true>(p0, p1, nmax - 64 * kt, hi);
                ecarry *= softmax_step(p0, p1, mref, l, o, true);
                mk[kt] = mref;
                float Eo[2][4];
#pragma unroll
                for (int a4 = 0; a4 < 4; ++a4) { Eo[0][a4] = __shfl_xor(p0[4 * a4 + 3], 32); Eo[1][a4] = __shfl_xor(p1[4 * a4 + 3], 32); }
#pragma unroll
                for (int s = 0; s < 2; ++s)
#pragma unroll
                    for (int a4 = 0; a4 < 4; ++a4) {
                        const float G = s == 0 ? (p0[4 * a4] + p0[4 * a4 + 1]) + (p0[4 * a4 + 2] + p0[4 * a4 + 3]) : (p1[4 * a4] + p1[4 * a4 + 1]) + (p1[4 * a4 + 2] + p1[4 * a4 + 3]);
                        const float prev = a4 >= 1 ? Eo[s][a4 - 1] : (s == 1 ? Eo[0][3] : ecarry);
                        impw[16 * kt + 8 * s + 2 * a4 + hi] = (_Float16)(G + (hi ? Eo[s][a4] : prev));
                    }
                ecarry = Eo[1][3];
                pv_mma(ATT_V(cpos), vf, p0, p1, o, lane, hi);
                ATT_STEP_END(cpos); ++cpos;
            }
        }
        l += __shfl_xor(l, 32);
        const float inv = l > 0.f ? 1.0f / l : 0.f;
        if (hi == 0) { f32x4 sc; sc[0] = __builtin_amdgcn_exp2f(mk[0] - mref) * inv; sc[1] = __builtin_amdgcn_exp2f(mk[1] - mref) * inv; sc[2] = __builtin_amdgcn_exp2f(mk[2] - mref) * inv; sc[3] = __builtin_amdgcn_exp2f(mk[3] - mref) * inv;
            *(LAS f32x4*)(lds + SC_OFF + (hh * 64 + u) * 16) = sc; }
        const float gsc = gate_c * inv;
        ATT_FOLD(gsc);
        asm volatile("s_waitcnt lgkmcnt(0)\n\ts_barrier" ::: "memory");
    }
    PROBE_MARK(0);
    {
        const int q = lane >> 3, kg = lane & 7, uq = 8 * wid + q, tq = t0 + uq;
        float v[8];
#pragma unroll
        for (int i = 0; i < 8; ++i) v[i] = 0.f;
#pragma unroll
        for (int h4 = 0; h4 < 4; ++h4) { typedef _Float16 h8 __attribute__((ext_vector_type(8)));
            const h8 x = *(const LAS h8*)(lds + IMP_OFF + ((h4 * 64 + uq) * IMP_LD + 8 * kg) * 2);
            const float sc = *(const LAS float*)(lds + SC_OFF + (h4 * 64 + uq) * 16 + 4 * (kg >> 1));
#pragma unroll
            for (int i = 0; i < 8; ++i) v[i] += (float)x[i] * sc; }
        unsigned key[8];
#pragma unroll
        for (int i = 0; i < 8; ++i) { const int j = 8 * kg + i; const bool valid = (64 * j <= tq), forced = (j == 0) || (j == qt) || (j == qt - 1);
            const float val = v[i] + (forced ? 1e4f : 0.f);
            key[i] = valid ? (((__float_as_uint(val) >> 16) << 6) | (unsigned)(63 - j)) : 0u; }
        unsigned thr = 0u;
#pragma unroll 1
        for (int bit = 20; bit >= 0; --bit) {
            const unsigned cand = thr | (1u << bit); int c = 0;
#pragma unroll
            for (int i = 0; i < 8; ++i) c += (key[i] >= cand) ? 1 : 0;
            c += __builtin_amdgcn_update_dpp(0, c, 0xB1, 0xF, 0xF, true);
            c += __builtin_amdgcn_update_dpp(0, c, 0x4E, 0xF, 0xF, true);
            c += __builtin_amdgcn_update_dpp(0, c, 0x141, 0xF, 0xF, true);
            thr = c >= 16 ? cand : thr;
        }
        unsigned m8 = 0u;
#pragma unroll
        for (int i = 0; i < 8; ++i) m8 |= ((key[i] != 0u && key[i] >= thr) ? 1u : 0u) << i;
        *(LAS unsigned char*)(lds + MSK_OFF + 8 * uq + kg) = (unsigned char)m8;
        __hip_atomic_fetch_or((LAS unsigned*)(lds + UNI_OFF + 4 * (kg >> 2)), m8 << (8 * (kg & 3)), __ATOMIC_RELAXED, __HIP_MEMORY_SCOPE_WORKGROUP);
        asm volatile("s_waitcnt lgkmcnt(0)\n\ts_barrier" ::: "memory");
    }
    const unsigned mlo = *(const LAS unsigned*)(lds + MSK_OFF + 8 * u), mhi = *(const LAS unsigned*)(lds + MSK_OFF + 8 * u + 4);
    const unsigned long long mymask = ((unsigned long long)mhi << 32) | mlo;
    unsigned long long cmp_uni = ((unsigned long long)(unsigned)__builtin_amdgcn_readfirstlane((int)*(const LAS unsigned*)(lds + UNI_OFF + 4)) << 32) | (unsigned)__builtin_amdgcn_readfirstlane((int)*(const LAS unsigned*)(lds + UNI_OFF));
    iss_uni = cmp_uni; total = sS + __builtin_popcountll(cmp_uni);
    PROBE_MARK(1);
#if PROBE_ID
    if (F.tid == 0) { atomicAdd(pc + 4, (unsigned)__builtin_popcountll(cmp_uni)); atomicAdd(pc + 5, (unsigned)(2 * nct + nw)); }
#endif
#define ATT_WS_LOOP(DEFER) { \
        float mref = MREF0, l = 0.f; \
        _Pragma("unroll") for (int r = 0; r < 16; ++r) { o[0][r] = 0.f; o[1][r] = 0.f; } \
        bf16x8 pa[4]; \
        const int nsteps = nw + __builtin_popcountll(cmp_uni); \
        for (int st = 0; st < nsteps; ++st, ++cpos) { \
            int j; bool win; \
            if (st < nw) { j = qt - st; win = true; } else { j = 63 - __builtin_clzll(cmp_uni); cmp_uni &= ~(1ull << j); win = false; } \
            if (DEFER && st > 0) { bf16x8 vf[4]; v_load(ATT_V(cpos - 1), 0, vf, lane, hi); pv_mma_packed(ATT_V(cpos - 1), vf, pa, o, lane, hi); } \
            if (st == nw) { \
                PROBE_MARK(2); \
                l += __shfl_xor(l, 32); \
                const float sc = l > 0.f ? gate_w / l : 0.f; \
                ATT_FOLD(sc); \
                _Pragma("unroll") for (int r = 0; r < 16; ++r) { o[0][r] = 0.f; o[1][r] = 0.f; } \
                mref = MREF0; l = 0.f; \
            } \
            ATT_ISSUE(); \
            f32x16 p0, p1; \
            const float selb = (win || ((mymask >> j) & 1ull)) ? 0.f : NEGBIG; \
            qk_tile(ATT_K(cpos), qf, sl2, sl2 * (float)(64 * j - t0) - mref + selb, p0, p1, r32, hi); \
            if (!DEFER) { \
                bf16x8 vf[4]; v_load(ATT_V(cpos), 0, vf, lane, hi); \
                if (j == qt) mask_tile<true>(p0, p1, u, hi); \
                if (win && j == qt - 8) mask_tile<false>(p0, p1, u + 1, hi); \
                softmax_step(p0, p1, mref, l, o, true); \
                pv_mma(ATT_V(cpos), vf, p0, p1, o, lane, hi); \
            } else { \
                if (j == qt) mask_tile<true>(p0, p1, u, hi); \
                if (win && j == qt - 8) mask_tile<false>(p0, p1, u + 1, hi); \
                softmax_step(p0, p1, mref, l, o, true); \
                pack_p(p0, p1, pa); \
            } \
            ATT_STEP_END(cpos); \
        } \
        if (DEFER) { bf16x8 vf[4]; v_load(ATT_V(cpos - 1), 0, vf, lane, hi); pv_mma_packed(ATT_V(cpos - 1), vf, pa, o, lane, hi); } \
        l += __shfl_xor(l, 32); \
        const float sc = l > 0.f ? gate_s / l : 0.f; \
        ATT_FOLD(sc); \
    }
    if (F.grp != 0) ATT_WS_LOOP(true) else ATT_WS_LOOP(false)
#undef ATT_WS_LOOP
    PROBE_MARK(3);
    bf16* op = (bf16*)(ws + WS_QB) + m * DM + head * 64 + 4 * hi;
#pragma unroll
    for (int d0 = 0; d0 < 2; ++d0)
#pragma unroll
        for (int a = 0; a < 4; ++a) { v2u pk; pk.x = oaccp[d0][2 * a]; pk.y = oaccp[d0][2 * a + 1]; *(v2u*)(op + 32 * d0 + 8 * a) = pk; }
#undef ATT_FOLD
#undef ATT_ISSUE
#undef ATT_STEP_END
#undef ATT_K
#undef ATT_V
}
#undef ATT_WAIT_BAR
#undef ATT_WAIT_BAR_NOVM
#undef ATT_SB
}

__device__ __forceinline__ void phase3(Frame& F, const Args& A) {
    for (int it = F.vcu; it < 256; it += F.G) lru_pass2(F, A, it);
#if FAST_ATTN
    __syncthreads();
    {
        const bool lab8 = (F.G % 8) == 0; const int nq = lab8 ? 8 : 1, lab = lab8 ? (int)(blockIdx.x & 7) : 0, per = 1024 / nq;
        unsigned* head = (unsigned*)(F.ws + WS_CTL) + CW_QUEUE + 64 * lab;
        volatile LAS unsigned* slotw = (volatile LAS unsigned*)(F.lds + MISC_OFF + 96);
        for (;;) {
            if (F.tid == 0) *slotw = __hip_atomic_fetch_add(head, 1u, __ATOMIC_RELAXED, __HIP_MEMORY_SCOPE_AGENT);
            __syncthreads();
            const int i = (int)*slotw;
            __syncthreads();
            if (i >= per) break;
            const int nbg = 16 / nq, bg = lab * nbg + (i % nbg), qt = 63 - i / nbg;
            att::attn_unit(F, A, bg, qt);
            __syncthreads();
        }
    }
#endif
}
constexpr int N_PHASES = 8;

__global__ void __launch_bounds__(NWAVES * 64, 2) fwd_kernel(Args args) {
    extern __shared__ __attribute__((aligned(16))) unsigned char lds[];
    Frame F;
    F.lds = (LAS unsigned char*)lds;
    F.MISC = (volatile LAS unsigned*)(F.lds + MISC_OFF);
    F.tid = threadIdx.x; F.lane = F.tid & 63; F.wave = __builtin_amdgcn_readfirstlane(F.tid >> 6);
    F.G = gridDim.x; { const int bx = blockIdx.x; F.vcu = (F.G % 8 == 0) ? (bx % 8) * (F.G / 8) + bx / 8 : bx; }
    F.out = args.out; F.ws = args.ws; unsigned char* ws = args.ws;
    F.ctl = (gu32*)(ws + WS_CTL);
    for (int u = F.tid; u < (LDS_BYTES - LDSCTL_OFF) / 4; u += NWAVES * 64) ((LAS unsigned*)(F.lds + LDSCTL_OFF))[u] = 0u;
    __syncthreads();
    { const unsigned simd = ((unsigned)__builtin_amdgcn_s_getreg((1 << 11) | (4 << 6) | 4)) & 3u;
      int slot = 0; if (F.lane == 0) slot = (int)__hip_atomic_fetch_add((LAS unsigned*)(F.lds + MISC_OFF + 64 + 4 * simd), 1u, __ATOMIC_RELAXED, __HIP_MEMORY_SCOPE_WORKGROUP);
      F.grp = __builtin_amdgcn_readfirstlane(slot) & 1; }
    const int lo = args.ph_lo, hi = args.ph_hi;
    const bool multi = (hi - lo) > 1;
    XcdBarrier bar; bar.bar = (unsigned*)(F.ctl + CW_BAR); bar.x = 0; bar.st = nullptr;
    if (multi) bar = xcd_barrier_post((unsigned*)(F.ctl + CW_BAR), F.MISC + 8);
#ifdef ONLY
#define IN(k) ((k) == ONLY && lo <= (k) && (k) < hi)
#else
#define IN(k) (lo <= (k) && (k) < hi)
#endif
#if PROBE_ID >= 10
#define STAMP(k) do { if (blockIdx.x == 0 && F.tid == 0) F.MISC[12 + (k)] = (unsigned)__builtin_amdgcn_s_memrealtime(); } while (0)
#else
#define STAMP(k) do {} while (0)
#endif
#define PIN(n) asm volatile(".p2align 8\n\t.fill " #n ", 4, 0xBF800000" ::: "memory")
#define SEAM(k) do { if (IN(k) && IN((k) + 1)) xcd_barrier(bar); STAMP((k) + 1); } while (0)
    using namespace pg8;
    PG8_LAS unsigned char* ring = (PG8_LAS unsigned char*)lds;

#ifndef REP_PHASE
#define REP_PHASE -1
#endif
#define NREP(k) ((k) == REP_PHASE ? 2 : 1)
    STAMP(0);
    if (IN(0)) { p0_prologue<false>(F, args); SEAM(0); }

    if (IN(1)) {
        Gemm g{2 * DM, 128, 2 * DM, 128, DM / 64};
        SchedSimple S; S.T.init(M_ROWS, NPROJ, F.G, (int)blockIdx.x); S.A = (const char*)(ws + WS_XB); S.B = (const char*)(ws + WS_WIN); S.tA = (size_t)256 * 2 * DM; S.tB = (size_t)256 * 2 * DM;
        EpiProj E{(const float*)(ws + WS_RSTD1), (bf16_t*)(ws + WS_QB), (bf16_t*)(ws + WS_KVB), (bf16_t*)(ws + WS_NG), (bf16_t*)(ws + WS_LX), (bf16_t*)(ws + WS_LGG), (bf16_t*)F.out};
        gemm_phase<EpiProj, SchedSimple, GEMM_ALIGN_P1>(ring, g, S, E);
        {
            const int nwg = S.T.nwg, G = F.G, rem = nwg % G, c = (int)blockIdx.x;
            if (rem == 0) p0_prologue<true>(F, args, c, G);
            else if (c >= rem) p0_prologue<true>(F, args, c - rem, G - rem);
        }
        SEAM(1);
    }
    if (IN(2)) { PIN(38); phase2(F, args); SEAM(2); }
    if (IN(3)) { PIN(53); phase3(F, args); SEAM(3); }
    if (IN(4)) { PIN(55);
        Gemm g{2 * DM, 128, 2 * DM, 128, DM / 64};
        SchedMerge S; S.T.init(M_ROWS, DM, F.G, (int)blockIdx.x); S.A0 = (const char*)(ws + WS_QB); S.A1 = (const char*)(ws + WS_LGG); S.B0 = (const char*)(ws + WS_WOA); S.B1 = (const char*)(ws + WS_WOL);
        S.tA = (size_t)256 * 2 * DM; S.tB = (size_t)256 * 2 * DM;
        EpiMerge E{(const bf16_t*)F.out, (bf16_t*)(ws + WS_LX)};
        for (int rep = 0; rep < NREP(4); ++rep) gemm_phase<EpiMerge, SchedMerge>(ring, g, S, E);
        SEAM(4);
    }
    if (IN(5)) { PIN(54);
        Gemm g{2 * DM, 128, 2 * DM, 128, DM / 64};
        SchedSimple S; S.T.init(M_ROWS, DM, F.G, (int)blockIdx.x); S.A = (const char*)(ws + WS_LX); S.B = (const char*)(ws + WS_WOUT); S.tA = (size_t)256 * 2 * DM; S.tB = (size_t)256 * 2 * DM;
        EpiWout E{args.in[0], F.out, (bf16_t*)(ws + WS_XB), (float*)(ws + WS_SSQ)};
        for (int rep = 0; rep < NREP(5); ++rep) gemm_phase<EpiWout, SchedSimple>(ring, g, S, E);
        SEAM(5);
    }
    if (IN(6)) { PIN(33);
        Gemm g{2 * DM, 128, 2 * DM, 128, DM / 64};
        SchedHalfTail S; S.T.init(M_ROWS, NGU, F.G, (int)blockIdx.x); S.A = (const char*)(ws + WS_XB); S.B = (const char*)(ws + WS_WGU); S.tA = (size_t)256 * 2 * DM; S.tB = (size_t)256 * 2 * DM;
        S.full = (F.G % 8 == 0 && 2 * (S.T.nwg % F.G) <= F.G) ? S.T.nwg / F.G : (S.T.nwg + F.G - 1) / F.G;
        EpiGU E{(const float*)(ws + WS_SSQ), (bf16_t*)(ws + WS_FF)};
        for (int rep = 0; rep < NREP(6); ++rep) gemm_phase<EpiGU, SchedHalfTail, GEMM_ALIGN_P6>(ring, g, S, E);
        SEAM(6);
    }
    if (IN(7)) { PIN(39);
        Gemm g{2 * DFF, 128, 2 * DFF, 128, DFF / 64};
        SchedSimple S; S.T.init(M_ROWS, DM, F.G, (int)blockIdx.x); S.A = (const char*)(ws + WS_FF); S.B = (const char*)(ws + WS_WDN); S.tA = (size_t)256 * 2 * DFF; S.tB = (size_t)256 * 2 * DFF;
        EpiDown E{F.out, (const bf16_t*)(ws + WS_XB)};
        gemm_phase<EpiDown, SchedSimple>(ring, g, S, E);
#if PROBE_ID
        const unsigned now_ = (unsigned)__builtin_amdgcn_s_memrealtime();
        xcd_barrier(bar);
        if (blockIdx.x == 0 && F.tid == 0) { const unsigned* pc = (const unsigned*)(ws + WS_CTL) + 8192; float v = 0.f;
            const float c0 = (float)__hip_atomic_load(pc + 0, RLX_AGENT), c1 = (float)__hip_atomic_load(pc + 1, RLX_AGENT), c2 = (float)__hip_atomic_load(pc + 2, RLX_AGENT), c3 = (float)__hip_atomic_load(pc + 3, RLX_AGENT);
            const float c4 = (float)__hip_atomic_load(pc + 4, RLX_AGENT), c5 = (float)__hip_atomic_load(pc + 5, RLX_AGENT);
            if (PROBE_ID == 1) v = c4 / 1024.f;
            if (PROBE_ID == 2) v = 100.f * c0 / (c0 + c1 + c2 + c3);
            if (PROBE_ID == 3) v = 100.f * c1 / (c0 + c1 + c2 + c3);
            if (PROBE_ID == 4) v = 100.f * c2 / (c0 + c1 + c2 + c3);
            if (PROBE_ID == 5) v = 100.f * c3 / (c0 + c1 + c2 + c3);
            if (PROBE_ID == 6) v = 16.f * (c0 + c2 + c3) / (c4 + c5) / 100.f;
            if (PROBE_ID == 7) v = 16.f * c1 / 1024.f / 100.f;
            if (PROBE_ID >= 20 && PROBE_ID < 27) { float tot = 0.f, mine = 0.f;
                for (int i = 0; i < 7; ++i) { const float ci = (float)__hip_atomic_load(pc + 8 + i, RLX_AGENT); tot += ci; if (i == PROBE_ID - 20) mine = ci; }
                v = 100.f * mine / tot; }
            if (PROBE_ID >= 10 && PROBE_ID < 18) { const unsigned now = now_; const int k = PROBE_ID - 10;
                const unsigned t1 = k == 7 ? now : F.MISC[12 + k + 1], t0_ = F.MISC[12 + k]; v = (float)(t1 - t0_) * 0.01f; if (PROBE_ID == 10 || PROBE_ID == 16) v = 10.f + floorf(v / 20.f); if (PROBE_ID == 13) v = floorf(v * 0.5f) - 80.f; if (PROBE_ID == 14) v = 2.f * floorf(v * 0.5f); if (PROBE_ID == 11) v = 2.f * floorf((v - 150.f) * 0.5f); if (PROBE_ID == 15) v = 2.f * floorf(v * 0.5f); }
            const float y0 = __hip_atomic_load(F.out, RLX_AGENT); F.out[0] = y0 + v; }
#endif
    }
#undef IN
#undef SEAM
}

extern "C" void kernel_launch(void* const* d_in, const int* in_sizes, int n_in, void* d_out, int out_size, void* d_ws, size_t ws_size, hipStream_t stream) {
    static int grid = 0;
    if (grid == 0) {
        if (n_in != 29 || out_size != M_ROWS * DM || ws_size < WS_END) { fprintf(stderr, "kernel_launch: unexpected problem (n_in %d, out %d, ws %zu)\n", n_in, out_size, ws_size); grid = -1; return; }
        int dev = 0, cus = 0, per_cu = 0;
        if (hipGetDevice(&dev) != hipSuccess || hipDeviceGetAttribute(&cus, hipDeviceAttributeMultiprocessorCount, dev) != hipSuccess) { grid = -1; return; }
        if (hipFuncSetAttribute((const void*)fwd_kernel, hipFuncAttributeMaxDynamicSharedMemorySize, LDS_BYTES) != hipSuccess) { fprintf(stderr, "kernel_launch: hipFuncSetAttribute failed\n"); grid = -1; return; }
        if (hipOccupancyMaxActiveBlocksPerMultiprocessor(&per_cu, (const void*)fwd_kernel, NWAVES * 64, LDS_BYTES) != hipSuccess || per_cu < 1) { fprintf(stderr, "kernel_launch: occupancy query says %d blocks per CU\n", per_cu); grid = -1; return; }
        (void)hipGetLastError();
        grid = cus;
        if (grid > 256) grid = 256;
    }
    if (grid < 0) return;
    (void)hipMemsetAsync((char*)d_ws + WS_CTL, 0, CTL_ZERO_BYTES, stream);
    Args a{};
    for (int i = 0; i < 29; ++i) a.in[i] = (const float*)d_in[i];
    a.out = (float*)d_out; a.ws = (unsigned char*)d_ws;
#if N_LAUNCHES == 1
    a.ph_lo = 0; a.ph_hi = N_PHASES;
    hipLaunchKernelGGL(fwd_kernel, dim3(grid), dim3(NWAVES * 64), LDS_BYTES, stream, a);
#else
    for (int p = 0; p < N_PHASES; ++p) {
        a.ph_lo = p; a.ph_hi = p + 1;
        hipLaunchKernelGGL(fwd_kernel, dim3(grid), dim3(NWAVES * 64), LDS_BYTES, stream, a);
    }
#endif
}
```

```cpp
#include <hip/hip_runtime.h>
#include <cstdio>
#include <cstdint>
#ifndef N_LAUNCHES
#define N_LAUNCHES 1
#endif
#define NAIVE_P2 0
#define NAIVE_ATTN 0
#define FAST_ATTN 1
#define USE_NAIVE 0
#ifndef REP_PHASE
#define REP_PHASE -1
#endif
#ifndef PROBE_ID
#define PROBE_ID 0
#endif
#ifndef GEMM_ALIGN_P1
#define GEMM_ALIGN_P1 true
#endif
#ifndef GEMM_ALIGN_P6
#define GEMM_ALIGN_P6 true
#endif
namespace pg8 {
#define PG8_LAS __attribute__((address_space(3)))
typedef unsigned short bf16_t;
typedef short bf16x8 __attribute__((ext_vector_type(8)));
typedef float f32x4 __attribute__((ext_vector_type(4)));
typedef float f32x2 __attribute__((ext_vector_type(2)));
typedef unsigned u32x4 __attribute__((ext_vector_type(4)));
typedef unsigned u32x2 __attribute__((ext_vector_type(2)));
constexpr int BM = 256, BK = 64, HALF = 128, HTB = HALF * BK * 2  , STAGE_BYTES = 8 * HTB, NXCD = 8, WGM = 8;

__host__ __device__ __forceinline__ int lds_byte(int r, int c) { const int st = (r >> 4) * 2 + (c >> 5), rr = r & 15, cc = c & 31, ob = rr * 64 + cc * 2; return st * 1024 + (ob ^ (((ob >> 9) & 1) << 5)); }
__host__ __device__ __forceinline__ void stage_rc(int b, int& R, int& C) { const int st = b / 1024, sb = b % 1024, swz = sb ^ (((sb >> 9) & 1) << 5); R = (st >> 1) * 16 + swz / 64; C = (st & 1) * 32 + (swz % 64) / 2; }
__host__ __device__ __forceinline__ int perm32(int rho) { const int n = rho >> 4, i = rho & 15; return 8 * (i >> 2) + 4 * n + (i & 3); }

struct Unit { int pm, pn, kind, r0, half; };
struct Gemm { int rowA, kstepA, rowB, kstepB, nt; };

struct TileOrder {
    int nM, nN, nwg, G, c;
    __device__ void init(int M, int N, int G_, int c_) { nM = M / BM; nN = N / BM; nwg = nM * nN; G = G_; c = c_; }
    __device__ bool tile(int i, int& pm, int& pn) const { return tileL((long)i * G + c, pm, pn); }
    __device__ bool tileL(long L, int& pm, int& pn) const {
        if (L >= nwg) return false;
        int wgid = (int)L; { const int q = nwg / NXCD, r = nwg % NXCD, xcd = wgid % NXCD, off = wgid / NXCD; wgid = (xcd < r ? xcd * (q + 1) : r * (q + 1) + (xcd - r) * q) + off; }
        const int nig = WGM * nN, gid = wgid / nig, fm = gid * WGM, gsz = (nM - fm) < WGM ? (nM - fm) : WGM;
        pm = fm + ((wgid % nig) % gsz); pn = (wgid % nig) / gsz; return true;
    }
};

__device__ __forceinline__ unsigned cvt_pk_bf16(float lo, float hi) { unsigned r; asm volatile("v_cvt_pk_bf16_f32 %0, %1, %2" : "=v"(r) : "v"(lo), "v"(hi)); return r; }

template <class Epi, class Sched, bool ALIGN_EPI = true>
__device__ __forceinline__ void gemm_phase(PG8_LAS unsigned char* lds, const Gemm g, const Sched& S, const Epi& E) {
    const int tid = threadIdx.x, wid = __builtin_amdgcn_readfirstlane(tid >> 6), lane = tid & 63, wr = wid >> 2, wc = wid & 3, fr = lane & 15, fq = lane >> 4;
    const int nt = g.nt;
    unsigned voffA[2], voffB[2];
#pragma unroll
    for (int i = 0; i < 2; ++i) { int R, C; stage_rc(tid * 16 + i * 8192, R, C); const int Rb = Epi::PERM ? ((R & ~31) + perm32(R & 31)) : R;
        voffA[i] = (unsigned)(R * g.rowA + C * 2); voffB[i] = (unsigned)(Rb * g.rowB + C * 2); }
    const size_t kstepA = (size_t)g.kstepA, kstepB = (size_t)g.kstepB;
    const size_t hstepA = (size_t)HALF * g.rowA, hstepB = (size_t)HALF * g.rowB;
    const unsigned ldsw = (unsigned)wid * 1024u;
    const int aoff = lds_byte(wr * 64 + fr, fq * 8), boff = lds_byte(wc * 32 + fr, fq * 8);
#define PG8_SA(b, h) (((b) * 2 + (h)) * HTB)
#define PG8_SB(b, h) ((4 + (b) * 2 + (h)) * HTB)
#define PG8_STAGE(bufoff, gbase, voff) do { _Pragma("unroll") for (int _i = 0; _i < 2; ++_i) \
        __builtin_amdgcn_global_load_lds((const unsigned*)((const char*)(gbase) + (voff)[_i]), (PG8_LAS unsigned*)(lds + (bufoff) + ldsw + _i * 8192), 16, 0, 0); } while (0)
#define PG8_LDA(dst, b, h) do { _Pragma("unroll") for (int m = 0; m < 4; ++m) _Pragma("unroll") for (int k = 0; k < 2; ++k) dst[m][k] = *(const PG8_LAS bf16x8*)(lds + PG8_SA(b, h) + aoff + m * 2048 + k * 1024); } while (0)
#define PG8_LDB(dst, b, h) do { _Pragma("unroll") for (int n = 0; n < 2; ++n) _Pragma("unroll") for (int k = 0; k < 2; ++k) dst[n][k] = *(const PG8_LAS bf16x8*)(lds + PG8_SB(b, h) + boff + n * 2048 + k * 1024); } while (0)
#define PG8_MMA(ai, bj, At, Bt) do { __builtin_amdgcn_s_setprio(1); _Pragma("unroll") for (int m = 0; m < 4; ++m) _Pragma("unroll") for (int n = 0; n < 2; ++n) _Pragma("unroll") for (int k = 0; k < 2; ++k) \
        acc[ai][bj][m][n] = __builtin_amdgcn_mfma_f32_16x16x32_bf16(Bt[n][k], At[m][k], acc[ai][bj][m][n], 0, 0, 0); __builtin_amdgcn_s_setprio(0); } while (0)
#define PG8_WAIT_V(n) asm volatile("s_waitcnt vmcnt(" #n ")" ::: "memory")
#define PG8_WAIT_L(n) asm volatile("s_waitcnt lgkmcnt(" #n ")" ::: "memory")
#define PG8_BAR __builtin_amdgcn_s_barrier()
#define PG8_SCHED __builtin_amdgcn_sched_barrier(0)
    Unit cur, nxt; int ui = 0;
    if (!S.next(0, cur)) return;
    f32x4 acc[2][2][4][2];
#pragma unroll
    for (int a = 0; a < 2; ++a)
#pragma unroll
        for (int b = 0; b < 2; ++b)
#pragma unroll
            for (int m = 0; m < 4; ++m)
#pragma unroll
                for (int n = 0; n < 2; ++n) acc[a][b][m][n] = (f32x4){0.f, 0.f, 0.f, 0.f};
    bf16x8 At[4][2], B0[2][2], B1[2][2];
    const char* cA = S.abase(cur); const char* cB = S.bbase(cur);
    PG8_STAGE(PG8_SB(0, 0), cB, voffB); PG8_STAGE(PG8_SB(0, 1), cB + hstepB, voffB); PG8_STAGE(PG8_SA(0, 0), cA, voffA); PG8_STAGE(PG8_SA(0, 1), cA + hstepA, voffA);
    if (wr == 1) PG8_BAR;
    PG8_WAIT_V(2); PG8_BAR;
    PG8_STAGE(PG8_SB(1, 0), cB + kstepB, voffB); PG8_STAGE(PG8_SA(1, 0), cA + kstepA, voffA); PG8_STAGE(PG8_SB(1, 1), cB + hstepB + kstepB, voffB);
    PG8_WAIT_V(6); PG8_BAR;
    for (;;) {
        const bool has_next = S.next(ui + 1, nxt);
        const char* nA = has_next ? S.abase(nxt) : cA; const char* nB = has_next ? S.bbase(nxt) : cB;
        asm volatile(".p2align 8\n\ts_nop 0\n\ts_nop 0\n\ts_nop 0\n\ts_nop 0\n\ts_nop 0\n\ts_nop 0");
        for (int t = 0; t < nt; t += 2) {
            const bool last = (t == nt - 2);
            const char* a1 = cA + (size_t)(t + 1) * kstepA;
            const char* a2 = last ? nA : cA + (size_t)(t + 2) * kstepA; const char* b2 = last ? nB : cB + (size_t)(t + 2) * kstepB;
            const char* a3 = a2 + kstepA; const char* b3 = b2 + kstepB;
            PG8_LDB(B0, 0, 0); PG8_LDB(B1, 0, 1); PG8_SCHED; PG8_LDA(At, 0, 0); PG8_STAGE(PG8_SA(1, 1), a1 + hstepA, voffA);
            PG8_WAIT_V(8); PG8_WAIT_L(0); PG8_BAR; PG8_MMA(0, 0, At, B0); PG8_MMA(0, 1, At, B1); PG8_BAR; PG8_SCHED;
            PG8_LDA(At, 0, 1); PG8_STAGE(PG8_SB(0, 0), b2, voffB); PG8_STAGE(PG8_SB(0, 1), b2 + hstepB, voffB); PG8_STAGE(PG8_SA(0, 0), a2, voffA);
            PG8_WAIT_V(8); PG8_WAIT_L(0); PG8_BAR; if (!cur.half) { PG8_MMA(1, 0, At, B0); PG8_MMA(1, 1, At, B1); } PG8_BAR; PG8_SCHED;
            PG8_LDB(B0, 1, 0); PG8_LDB(B1, 1, 1); PG8_SCHED; PG8_LDA(At, 1, 0); PG8_STAGE(PG8_SA(0, 1), a2 + hstepA, voffA);
            PG8_WAIT_V(8); PG8_WAIT_L(0); PG8_BAR; PG8_MMA(0, 0, At, B0); PG8_MMA(0, 1, At, B1); PG8_BAR; PG8_SCHED;
            PG8_LDA(At, 1, 1); PG8_STAGE(PG8_SB(1, 0), b3, voffB); PG8_STAGE(PG8_SB(1, 1), b3 + hstepB, voffB); PG8_STAGE(PG8_SA(1, 0), a3, voffA);
            PG8_WAIT_V(8); PG8_WAIT_L(0); PG8_BAR; if (!cur.half) { PG8_MMA(1, 0, At, B0); PG8_MMA(1, 1, At, B1); } PG8_BAR; PG8_SCHED;
        }
        if constexpr (ALIGN_EPI) { if (wr == 0) PG8_BAR; }
        const bool keep = E(acc, cur, wr, wc, fr, fq);
        if (!has_next) break;
        if (!keep) {
#pragma unroll
        for (int a = 0; a < 2; ++a)
#pragma unroll
            for (int b = 0; b < 2; ++b)
#pragma unroll
                for (int m = 0; m < 4; ++m)
#pragma unroll
                    for (int n = 0; n < 2; ++n) acc[a][b][m][n] = (f32x4){0.f, 0.f, 0.f, 0.f};
        }
        cur = nxt; cA = nA; cB = nB; ++ui;
        if constexpr (ALIGN_EPI) { if (wr == 1) PG8_BAR; }
    }
    PG8_WAIT_V(0);
    if constexpr (!ALIGN_EPI) { if (wr == 0) PG8_BAR; }
    PG8_BAR;
#undef PG8_SA
#undef PG8_SB
#undef PG8_STAGE
#undef PG8_LDA
#undef PG8_LDB
#undef PG8_MMA
#undef PG8_WAIT_V
#undef PG8_WAIT_L
#undef PG8_BAR
#undef PG8_SCHED
}
}
constexpr int BATCH = 4, SEQ = 4096, DM = 1024, M_ROWS = BATCH * SEQ;
constexpr int NH = 16, HD = 64, NKV = 4, HPG = 4, KVW = 1536;
constexpr int IN_DIM = 6704, NPROJ = 6912;
constexpr int DFF = 2816, NGU = 2 * DFF;
constexpr int NCMP = 255, NCP = 256;
constexpr float EPS = 1e-6f;
constexpr float LOG2E = 1.4426950408889634f;

__device__ __forceinline__ float fast_sigmoid(float x) { return __builtin_amdgcn_rcpf(1.f + __builtin_amdgcn_exp2f(-LOG2E * x)); }
__device__ __forceinline__ float gelu_tanh(float x) { return x * fast_sigmoid(x * (1.5957691216f + 0.0713548163f * x * x)); }

namespace pg8 {
struct SchedSimple {
    TileOrder T; const char* A; const char* B; size_t tA, tB;
    __device__ __forceinline__ bool next(int i, Unit& u) const { u.kind = 0; u.half = 0; const bool ok = T.tile(i, u.pm, u.pn); u.r0 = u.pm * BM; return ok; }
    __device__ __forceinline__ const char* abase(const Unit& u) const { return A + (size_t)u.pm * tA; }
    __device__ __forceinline__ const char* bbase(const Unit& u) const { return B + (size_t)u.pn * tB; }
};
struct SchedHalfTail {
    TileOrder T; const char* A; const char* B; size_t tA, tB; int full;
    __device__ __forceinline__ bool next(int i, Unit& u) const {
        u.kind = 0;
        if (i < full) { u.half = 0; const bool ok = T.tile(i, u.pm, u.pn); u.r0 = u.pm * BM; return ok; }
        if (i > full) return false;
        const int idx = T.c >> 3, lab = T.c & 7;
        const bool ok = T.tileL((long)full * T.G + 8 * (idx >> 1) + lab, u.pm, u.pn); u.half = 1; u.r0 = u.pm * BM + (idx & 1) * HALF; return ok;
    }
    __device__ __forceinline__ const char* abase(const Unit& u) const { return A + (size_t)u.r0 * (tA / BM); }
    __device__ __forceinline__ const char* bbase(const Unit& u) const { return B + (size_t)u.pn * tB; }
};
struct SchedMerge {
    TileOrder T; const char* A0; const char* A1; const char* B0; const char* B1; size_t tA, tB;
    __device__ __forceinline__ bool next(int i, Unit& u) const { u.kind = i & 1; u.half = 0; const bool ok = T.tile(i >> 1, u.pm, u.pn); u.r0 = u.pm * BM; return ok; }
    __device__ __forceinline__ const char* abase(const Unit& u) const { return (u.kind ? A1 : A0) + (size_t)u.pm * tA; }
    __device__ __forceinline__ const char* bbase(const Unit& u) const { return (u.kind ? B1 : B0) + (size_t)u.pn * tB; }
};

typedef f32x4 Acc[2][2][4][2];
#define EPI_ROW(ai, m) (u.r0 + (ai) * HALF + wr * 64 + (m) * 16 + fr)
#define EPI_CT(bj) ((bj) * HALF + wc * 32 + 8 * fq)

__device__ __forceinline__ u32x4 pack8(f32x4 a, f32x4 b) { u32x4 w; w.x = cvt_pk_bf16(a[0], a[1]); w.y = cvt_pk_bf16(a[2], a[3]); w.z = cvt_pk_bf16(b[0], b[1]); w.w = cvt_pk_bf16(b[2], b[3]); return w; }

struct EpiProj {
    static constexpr bool PERM = true;
    const float* rstd; bf16_t *QB, *KVB, *NG, *LX, *LGG, *MG;
    __device__ __forceinline__ bool operator()(Acc& acc, const Unit& u, int wr, int wc, int fr, int fq) const {
        const int pn = u.pn; bf16_t* dst; int ld, c0, act = 0, lim = 256;
        if (pn < 4) { dst = QB; ld = DM; c0 = pn * 256; }
        else if (pn < 10) { dst = KVB; ld = KVW; c0 = (pn - 4) * 256; }
        else if (pn == 10) { dst = NG; ld = 48; c0 = 0; act = 1; lim = 48; }
        else if (pn < 15) { dst = LX; ld = DM; c0 = (pn - 11) * 256; act = 3; }
        else if (pn < 19) { dst = LGG; ld = DM; c0 = (pn - 15) * 256; act = 2; }
        else {
            bf16_t* MGp = MG + (pn - 19) * 128;
#pragma unroll
            for (int ai = 0; ai < 2; ++ai)
#pragma unroll
                for (int m = 0; m < 4; ++m) {
                    const int row = EPI_ROW(ai, m); const float rs = rstd[row];
                    f32x4 a0 = acc[ai][0][m][0] * rs, a1 = acc[ai][0][m][1] * rs, b0 = acc[ai][1][m][0] * rs, b1 = acc[ai][1][m][1] * rs;
#pragma unroll
                    for (int e = 0; e < 4; ++e) { a0[e] = fast_sigmoid(a0[e]); a1[e] = fast_sigmoid(a1[e]); b0[e] = fast_sigmoid(b0[e]); b1[e] = fast_sigmoid(b1[e]); }
                    const u32x4 w1 = pack8(b0, b1);
                    b0[0] = __uint_as_float(w1.x << 16); b0[1] = __uint_as_float(w1.x & 0xffff0000u); b0[2] = __uint_as_float(w1.y << 16); b0[3] = __uint_as_float(w1.y & 0xffff0000u);
                    b1[0] = __uint_as_float(w1.z << 16); b1[1] = __uint_as_float(w1.z & 0xffff0000u); b1[2] = __uint_as_float(w1.w << 16); b1[3] = __uint_as_float(w1.w & 0xffff0000u);
#pragma unroll
                    for (int e = 0; e < 4; ++e) { a0[e] *= __builtin_amdgcn_rcpf(fmaxf(b0[e], 8.6736174e-19f)); a1[e] *= __builtin_amdgcn_rcpf(fmaxf(b1[e], 8.6736174e-19f)); }
                    bf16_t* q = MGp + (size_t)row * (2 * DM) + wc * 32 + 8 * fq;
                    *(u32x4*)q = pack8(a0, a1); *(u32x4*)(q + DM) = w1;
                }
            return false;
        }
#pragma unroll
        for (int ai = 0; ai < 2; ++ai)
#pragma unroll
            for (int m = 0; m < 4; ++m) {
                const int row = EPI_ROW(ai, m); const float rs = rstd[row];
#pragma unroll
                for (int bj = 0; bj < 2; ++bj) {
                    const int ct = EPI_CT(bj);
                    f32x4 v0 = acc[ai][bj][m][0] * rs, v1 = acc[ai][bj][m][1] * rs;
                    if (act == 1) {
#pragma unroll
                        for (int e = 0; e < 4; ++e) { v0[e] = fast_sigmoid(v0[e]); v1[e] = fast_sigmoid(v1[e]); }
                    } else if (act == 2) {
#pragma unroll
                        for (int e = 0; e < 4; ++e) { v0[e] = gelu_tanh(v0[e]); v1[e] = gelu_tanh(v1[e]); }
                    }
                    u32x4 pk;
                    if (act == 3) { pk.x = __builtin_bit_cast(unsigned, __builtin_amdgcn_cvt_pkrtz(v0[0], v0[1])); pk.y = __builtin_bit_cast(unsigned, __builtin_amdgcn_cvt_pkrtz(v0[2], v0[3]));
                                    pk.z = __builtin_bit_cast(unsigned, __builtin_amdgcn_cvt_pkrtz(v1[0], v1[1])); pk.w = __builtin_bit_cast(unsigned, __builtin_amdgcn_cvt_pkrtz(v1[2], v1[3])); }
                    else pk = pack8(v0, v1);
                    if (ct + 8 <= lim) *(u32x4*)(dst + (size_t)row * ld + c0 + ct) = pk;
                }
            }
        return false;
    }
};

struct EpiMerge {
    static constexpr bool PERM = true;
    const bf16_t* MG; bf16_t* MRG;
    __device__ __forceinline__ bool operator()(Acc& acc, const Unit& u, int wr, int wc, int fr, int fq) const {
        const bf16_t* MGp = MG; bf16_t* MRGp = MRG;
        asm volatile("" : "+s"(MGp), "+s"(MRGp));
#pragma unroll
        for (int ai = 0; ai < 2; ++ai)
#pragma unroll
            for (int m = 0; m < 4; ++m) {
                const int row = EPI_ROW(ai, m);
#pragma unroll
                for (int bj = 0; bj < 2; ++bj) {
                    const int col = u.pn * BM + EPI_CT(bj);
                    if (u.kind == 0) {
                        const u32x4 w0 = *(const u32x4*)(MGp + (size_t)row * (2 * DM) + col);
                        f32x4 a0, a1;
                        a0[0] = __uint_as_float(w0.x << 16); a0[1] = __uint_as_float(w0.x & 0xffff0000u); a0[2] = __uint_as_float(w0.y << 16); a0[3] = __uint_as_float(w0.y & 0xffff0000u);
                        a1[0] = __uint_as_float(w0.z << 16); a1[1] = __uint_as_float(w0.z & 0xffff0000u); a1[2] = __uint_as_float(w0.w << 16); a1[3] = __uint_as_float(w0.w & 0xffff0000u);
                        acc[ai][bj][m][0] *= a0; acc[ai][bj][m][1] *= a1;
                    } else {
                        const u32x4 w1 = *(const u32x4*)(MGp + (size_t)row * (2 * DM) + DM + col);
                        f32x4 b0, b1;
                        b0[0] = __uint_as_float(w1.x << 16); b0[1] = __uint_as_float(w1.x & 0xffff0000u); b0[2] = __uint_as_float(w1.y << 16); b0[3] = __uint_as_float(w1.y & 0xffff0000u);
                        b1[0] = __uint_as_float(w1.z << 16); b1[1] = __uint_as_float(w1.z & 0xffff0000u); b1[2] = __uint_as_float(w1.w << 16); b1[3] = __uint_as_float(w1.w & 0xffff0000u);
#pragma unroll
                        for (int e = 0; e < 4; ++e) { b0[e] = fmaxf(b0[e], 8.6736174e-19f); b1[e] = fmaxf(b1[e], 8.6736174e-19f); }
                        *(u32x4*)(MRGp + (size_t)row * DM + col) = pack8(acc[ai][bj][m][0] * b0, acc[ai][bj][m][1] * b1);
                    }
                }
                asm volatile("" ::: "memory");
            }
        return u.kind == 0;
    }
};

struct EpiWout {
    static constexpr bool PERM = true;
    const float* x; float* out; bf16_t* X1B; float* ssq;
    __device__ __forceinline__ bool operator()(Acc& acc, const Unit& u, int wr, int wc, int fr, int fq) const {
#pragma unroll
        for (int ai = 0; ai < 2; ++ai)
#pragma unroll
            for (int m = 0; m < 4; ++m) {
                const int row = EPI_ROW(ai, m); float s = 0.f;
#pragma unroll
                for (int bj = 0; bj < 2; ++bj) {
                    const int col = u.pn * BM + EPI_CT(bj); const size_t off = (size_t)row * DM + col;
                    const f32x4 v0 = *(const f32x4*)(x + off) + acc[ai][bj][m][0], v1 = *(const f32x4*)(x + off + 4) + acc[ai][bj][m][1];
                    *(u32x4*)(X1B + off) = pack8(v0, v1);
                    s += (v0[0] * v0[0] + v0[1] * v0[1]) + (v0[2] * v0[2] + v0[3] * v0[3]) + (v1[0] * v1[0] + v1[1] * v1[1]) + (v1[2] * v1[2] + v1[3] * v1[3]);
                }
                s += __shfl_xor(s, 16); s += __shfl_xor(s, 32);
                if (fq == 0) ssq[(size_t)row * 16 + u.pn * 4 + wc] = s;
            }
        return false;
    }
};

struct EpiGU {
    static constexpr bool PERM = true;
    const float* ssq; bf16_t* FF;
    __device__ __forceinline__ bool operator()(Acc& acc, const Unit& u, int wr, int wc, int fr, int fq) const {
#pragma unroll
        for (int ai = 0; ai < 2; ++ai)
            if (ai == 0 || !u.half)
#pragma unroll
            for (int m = 0; m < 4; ++m) {
                const int row = EPI_ROW(ai, m);
                const f32x4* sp = (const f32x4*)(ssq + (size_t)row * 16);
                const f32x4 s0 = sp[0], s1 = sp[1], s2 = sp[2], s3 = sp[3];
                const float tot = ((s0[0] + s0[1]) + (s0[2] + s0[3])) + ((s1[0] + s1[1]) + (s1[2] + s1[3])) + ((s2[0] + s2[1]) + (s2[2] + s2[3])) + ((s3[0] + s3[1]) + (s3[2] + s3[3]));
                const float rs = __builtin_amdgcn_rsqf(tot * (1.f / DM) + EPS);
                f32x4 o[2];
#pragma unroll
                for (int n = 0; n < 2; ++n)
#pragma unroll
                    for (int e = 0; e < 4; ++e) { const float g = acc[ai][0][m][n][e] * rs, up = acc[ai][1][m][n][e] * rs; o[n][e] = g * fast_sigmoid(g) * up; }
                *(u32x4*)(FF + (size_t)row * DFF + u.pn * HALF + wc * 32 + 8 * fq) = pack8(o[0], o[1]);
            }
        return false;
    }
};

struct EpiDown {
    static constexpr bool PERM = true;
    float* out; const bf16_t* X1B;
    __device__ __forceinline__ bool operator()(Acc& acc, const Unit& u, int wr, int wc, int fr, int fq) const {
#pragma unroll
        for (int ai = 0; ai < 2; ++ai)
#pragma unroll
            for (int m = 0; m < 4; ++m) {
                const int row = EPI_ROW(ai, m);
#pragma unroll
                for (int bj = 0; bj < 2; ++bj) {
                    const size_t off = (size_t)row * DM + u.pn * BM + EPI_CT(bj);
                    const u32x4 xw = *(const u32x4*)(X1B + off);
                    f32x4 x0, x1;
                    x0[0] = __uint_as_float(xw.x << 16); x0[1] = __uint_as_float(xw.x & 0xffff0000u); x0[2] = __uint_as_float(xw.y << 16); x0[3] = __uint_as_float(xw.y & 0xffff0000u);
                    x1[0] = __uint_as_float(xw.z << 16); x1[1] = __uint_as_float(xw.z & 0xffff0000u); x1[2] = __uint_as_float(xw.w << 16); x1[3] = __uint_as_float(xw.w & 0xffff0000u);
                    *(f32x4*)(out + off) = x0 + acc[ai][bj][m][0]; *(f32x4*)(out + off + 4) = x1 + acc[ai][bj][m][1];
                }
            }
        return false;
    }
};
#undef EPI_ROW
#undef EPI_CT
}
constexpr size_t MiB = 1u << 20;
constexpr size_t WS_CTL = 0, CTL_ZERO_BYTES = 1 * MiB;
constexpr size_t WS_NG = 1 * MiB;
constexpr size_t WS_RSTD1 = 3 * MiB;
constexpr size_t WS_SSQ = 4 * MiB;
constexpr size_t WS_KC = 5 * MiB;
constexpr size_t WS_VC = 5 * MiB + 512 * 1024;
constexpr size_t WS_LSUM = 6 * MiB;
constexpr size_t WS_CW2 = 7 * MiB;
constexpr size_t WS_LW = 7 * MiB + 256 * 1024;
constexpr size_t WS_HID = 8 * MiB;
constexpr size_t WS_CW1 = 12 * MiB;
constexpr size_t WS_WOA = 14 * MiB, WS_WOL = 16 * MiB, WS_WOUT = 18 * MiB;
constexpr size_t WS_WDN = 20 * MiB;
constexpr size_t WS_WGU = 26 * MiB;
constexpr size_t WS_WIN = 37 * MiB;
constexpr size_t WS_XB = 51 * MiB;
constexpr size_t WS_HL = 51 * MiB;
constexpr size_t WS_PC0 = 227 * MiB;
constexpr size_t WS_PC3 = 37 * MiB;
constexpr size_t WS_QB = 83 * MiB;
constexpr size_t WS_KVB = 115 * MiB;
constexpr size_t WS_LX = 163 * MiB;
constexpr size_t WS_LGG = 195 * MiB;
constexpr size_t WS_MRGF = 83 * MiB;
constexpr size_t WS_FF = 83 * MiB;
constexpr size_t WS_END = 251 * MiB;

constexpr int CW_BAR = 4096;
constexpr int CW_QUEUE = 16384;

constexpr int RING_BYTES = 131072;
constexpr int LDSCTL_OFF = RING_BYTES, MISC_OFF = LDSCTL_OFF + 320;
constexpr int LDS_BYTES = 147456;
constexpr int NWAVES = 8;

#define GAS __attribute__((address_space(1)))
#define LAS __attribute__((address_space(3)))
typedef unsigned short bf16;
typedef unsigned v4u __attribute__((ext_vector_type(4)));
typedef unsigned v2u __attribute__((ext_vector_type(2)));
typedef float f32x4 __attribute__((ext_vector_type(4)));
typedef short bf16x8 __attribute__((ext_vector_type(8)));
typedef GAS unsigned gu32;
#define RLX_AGENT __ATOMIC_RELAXED, __HIP_MEMORY_SCOPE_AGENT
#define LDS_WAIT() asm volatile("s_waitcnt lgkmcnt(0)" ::: "memory")
#define VM_WAIT() asm volatile("s_waitcnt vmcnt(0)" ::: "memory")
__device__ __forceinline__ unsigned f2bf(float f) { unsigned u = __builtin_bit_cast(unsigned, f); return (u + 0x7fffu + ((u >> 16) & 1u)) >> 16; }
__device__ __forceinline__ unsigned pk2(float lo, float hi) { return f2bf(lo) | (f2bf(hi) << 16); }
__device__ __forceinline__ float bf2f(unsigned short h) { return __uint_as_float((unsigned)h << 16); }
__device__ __forceinline__ float bflo(unsigned w) { return __uint_as_float(w << 16); }
__device__ __forceinline__ float bfhi(unsigned w) { return __uint_as_float(w & 0xffff0000u); }

#define XB_TMO      128
#define XB_XCNT(j)  (256  + 64 * (j))
#define XB_XSUB(j)  (1280 + 64 * (j))
#define XB_XGEN(j)  (2304 + 64 * (j))
#define XB_TOP      3328
#define XB_TOPGEN   3392
#define XCD_BAR_WORDS 3456
#define XB_SPIN_CAP (1u << 20)
__device__ __forceinline__ unsigned xb_ld(unsigned* p)              { return __hip_atomic_load(p, __ATOMIC_RELAXED, __HIP_MEMORY_SCOPE_AGENT); }
__device__ __forceinline__ unsigned xb_add(unsigned* p, unsigned v) { return __hip_atomic_fetch_add(p, v, __ATOMIC_RELAXED, __HIP_MEMORY_SCOPE_AGENT); }
__device__ __forceinline__ unsigned xb_xcc_id() { return (unsigned)__builtin_amdgcn_s_getreg((3 << 11) | 20) & 0xFu; }
#define XB_SPIN(cond, bar) do { unsigned _sp = 0; while (cond) { __builtin_amdgcn_s_sleep(1); \
    if ((++_sp & 255u) == 0u) { if (xb_ld(&(bar)[XB_TMO])) break; if (_sp > XB_SPIN_CAP) { atomicAdd(&(bar)[XB_TMO], 1u); break; } } } } while (0)
struct XcdBarrier { unsigned* bar; unsigned x; volatile LAS unsigned* st; };
__device__ __forceinline__ XcdBarrier xcd_barrier_post(unsigned* bar, volatile LAS unsigned* st) {
    XcdBarrier b; b.bar = bar; b.x = xb_xcc_id(); b.st = st;
    if (threadIdx.x == 0) (void)xb_add(&bar[XB_XCNT(b.x)], 1u);
    return b;
}
__device__ __forceinline__ void xcd_barrier_complete(unsigned* bar, unsigned x, unsigned& nloc, unsigned& nx) {
    const unsigned G = gridDim.x * gridDim.y * gridDim.z;
    unsigned sum, cnt, mine, sp = 0u;
    for (;;) {
        sum = 0u; cnt = 0u; mine = 0u;
#pragma unroll
        for (unsigned j = 0; j < 16; ++j) { const unsigned c = xb_ld(&bar[XB_XCNT(j)]); sum += c; cnt += (c > 0u) ? 1u : 0u; mine = (j == x) ? c : mine; }
        if (sum == G) break;
        __builtin_amdgcn_s_sleep(1);
        if ((++sp & 255u) == 0u) { if (xb_ld(&bar[XB_TMO])) break; if (sp > XB_SPIN_CAP) { atomicAdd(&bar[XB_TMO], 1u); break; } }
    }
    nloc = mine > 0u ? mine : 1u; nx = cnt > 0u ? cnt : 1u;
}
__device__ __forceinline__ void xcd_barrier(const XcdBarrier& b) {
    asm volatile("s_waitcnt vmcnt(0)" ::: "memory");
    __syncthreads();
    if (threadIdx.x == 0) {
        unsigned* bar = b.bar;
        __builtin_amdgcn_s_waitcnt(0);
        unsigned nloc = b.st[0], nx = b.st[1];
        if (nloc == 0u) { xcd_barrier_complete(bar, b.x, nloc, nx); b.st[0] = nloc; b.st[1] = nx; }
        const unsigned old = xb_add(&bar[XB_XSUB(b.x)], 1u);
        const unsigned gen = old / nloc;
        if (old + 1u == (gen + 1u) * nloc) {
            __builtin_amdgcn_fence(__ATOMIC_RELEASE, "agent");
            asm volatile("s_waitcnt vmcnt(0)" ::: "memory");
            const unsigned og = xb_add(&bar[XB_TOP], 1u);
            const unsigned tg = og / nx;
            if (og + 1u == (tg + 1u) * nx) xb_add(&bar[XB_TOPGEN], 1u);
            else XB_SPIN(xb_ld(&bar[XB_TOPGEN]) == tg, bar);
            __builtin_amdgcn_fence(__ATOMIC_ACQUIRE, "agent");
            xb_add(&bar[XB_XGEN(b.x)], 1u);
            asm volatile("s_waitcnt vmcnt(0)" ::: "memory");
        } else {
            XB_SPIN(xb_ld(&bar[XB_XGEN(b.x)]) == gen, bar);
            __builtin_amdgcn_fence(__ATOMIC_ACQUIRE, "agent");
            asm volatile("s_waitcnt vmcnt(0)" ::: "memory");
        }
    }
    __syncthreads();
}

constexpr int CW_LAB = 20480;
__device__ __forceinline__ void label_barrier(unsigned* cnt, unsigned members, unsigned* bar) {
    asm volatile("s_waitcnt vmcnt(0)" ::: "memory");
    __syncthreads();
    if (threadIdx.x == 0) {
        const unsigned old = xb_add(cnt, 1u);
        const unsigned target = (old / members + 1u) * members;
        XB_SPIN(xb_ld(cnt) < target, bar);
        __builtin_amdgcn_fence(__ATOMIC_ACQUIRE, "agent");
        asm volatile("s_waitcnt vmcnt(0)" ::: "memory");
    }
    __syncthreads();
}

struct Frame {
    LAS unsigned char* lds;
    volatile LAS unsigned* MISC;
    gu32* ctl;
    int tid, lane, wave, vcu, G, grp;
    float* out; unsigned char* ws;
};
struct Args { const float* in[29]; float* out; unsigned char* ws; int ph_lo, ph_hi; };
__device__ __forceinline__ float wave_sum(float v) {
#pragma unroll
    for (int o = 1; o < 64; o <<= 1) v += __shfl_xor(v, o);
    return v;
}

struct ConvItem { const float* W; const float* gk; bf16* WT; int ldw, k0, nsrc, nvalid, ldt, ndst, fragmajor; };
constexpr int I_IN = (NPROJ / 32) * 16, I_SQ = 32 * 16, I_GU = (DFF / 32) * 16, I_DN = 32 * (DFF / 64), I_C1 = 8 * 32, I_C2 = 2 * 4, I_LW = 16 * 2;
constexpr int I_EARLY = I_IN + 2 * I_C1 + 2 * I_C2 + 2 * I_LW + I_GU, I_LATE = I_GU + 3 * I_SQ + I_DN;
__device__ __forceinline__ ConvItem p0_item(const Args& A, unsigned char* ws, int r) {
    ConvItem d; d.gk = nullptr; d.nvalid = 32; d.fragmajor = 0;
    if (r < I_IN) { const int nb = r % (NPROJ / 32), kb = r / (NPROJ / 32); int nsrc, nv = 32;
        if (nb < 80) nsrc = 32 * nb; else if (nb < 88) { nsrc = 2560 + 32 * (nb - 80); nv = 48 - 32 * (nb - 80); nv = nv < 0 ? 0 : (nv > 32 ? 32 : nv); } else if (nb < 152) nsrc = 2608 + 32 * (nb - 88);
        else { const int dc = 32 * (nb - 152), j = dc >> 8, w = dc & 255; nsrc = 2608 + 2048 + (w >> 7) * 1024 + 128 * j + (w & 127); }
        d.W = A.in[2]; d.ldw = IN_DIM; d.k0 = 64 * kb; d.nsrc = nsrc; d.nvalid = nv; d.WT = (bf16*)(ws + WS_WIN); d.ldt = DM; d.ndst = 32 * nb; d.gk = A.in[1]; return d; }
    r -= I_IN;
    if (r < 2 * I_C1) { const int w = r / I_C1, q = r % I_C1, nb = q % 8, kb = q / 8;
        d.W = w == 0 ? A.in[6] : A.in[11]; d.ldw = 256; d.k0 = 64 * kb; d.nsrc = 32 * nb; d.WT = (bf16*)(ws + WS_CW1) + (size_t)w * 256 * 2048; d.ldt = 2048; d.ndst = 32 * nb; d.fragmajor = 1; return d; }
    r -= 2 * I_C1;
    if (r < 2 * I_C2) { const int w = r / I_C2, q = r % I_C2, nb = q % 2, kb = q / 2;
        d.W = w == 0 ? A.in[8] : A.in[13]; d.ldw = 64; d.k0 = 64 * kb; d.nsrc = 32 * nb; d.WT = (bf16*)(ws + WS_CW2) + (size_t)w * 64 * 256; d.ldt = 256; d.ndst = 32 * nb; return d; }
    r -= 2 * I_C2;
    if (r < 2 * I_LW) { const int w = r / I_LW, q = r % I_LW, nb = q % 2, blk = q / 2;
        d.W = (w == 0 ? A.in[17] : A.in[19]) + (size_t)blk * 4096; d.ldw = 64; d.k0 = 0; d.nsrc = 32 * nb; d.WT = (bf16*)(ws + WS_LW) + (size_t)(w * 16 + blk) * 4096; d.ldt = 64; d.ndst = 32 * nb; return d; }
    r -= 2 * I_LW;
    if (r < 2 * I_GU) { const int w = r / I_GU, q = r % I_GU, nb = q % (DFF / 32), kb = q / (DFF / 32); const int c = 32 * nb;
        d.W = w == 0 ? A.in[26] : A.in[27]; d.ldw = DFF; d.k0 = 64 * kb; d.nsrc = c; d.WT = (bf16*)(ws + WS_WGU); d.ldt = DM; d.ndst = 256 * (c / 128) + (c % 128) + 128 * w; d.gk = A.in[25]; return d; }
    r -= 2 * I_GU;
    if (r < 3 * I_SQ) { const int w = r / I_SQ, q = r % I_SQ, nb = q % 32, kb = q / 32;
        d.W = w == 0 ? A.in[22] : (w == 1 ? A.in[23] : A.in[24]); d.WT = (bf16*)(ws + (w == 0 ? WS_WOA : (w == 1 ? WS_WOL : WS_WOUT)));
        d.ldw = DM; d.k0 = 64 * kb; d.nsrc = 32 * nb; d.ldt = DM; d.ndst = 32 * nb; return d; }
    r -= 3 * I_SQ;
    { const int nb = r % 32, kb = r / 32;
        d.W = A.in[28]; d.ldw = DM; d.k0 = 64 * kb; d.nsrc = 32 * nb; d.WT = (bf16*)(ws + WS_WDN); d.ldt = DFF; d.ndst = 32 * nb; return d; }
}
__device__ __forceinline__ void p0_item_load(const ConvItem& d, f32x4* v, int lane) {
    const int kr = lane >> 3, cc = lane & 7; const bool ok = 4 * cc < d.nvalid;
    const float* wp = d.W + (size_t)(d.k0 + kr) * d.ldw + d.nsrc + (ok ? 4 * cc : 0);
#pragma unroll
    for (int i = 0; i < 8; ++i) v[i] = __builtin_nontemporal_load((const f32x4*)(wp + (size_t)(8 * i) * d.ldw));
}
__device__ __forceinline__ void p0_item_finish(const ConvItem& d, const f32x4* v, LAS float* scr, int lane) {
    { const int kr = lane >> 3, cc = lane & 7; const bool ok = 4 * cc < d.nvalid;
#pragma unroll
      for (int i = 0; i < 8; ++i) { const int kk = 8 * i + kr; f32x4 x = ok ? v[i] : (f32x4){0.f, 0.f, 0.f, 0.f}; if (d.gk) x = x * d.gk[d.k0 + kk];
          LAS float* q = scr + kk * 33 + 4 * cc; q[0] = x[0]; q[1] = x[1]; q[2] = x[2]; q[3] = x[3]; } }
    LDS_WAIT(); asm volatile("" ::: "memory");
    const int c = lane & 7;
#pragma unroll
    for (int j = 0; j < 4; ++j) { const int n = (lane >> 3) + 8 * j; const LAS float* s = scr + (8 * c) * 33 + n;
        v4u o; o.x = pk2(s[0 * 33], s[1 * 33]); o.y = pk2(s[2 * 33], s[3 * 33]); o.z = pk2(s[4 * 33], s[5 * 33]); o.w = pk2(s[6 * 33], s[7 * 33]);
        if (d.fragmajor) { const int nn = d.ndst + n, k8 = (d.k0 >> 3) + c;
            *(GAS v4u*)(d.WT + ((((size_t)(nn >> 5) * (d.ldt >> 4) + (k8 >> 1)) * 64 + (k8 & 1) * 32 + (nn & 31)) << 3)) = o; }
        else *(GAS v4u*)(d.WT + (size_t)(d.ndst + n) * d.ldt + d.k0 + 8 * c) = o; }
    LDS_WAIT(); asm volatile("" ::: "memory");
}
template <bool LATE>
__device__ __forceinline__ void p0_prologue(Frame& F, const Args& A, int hrank = 0, int nhelp = 0) {
    LAS float* scr = (LAS float*)(F.lds + F.wave * 16384);
    const int gw = LATE ? hrank * NWAVES + F.wave : F.vcu * NWAVES + F.wave, NGW = LATE ? nhelp * NWAVES : F.G * NWAVES;
    unsigned char* ws = F.ws;
    const int NITEMS = LATE ? I_LATE : I_EARLY, ibase = LATE ? I_EARLY : 0;
    if (gw < NITEMS) {
        f32x4 v[8]; ConvItem cur = p0_item(A, ws, ibase + gw); p0_item_load(cur, v, F.lane);
        for (int it = gw; it < NITEMS; it += NGW) {
            const int nx = it + NGW; f32x4 vn[8]; ConvItem nxt = cur;
            if (nx < NITEMS) nxt = p0_item(A, ws, ibase + nx);
            p0_item_load(nxt, vn, F.lane);
            p0_item_finish(cur, v, scr, F.lane);
            cur = nxt;
#pragma unroll
            for (int i = 0; i < 8; ++i) v[i] = vn[i];
        }
    }
    if (LATE) return;
    const float* x = A.in[0]; bf16* XB = (bf16*)(ws + WS_XB); float* rstd = (float*)(ws + WS_RSTD1);
    for (int rep_ = 0; rep_ < (REP_PHASE == 31 ? 2 : 1); ++rep_)
    for (int m0 = gw; m0 < M_ROWS; m0 += 4 * NGW) {
        f32x4 v[4][4];
#pragma unroll
        for (int r = 0; r < 4; ++r) { const int m = m0 + r * NGW < M_ROWS ? m0 + r * NGW : m0; const GAS f32x4* xr = (const GAS f32x4*)(x + (size_t)m * DM) + 2 * F.lane;
#pragma unroll
            for (int j = 0; j < 4; ++j) v[r][j] = __builtin_nontemporal_load(xr + 128 * (j >> 1) + (j & 1)); }
#pragma unroll
        for (int r = 0; r < 4; ++r) { const int m = m0 + r * NGW; if (m < M_ROWS) {
            float s = 0.f;
#pragma unroll
            for (int j = 0; j < 4; ++j) s += (v[r][j].x * v[r][j].x + v[r][j].y * v[r][j].y) + (v[r][j].z * v[r][j].z + v[r][j].w * v[r][j].w);
            s = wave_sum(s);
            if (F.lane == 0) rstd[m] = 1.0f / sqrtf(s * (1.f / DM) + EPS);
            GAS v4u* o16 = (GAS v4u*)(XB + (size_t)m * DM) + F.lane;
#pragma unroll
            for (int hf = 0; hf < 2; ++hf) { v4u o; o.x = pk2(v[r][2 * hf].x, v[r][2 * hf].y); o.y = pk2(v[r][2 * hf].z, v[r][2 * hf].w); o.z = pk2(v[r][2 * hf + 1].x, v[r][2 * hf + 1].y); o.w = pk2(v[r][2 * hf + 1].z, v[r][2 * hf + 1].w);
                o16[64 * hf] = o; } } }
    }
}
typedef float f32x16 __attribute__((ext_vector_type(16)));
typedef short s16x4 __attribute__((ext_vector_type(4)));
__device__ __forceinline__ int crow(int r, int hi) { return (r & 3) + 8 * (r >> 2) + 4 * hi; }
__device__ __forceinline__ unsigned cvtpk(float lo, float hi) { unsigned r; asm volatile("v_cvt_pk_bf16_f32 %0, %1, %2" : "=v"(r) : "v"(lo), "v"(hi)); return r; }
__device__ __forceinline__ bf16x8 pack_bf8(const float* v) { v4u w; w.x = cvtpk(v[0], v[1]); w.y = cvtpk(v[2], v[3]); w.z = cvtpk(v[4], v[5]); w.w = cvtpk(v[6], v[7]); return __builtin_bit_cast(bf16x8, w); }
__device__ __forceinline__ void unpack_bf8(v4u w, float* v) { v[0] = bflo(w.x); v[1] = bfhi(w.x); v[2] = bflo(w.y); v[3] = bfhi(w.y); v[4] = bflo(w.z); v[5] = bfhi(w.z); v[6] = bflo(w.w); v[7] = bfhi(w.w); }

__device__ __forceinline__ void p2_knorm(Frame& F, const Args& A) {
    const int idx = F.vcu * 512 + F.tid;
    for (int it = idx; it < M_ROWS * 8; it += F.G * 512) {
        const int m = it >> 3, s = (it >> 2) & 1, g = it & 3, set = s ? 4 : 2;
        bf16* p = (bf16*)(F.ws + WS_KVB) + (size_t)m * KVW + set * 256 + g * 64; const float* gw = A.in[4] + (s ? 2 : 1) * 64;
        v4u w[8]; float ss = 0.f;
#pragma unroll
        for (int c = 0; c < 8; ++c) { w[c] = *(const v4u*)(p + 8 * c); float v[8]; unpack_bf8(w[c], v);
#pragma unroll
            for (int e = 0; e < 8; ++e) ss += v[e] * v[e]; }
        const float r = 1.0f / sqrtf(ss * (1.f / 64) + EPS);
#pragma unroll
        for (int c = 0; c < 8; ++c) { float v[8]; unpack_bf8(w[c], v); const f32x4 g0 = *(const f32x4*)(gw + 8 * c), g1 = *(const f32x4*)(gw + 8 * c + 4);
            v[0] *= r * g0[0]; v[1] *= r * g0[1]; v[2] *= r * g0[2]; v[3] *= r * g0[3]; v[4] *= r * g1[0]; v[5] *= r * g1[1]; v[6] *= r * g1[2]; v[7] *= r * g1[3];
            *(bf16x8*)(p + 8 * c) = pack_bf8(v); }
    }
}

constexpr int HID_LD = 264, CMP_A_OFF = 0, CMP_POS_OFF = 528 * 128, CMP_HID_OFF = 113664;
__device__ __forceinline__ void p2_compress(Frame& F, const Args& A, int unit) {
    const int set = unit >> 7, bg = (unit >> 3) & 15, oct = unit & 7, b = bg >> 2, g = bg & 3;
    const int lane = F.lane, w = F.wave, r32 = lane & 31, hi = lane >> 5, n0 = oct * 32;
    LAS unsigned char* lds = F.lds;
    { const bf16* kvb = (const bf16*)(F.ws + WS_KVB) + (size_t)(b * SEQ + 16 * n0) * KVW + set * 256 + g * 64;
      for (int q = w; q < 66; q += NWAVES) { const int R = 8 * q + (lane >> 3), c = (lane & 7) ^ ((R >> 4) & 7);
          __builtin_amdgcn_global_load_lds((const unsigned*)(kvb + (size_t)R * KVW + c * 8), (LAS unsigned*)(lds + CMP_A_OFF + q * 1024), 16, 0, 0); } }
    { const float* pos = set ? A.in[10] : A.in[5]; const f32x4 p = *(const f32x4*)(pos + 4 * F.tid); v2u pk; pk.x = cvtpk(p[0], p[1]); pk.y = cvtpk(p[2], p[3]);
      *(LAS v2u*)(lds + CMP_POS_OFF + 8 * F.tid) = pk; }
    const bf16* w1f = (const bf16*)(F.ws + WS_CW1) + ((size_t)(set * 8 + w) * 128 * 64 + lane) * 8;
    bf16x8 bq[8];
#pragma unroll
    for (int i = 0; i < 8; ++i) bq[i] = *(const bf16x8*)(w1f + (size_t)i * 512);
    asm volatile("s_waitcnt vmcnt(8)" ::: "memory");
    __syncthreads();
    f32x16 acc, acc2;
#pragma unroll
    for (int i = 0; i < 16; ++i) { acc[i] = 0.f; acc2[i] = 0.f; }
    const LAS unsigned char* arow = lds + CMP_A_OFF + r32 * 2048;
    const LAS unsigned char* prow = lds + CMP_POS_OFF + 16 * hi;
#pragma unroll 1
    for (int k8 = 0; k8 < 16; ++k8) {
        bf16x8 bn[8];
        const int kn = k8 < 15 ? k8 + 1 : 15;
#pragma unroll
        for (int i = 0; i < 8; ++i) bn[i] = *(const bf16x8*)(w1f + (size_t)(kn * 8 + i) * 512);
#pragma unroll
        for (int i = 0; i < 8; ++i) {
            const int lt = 2 * k8 + (i >> 2), kq = i & 3;
            const int key = (r32 + (k8 >> 3)) & 7;
            const bf16x8 af = *(const LAS bf16x8*)(arow + lt * 128 + (((2 * kq + hi) ^ key) << 4));
            const bf16x8 pf = *(const LAS bf16x8*)(prow + lt * 128 + kq * 32);
            acc = __builtin_amdgcn_mfma_f32_32x32x16_bf16(af, bq[i], acc, 0, 0, 0);
            acc2 = __builtin_amdgcn_mfma_f32_32x32x16_bf16(pf, bq[i], acc2, 0, 0, 0);
        }
#pragma unroll
        for (int i = 0; i < 8; ++i) bq[i] = bn[i];
    }
    LAS bf16* hid = (LAS bf16*)(lds + CMP_HID_OFF);
    { const float b1 = (set ? A.in[12] : A.in[7])[w * 32 + r32];
#pragma unroll
      for (int r = 0; r < 16; ++r) hid[crow(r, hi) * HID_LD + w * 32 + r32] = (bf16)f2bf(gelu_tanh(acc[r] + acc2[r] + b1)); }
    __syncthreads();
    if (w == 0) {
        const bf16* w2t = (const bf16*)(F.ws + WS_CW2) + (size_t)set * 64 * 256;
        f32x16 o[2];
#pragma unroll
        for (int mt = 0; mt < 2; ++mt)
#pragma unroll
            for (int i = 0; i < 16; ++i) o[mt][i] = 0.f;
#pragma unroll
        for (int k4 = 0; k4 < 4; ++k4) {
            bf16x8 wa[4][2];
#pragma unroll
            for (int i = 0; i < 4; ++i)
#pragma unroll
                for (int mt = 0; mt < 2; ++mt) wa[i][mt] = *(const bf16x8*)(w2t + (size_t)(32 * mt + r32) * 256 + 16 * (4 * k4 + i) + 8 * hi);
#pragma unroll
            for (int i = 0; i < 4; ++i) {
                const bf16x8 hb = *(const LAS bf16x8*)(hid + r32 * HID_LD + 16 * (4 * k4 + i) + 8 * hi);
#pragma unroll
                for (int mt = 0; mt < 2; ++mt) o[mt] = __builtin_amdgcn_mfma_f32_32x32x16_bf16(wa[i][mt], hb, o[mt], 0, 0, 0);
            }
        }
        const float* b2 = set ? A.in[14] : A.in[9]; float ss = 0.f;
#pragma unroll
        for (int mt = 0; mt < 2; ++mt)
#pragma unroll
            for (int r = 0; r < 16; ++r) { o[mt][r] += b2[32 * mt + crow(r, hi)]; ss += o[mt][r] * o[mt][r]; }
        ss += __shfl_xor(ss, 32);
        const float rs = 1.0f / sqrtf(ss * (1.f / 64) + EPS);
        const int n = n0 + r32;
        bf16* dst = (bf16*)(F.ws + (set ? WS_VC : WS_KC)) + ((size_t)bg * NCP + n) * 64;
#pragma unroll
        for (int mt = 0; mt < 2; ++mt)
#pragma unroll
            for (int a = 0; a < 4; ++a) { float v[4];
#pragma unroll
                for (int e = 0; e < 4; ++e) { const int d = 32 * mt + 8 * a + 4 * hi + e; float x = o[mt][4 * a + e]; if (set == 0) x *= rs * A.in[4][d]; if (n >= NCMP) x = 0.f; v[e] = x; }
                v2u pk; pk.x = cvtpk(v[0], v[1]); pk.y = cvtpk(v[2], v[3]);
                *(v2u*)(dst + 32 * mt + 8 * a + 4 * hi) = pk; }
    }
}

typedef _Float16 h8v __attribute__((ext_vector_type(8)));
typedef _Float16 h2v __attribute__((ext_vector_type(2)));
__device__ __forceinline__ unsigned pkh(float a, float b) { return __builtin_bit_cast(unsigned, __builtin_amdgcn_cvt_pkrtz(a, b)); }
constexpr int LRU_SEG = 128, LRU_NSEG = SEQ / LRU_SEG, LRU_BW_OFF = 0, LRU_CW_OFF = 16384, LRU_X_OFF = 20480;
__device__ __forceinline__ void lru_wg(Frame& F, const Args& A, int item) {
    const int n = item & 15, b = (item >> 4) & 3, seg = (item >> 6) * 8 + F.wave;
    int lane = F.lane, tid = F.tid; asm volatile("" : "+v"(lane), "+v"(tid));
    const int r32 = lane & 31, hi = lane >> 5;
    LAS v4u* BWL = (LAS v4u*)(F.lds + LRU_BW_OFF); LAS _Float16* cwH = (LAS _Float16*)(F.lds + LRU_CW_OFF);
    { const bf16* lw = (const bf16*)(F.ws + WS_LW);
      for (int e = tid; e < 1024; e += NWAVES * 64) { const int fr = e >> 6, ln = e & 63, gt = fr >> 3, nt = (fr >> 2) & 1, ks = fr & 3;
          const v4u w = *(const v4u*)(lw + ((size_t)(gt * 16 + n) * 64 + 32 * nt + (ln & 31)) * 64 + 16 * ks + 8 * (ln >> 5));
          float wv[8]; unpack_bf8(w, wv);
#pragma unroll
          for (int i = 0; i < 8; ++i) wv[i] *= -LOG2E;
          v4u o; o.x = pkh(wv[0], wv[1]); o.y = pkh(wv[2], wv[3]); o.z = pkh(wv[4], wv[5]); o.w = pkh(wv[6], wv[7]);
          BWL[e] = o; }
      if (tid < 320) { const int tap = tid >> 6, ln = tid & 63; cwH[tid] = (_Float16)(tap < 4 ? A.in[15][tap * 1024 + n * 64 + ln] : A.in[16][n * 64 + ln]); } }
    __syncthreads();
    bf16x8 ID0, ID1;
    { const bool mine = (hi == ((r32 >> 3) & 1));
#pragma unroll
      for (int j = 0; j < 8; ++j) { const short one = (mine && j == (r32 & 7)) ? (short)0x3C00 : (short)0; ID0[j] = (r32 < 16) ? one : (short)0; ID1[j] = (r32 >= 16) ? one : (short)0; } }
    float L2A[2], bar_[2], bi_[2], carry[2], Aseg[2];
#pragma unroll
    for (int nt = 0; nt < 2; ++nt) { const int cj = n * 64 + 32 * nt + r32; const float lam = A.in[21][cj];
        L2A[nt] = -8.0f * log1pf(expf(-lam)) * LOG2E; bar_[nt] = -LOG2E * A.in[18][cj]; bi_[nt] = -LOG2E * A.in[20][cj]; carry[nt] = 0.f; Aseg[nt] = 1.f; }
    const bf16* LXb = (const bf16*)(F.ws + WS_LX) + (size_t)b * SEQ * DM + n * 64; _Float16* HL = (_Float16*)(F.ws + WS_HL); _Float16* PC = (_Float16*)(F.ws + (b < 3 ? WS_PC0 : WS_PC3)) - (size_t)(b < 3 ? 0 : 3) * (SEQ / 32) * 16 * 2 * 1024;
    LAS unsigned char* xbuf = F.lds + LRU_X_OFF + F.wave * 10240;
#define LRU_DMA(tile_) do { const bf16* p_ = LXb + ((long)(seg * LRU_SEG + (tile_) * 32 + (lane >> 3)) - 3) * DM + (((lane & 7) ^ ((lane >> 3) & 7)) << 3); \
        _Pragma("unroll") for (int q = 0; q < 5; ++q) __builtin_amdgcn_global_load_lds((const unsigned*)(p_ + (size_t)q * 8 * DM), (LAS unsigned*)(xbuf + ((tile_) & 1) * 5120 + q * 1024), 16, 0, 0); } while (0)
    LRU_DMA(0);
#pragma unroll 1
    for (int tile = 0; tile < LRU_SEG / 32; ++tile) {
        const int t0 = seg * LRU_SEG + tile * 32, t = t0 + r32;
        asm volatile("s_waitcnt vmcnt(0)" ::: "memory");
        if (tile + 1 < LRU_SEG / 32) LRU_DMA(tile + 1);
        const LAS unsigned char* xb = xbuf + (tile & 1) * 5120;


        h8v AX[4];
        v4u xw[4][4]; v4u wv[4][5];
#pragma unroll
        for (int ks = 0; ks < 4; ++ks) {
#pragma unroll
            for (int tap = 0; tap < 4; ++tap) { const int Rl = r32 + tap; xw[ks][tap] = *(const LAS v4u*)(xb + Rl * 128 + (((2 * ks + hi) ^ (Rl & 7)) << 4)); }
#pragma unroll
            for (int tap = 0; tap < 5; ++tap) wv[ks][tap] = *(const LAS v4u*)(cwH + tap * 64 + 16 * ks + 8 * hi);
        }
        __builtin_amdgcn_sched_barrier(0);
#pragma unroll
        for (int ks = 0; ks < 4; ++ks) {
            h8v acc = __builtin_bit_cast(h8v, wv[ks][4]);
#pragma unroll
            for (int tap = 0; tap < 4; ++tap) {
                v4u x4 = xw[ks][tap];
                if (t - 3 + tap < 0) x4 = (v4u){0u, 0u, 0u, 0u};
                acc = __builtin_bit_cast(h8v, wv[ks][tap]) * __builtin_bit_cast(h8v, x4) + acc;
            }
            AX[ks] = acc;
        }
#pragma unroll
        for (int nt = 0; nt < 2; ++nt) {
            f32x16 ar, ai, xq;
#pragma unroll
            for (int i = 0; i < 16; ++i) { ar[i] = 0.f; ai[i] = 0.f; xq[i] = 0.f; }
            h8v bwr[4], bwi[4];
#pragma unroll
            for (int ks = 0; ks < 4; ++ks) { bwr[ks] = __builtin_bit_cast(h8v, BWL[((0 * 2 + nt) * 4 + ks) * 64 + lane]); bwi[ks] = __builtin_bit_cast(h8v, BWL[((1 * 2 + nt) * 4 + ks) * 64 + lane]); }
            __builtin_amdgcn_sched_barrier(0);
#pragma unroll
            for (int ks = 0; ks < 4; ++ks) { ar = __builtin_amdgcn_mfma_f32_32x32x16_f16(AX[ks], bwr[ks], ar, 0, 0, 0); ai = __builtin_amdgcn_mfma_f32_32x32x16_f16(AX[ks], bwi[ks], ai, 0, 0, 0); }
            xq = __builtin_amdgcn_mfma_f32_32x32x16_f16(AX[2 * nt], __builtin_bit_cast(h8v, ID0), xq, 0, 0, 0);
            xq = __builtin_amdgcn_mfma_f32_32x32x16_f16(AX[2 * nt + 1], __builtin_bit_cast(h8v, ID1), xq, 0, 0, 0);
            float av[16], bv[16];
#pragma unroll
            for (int r = 0; r < 16; ++r) {
                const float ea = 1.f + __builtin_amdgcn_exp2f(ar[r] + bar_[nt]), eb = 1.f + __builtin_amdgcn_exp2f(ai[r] + bi_[nt]);
                const float rc = __builtin_amdgcn_rcpf(ea * eb), rr = rc * eb, ii = rc * ea;
                const float a = __builtin_amdgcn_exp2f(rr * L2A[nt]);
                av[r] = a; bv[r] = __builtin_amdgcn_sqrtf(fmaxf(1.f - a * a, 0.f)) * (ii * xq[r]);
            }
            float Ag[4], Bg[4];
#pragma unroll
            for (int a = 0; a < 4; ++a) { Ag[a] = (av[4 * a] * av[4 * a + 1]) * (av[4 * a + 2] * av[4 * a + 3]);
                Bg[a] = ((bv[4 * a] * av[4 * a + 1] + bv[4 * a + 1]) * av[4 * a + 2] + bv[4 * a + 2]) * av[4 * a + 3] + bv[4 * a + 3]; }
            float st = carry[nt], pr = Aseg[nt], hst[4], pst[4];
#pragma unroll
            for (int a = 0; a < 4; ++a) {
                const float Ap = __shfl_xor(Ag[a], 32), Bp = __shfl_xor(Bg[a], 32);
                const float Alo = hi ? Ap : Ag[a], Blo = hi ? Bp : Bg[a], Ahi = hi ? Ag[a] : Ap, Bhi = hi ? Bg[a] : Bp;
                const float s_lo = st; st = Alo * st + Blo; const float s_hi = st; st = Ahi * st + Bhi;
                const float p_lo = pr; pr *= Alo; const float p_hi = pr; pr *= Ahi;
                hst[a] = hi ? s_hi : s_lo; pst[a] = hi ? p_hi : p_lo;
            }
            carry[nt] = st; Aseg[nt] = pr;
            {
                float hv[16], pv[16];
#pragma unroll
                for (int a = 0; a < 4; ++a) { float h = hst[a], p = pst[a];
#pragma unroll
                    for (int e = 0; e < 4; ++e) { const int r = 4 * a + e; h = av[r] * h + bv[r]; p *= av[r]; hv[r] = h; pv[r] = p; } }
                const size_t toff = ((size_t)((b * (SEQ / 32) + seg * (LRU_SEG / 32) + tile) * 16 + n) * 2 + nt) * 1024 + lane * 16;
                v4u w0, w1;
                w0.x = pkh(hv[0], hv[1]); w0.y = pkh(hv[2], hv[3]); w0.z = pkh(hv[4], hv[5]); w0.w = pkh(hv[6], hv[7]); w1.x = pkh(hv[8], hv[9]); w1.y = pkh(hv[10], hv[11]); w1.z = pkh(hv[12], hv[13]); w1.w = pkh(hv[14], hv[15]);
                *(v4u*)(HL + toff) = w0; *(v4u*)(HL + toff + 8) = w1;
                w0.x = pkh(pv[0], pv[1]); w0.y = pkh(pv[2], pv[3]); w0.z = pkh(pv[4], pv[5]); w0.w = pkh(pv[6], pv[7]); w1.x = pkh(pv[8], pv[9]); w1.y = pkh(pv[10], pv[11]); w1.z = pkh(pv[12], pv[13]); w1.w = pkh(pv[14], pv[15]);
                *(v4u*)(PC + toff) = w0; *(v4u*)(PC + toff + 8) = w1;
            }
        }
    }
#undef LRU_DMA
    if (hi == 0) {
        float* ls = (float*)(F.ws + WS_LSUM);
#pragma unroll
        for (int nt = 0; nt < 2; ++nt) *(float2*)(ls + ((size_t)(b * LRU_NSEG + seg) * 1024 + n * 64 + 32 * nt + r32) * 2) = make_float2(Aseg[nt], carry[nt]);
    }
}

__device__ __forceinline__ void lru_pass2(Frame& F, const Args& A, int item) {
    const int half = item & 1, seg = (item >> 1) & 31, b = item >> 6, lane = F.lane, r32 = lane & 31, hi = lane >> 5;
    LAS float* hin = (LAS float*)F.lds;
    { const float* ls = (const float*)(F.ws + WS_LSUM) + ((size_t)b * LRU_NSEG * 1024 + half * 512 + F.tid) * 2; float h = 0.f;
      for (int s0 = 0; s0 < seg; s0 += 8) {
          float2 ab[8];
#pragma unroll
          for (int i = 0; i < 8; ++i) { const int s = (s0 + i < seg) ? s0 + i : seg - 1; ab[i] = *(const float2*)(ls + (size_t)s * 2048); }
#pragma unroll
          for (int i = 0; i < 8; ++i) if (s0 + i < seg) h = ab[i].x * h + ab[i].y;
      }
      hin[F.tid] = h; }
    __syncthreads();
    const int n = half * 8 + F.wave;
    const float h0 = hin[F.wave * 64 + r32], h1 = hin[F.wave * 64 + 32 + r32];
    LAS unsigned char* tb = F.lds + 4096 + F.wave * 4608;
    const _Float16* HL = (const _Float16*)(F.ws + WS_HL); const _Float16* PC = (const _Float16*)(F.ws + (b < 3 ? WS_PC0 : WS_PC3)) - (size_t)(b < 3 ? 0 : 3) * (SEQ / 32) * 16 * 2 * 1024;
    bf16* LR = (bf16*)(F.ws + WS_LGG);
    typedef _Float16 hh8 __attribute__((ext_vector_type(8)));
#pragma unroll 1
    for (int tile = 0; tile < LRU_SEG / 32; ++tile) {
        const int t0 = seg * LRU_SEG + tile * 32;
        const size_t toff = ((size_t)((b * (SEQ / 32) + seg * (LRU_SEG / 32) + tile) * 16 + n) * 2) * 1024 + lane * 16;
        hh8 hq[2][2], pq[2][2];
#pragma unroll
        for (int nt = 0; nt < 2; ++nt) { hq[nt][0] = *(const hh8*)(HL + toff + nt * 1024); hq[nt][1] = *(const hh8*)(HL + toff + nt * 1024 + 8); pq[nt][0] = *(const hh8*)(PC + toff + nt * 1024); pq[nt][1] = *(const hh8*)(PC + toff + nt * 1024 + 8); }
        v4u gw[4];
#pragma unroll
        for (int i = 0; i < 4; ++i) { const int q = lane + 64 * i; gw[i] = *(const v4u*)(LR + (size_t)(b * SEQ + t0 + (q >> 3)) * DM + n * 64 + 8 * (q & 7)); }
#pragma unroll
        for (int nt = 0; nt < 2; ++nt) { const float hc = nt ? h1 : h0;
#pragma unroll
            for (int r = 0; r < 16; ++r) { const float s = (float)hq[nt][r >> 3][r & 7] + (float)pq[nt][r >> 3][r & 7] * hc;
                *(LAS _Float16*)(tb + crow(r, hi) * 144 + (32 * nt + r32) * 2) = (_Float16)s; } }
        asm volatile("s_waitcnt lgkmcnt(0)" ::: "memory");
#pragma unroll
        for (int i = 0; i < 4; ++i) { const int q = lane + 64 * i;
            const hh8 sv = *(const LAS hh8*)(tb + (q >> 3) * 144 + 16 * (q & 7)); float g[8], o[8]; unpack_bf8(gw[i], g);
#pragma unroll
            for (int k = 0; k < 8; ++k) o[k] = (float)sv[k] * g[k];
            *(bf16x8*)(LR + (size_t)(b * SEQ + t0 + (q >> 3)) * DM + n * 64 + 8 * (q & 7)) = pack_bf8(o); }
        asm volatile("s_waitcnt lgkmcnt(0)" ::: "memory");
    }
    __syncthreads();
}

__device__ __forceinline__ void phase2(Frame& F, const Args& A) {
    p2_knorm(F, A);
    for (int rep = 0; rep < (REP_PHASE == 20 ? 2 : 1); ++rep)
    for (int u = F.vcu; u < 256; u += F.G) { p2_compress(F, A, u); __syncthreads(); }
    for (int rep = 0; rep < (REP_PHASE == 21 ? 2 : 1); ++rep)
    for (int it = F.vcu; it < 256; it += F.G) { lru_wg(F, A, it); __syncthreads(); }
}
namespace att {
constexpr int NSLOT = 4, SLOTB = 16384  , IMP_OFF = NSLOT * SLOTB, IMP_LD = 72, MSK_OFF = IMP_OFF + 4 * 64 * IMP_LD * 2, UNI_OFF = MSK_OFF + 512, SC_OFF = UNI_OFF + 16;
static_assert(SC_OFF + 4 * 64 * 4 * 4 <= RING_BYTES, "attention LDS map");
constexpr float NEGBIG = -1e30f, MREF0 = -8192.f, C2 = 0.125f * LOG2E, THR = 8.f;
constexpr int DIST = 2;

__device__ __forceinline__ void glds16(const void* gsrc, unsigned lds_dst) { unsigned keep;
    asm volatile("s_mov_b32 %0, m0\n\ts_mov_b32 m0, %2\n\ts_nop 0\n\tglobal_load_lds_dwordx4 %1, off\n\ts_mov_b32 m0, %0" : "=&s"(keep) : "v"(gsrc), "s"(lds_dst) : "memory"); }
#define ATT_WAIT_BAR(N) asm volatile("s_waitcnt vmcnt(" #N ") lgkmcnt(0)\n\ts_barrier" ::: "memory")
#define ATT_WAIT_BAR_NOVM() asm volatile("s_waitcnt lgkmcnt(0)\n\ts_barrier" ::: "memory")
__device__ __forceinline__ float fadd_s(float a, float b) { float r; asm("v_add_f32_e32 %0, %1, %2" : "=v"(r) : "v"(a), "v"(b)); return r; }
__device__ __forceinline__ float max3f(float a, float b, float c) { float r; asm("v_max3_f32 %0, %1, %2, %3" : "=v"(r) : "v"(a), "v"(b), "v"(c)); return r; }

#define ATT_SB() __builtin_amdgcn_sched_barrier(0)
__device__ __forceinline__ void qk_tile(const LAS unsigned char* kslot, const bf16x8* qf, float slk  , float base0, f32x16& p0, f32x16& p1, int r32, int hi) {
    const LAS unsigned char* kp = kslot + r32 * 128; const int kx = (r32 >> 1) & 7;
    bf16x8 kf[8];
#pragma unroll
    for (int d0 = 0; d0 < 4; ++d0) { const int so = ((2 * d0 + hi) ^ kx) << 4; kf[2 * d0] = *(const LAS bf16x8*)(kp + so); kf[2 * d0 + 1] = *(const LAS bf16x8*)(kp + 4096 + so); }
    ATT_SB();
    const float bl = base0 + slk * (float)(4 * hi), bh = bl + slk * 32.f;
#pragma unroll
    for (int r = 0; r < 16; ++r) { const float c = (float)((r & 3) + 8 * (r >> 2)); p0[r] = __builtin_fmaf(slk, c, bl); p1[r] = __builtin_fmaf(slk, c, bh); }
    ATT_SB();
    __builtin_amdgcn_s_setprio(1);
#pragma unroll
    for (int d0 = 0; d0 < 4; ++d0) {
        p0 = __builtin_amdgcn_mfma_f32_32x32x16_bf16(kf[2 * d0], qf[d0], p0, 0, 0, 0);
        p1 = __builtin_amdgcn_mfma_f32_32x32x16_bf16(kf[2 * d0 + 1], qf[d0], p1, 0, 0, 0);
    }
    __builtin_amdgcn_s_setprio(0);
    ATT_SB();
}
template <bool LE> __device__ __forceinline__ void mask_tile(f32x16& p0, f32x16& p1, int bound, int hi) {
    const int bb = bound - 4 * hi;
#pragma unroll
    for (int r = 0; r < 16; ++r) { const int c = (r & 3) + 8 * (r >> 2);
        if (LE) { if (c > bb) p0[r] = NEGBIG; if (c + 32 > bb) p1[r] = NEGBIG; }
        else { if (c < bb) p0[r] = NEGBIG; if (c + 32 < bb) p1[r] = NEGBIG; } }
}
__device__ __forceinline__ float row_max(const f32x16& p0, const f32x16& p1) {
    float a = max3f(p0[0], p0[1], p1[0]), b = max3f(p0[2], p0[3], p1[1]); a = max3f(a, p1[2], p1[3]);
#pragma unroll
    for (int r = 4; r < 16; r += 4) { a = max3f(a, p0[r], p0[r + 1]); b = max3f(b, p0[r + 2], p0[r + 3]); a = max3f(a, p1[r], p1[r + 1]); b = max3f(b, p1[r + 2], p1[r + 3]); }
    a = fmaxf(a, b);
    return fmaxf(a, __shfl_xor(a, 32));
}
__device__ __forceinline__ s16x4 vtr(const LAS unsigned char* p) { typedef short v4i16_t __attribute__((ext_vector_type(4))); return __builtin_bit_cast(s16x4, __builtin_amdgcn_ds_read_tr16_b64_v4i16((LAS v4i16_t*)p)); }
__device__ __forceinline__ void v_load(const LAS unsigned char* vslot, int d0, bf16x8* vf, int lane, int hi) {
    const int q4 = (lane & 15) >> 2, p4 = lane & 3, g2 = (lane >> 4) & 1;
    const LAS unsigned char* vp = vslot + (4 * hi + q4) * 128 + ((((4 * d0 + 2 * g2 + (p4 >> 1)) ^ ((q4 >> 1) << 2))) << 4) + 8 * (p4 & 1);
#pragma unroll
    for (int i = 0; i < 4; ++i) {
        const s16x4 lo = vtr(vp + i * 2048), hh = vtr(vp + i * 2048 + 1024);
        vf[i] = (bf16x8){lo[0], lo[1], lo[2], lo[3], hh[0], hh[1], hh[2], hh[3]};
    }
    ATT_SB();
}
__device__ __forceinline__ void pack_p(const f32x16& p0, const f32x16& p1, bf16x8* pa) {
    float t[8];
#pragma unroll
    for (int i = 0; i < 8; ++i) t[i] = p0[i];
    pa[0] = pack_bf8(t);
#pragma unroll
    for (int i = 0; i < 8; ++i) t[i] = p0[8 + i];
    pa[1] = pack_bf8(t);
#pragma unroll
    for (int i = 0; i < 8; ++i) t[i] = p1[i];
    pa[2] = pack_bf8(t);
#pragma unroll
    for (int i = 0; i < 8; ++i) t[i] = p1[8 + i];
    pa[3] = pack_bf8(t);
}
__device__ __forceinline__ void pv_mma_packed(const LAS unsigned char* vslot, const bf16x8* vf0, const bf16x8* pa, f32x16* o, int lane, int hi) {
    bf16x8 vf1[4]; v_load(vslot, 1, vf1, lane, hi);
    __builtin_amdgcn_s_setprio(1);
#pragma unroll
    for (int ks = 0; ks < 4; ++ks) o[0] = __builtin_amdgcn_mfma_f32_32x32x16_bf16(vf0[ks], pa[ks], o[0], 0, 0, 0);
#pragma unroll
    for (int ks = 0; ks < 4; ++ks) o[1] = __builtin_amdgcn_mfma_f32_32x32x16_bf16(vf1[ks], pa[ks], o[1], 0, 0, 0);
    __builtin_amdgcn_s_setprio(0);
    ATT_SB();
}
__device__ __forceinline__ void pv_mma(const LAS unsigned char* vslot, const bf16x8* vf0, const f32x16& p0, const f32x16& p1, f32x16* o, int lane, int hi) {
    bf16x8 pa[4]; pack_p(p0, p1, pa); ATT_SB();
    pv_mma_packed(vslot, vf0, pa, o, lane, hi);
}
__device__ __forceinline__ float softmax_exp(f32x16& p0, f32x16& p1, float& mref, float& l, f32x16* o, bool has_o) {
    const float rm = row_max(p0, p1); float fac = 1.f;
    if (__any(rm > THR)) {
        const float d = fmaxf(rm, 0.f), alpha = __builtin_amdgcn_exp2f(-d); mref += d; l *= alpha; fac = alpha;
#pragma unroll
        for (int r = 0; r < 16; ++r) { p0[r] -= d; p1[r] -= d; }
        if (has_o) {
#pragma unroll
            for (int r = 0; r < 16; ++r) { o[0][r] *= alpha; o[1][r] *= alpha; }
        }
    }
#pragma unroll
    for (int r = 0; r < 16; ++r) { p0[r] = __builtin_amdgcn_exp2f(p0[r]); p1[r] = __builtin_amdgcn_exp2f(p1[r]); }
    return fac;
}
__device__ __forceinline__ void softmax_sum(const f32x16& p0, const f32x16& p1, float& l) {
    float s0 = 0.f, s1 = 0.f;
#pragma unroll
    for (int r = 0; r < 16; ++r) { s0 += p0[r]; s1 += p1[r]; }
    l += s0 + s1;
}
__device__ __forceinline__ float softmax_step(f32x16& p0, f32x16& p1, float& mref, float& l, f32x16* o, bool has_o) { const float f = softmax_exp(p0, p1, mref, l, o, has_o); softmax_sum(p0, p1, l); return f; }

__device__ __forceinline__ void attn_unit(Frame& F, const Args& A, int bg, int qt) {
    int lane = F.lane; asm volatile("" : "+v"(lane));
    const int b = bg >> 2, g = bg & 3, wid = F.wave, r32 = lane & 31, hi = lane >> 5;
    const int hh = wid & 3, qh = wid >> 2, head = g * 4 + hh;
    const int t0 = qt * 64, u = 32 * qh + r32, t = t0 + u; const size_t m = (size_t)b * SEQ + t;
    LAS unsigned char* lds = F.lds;
    const unsigned lds0 = (unsigned)(uintptr_t)lds;
    unsigned char* ws = F.ws;
    if (F.tid == 0) { *(LAS unsigned*)(lds + UNI_OFF) = 0u; *(LAS unsigned*)(lds + UNI_OFF + 4) = 0u; }
    const bf16* KCb = (const bf16*)(ws + WS_KC) + (size_t)bg * NCP * 64; const bf16* VCb = (const bf16*)(ws + WS_VC) + (size_t)bg * NCP * 64;
    const bf16* KVb = (const bf16*)(ws + WS_KVB) + (size_t)b * SEQ * KVW + g * 64;
    const int rowl = 8 * wid + (lane >> 3), kch = (lane & 7) ^ ((rowl >> 1) & 7), vch = (lane & 7) ^ (((rowl >> 1) & 1) << 2);
    const int kofC = rowl * 64 + kch * 8, vofC = rowl * 64 + vch * 8;
    const int kofT = rowl * KVW + kch * 8, vofT = rowl * KVW + vch * 8;
    const int nct = (((t0 + 32) >> 4) >> 6) + 1;
    const int jlast = qt >= 8 ? qt - 8 : 0, nw = qt - jlast + 1;
    const int sW = nct, sS = sW + nw;
    int total = sS;
    int ipos = 0;
    unsigned long long iss_uni = 0ull;
    const unsigned kdst = lds0 + wid * 1024, vdst = lds0 + 8192 + wid * 1024;
#define ATT_ISSUE() do { if (ipos < total) { const unsigned so = (unsigned)(ipos & (NSLOT - 1)) * SLOTB; \
        if (ipos < sW) { const int row = 64 * ipos; glds16(KCb + row * 64 + kofC, (unsigned)__builtin_amdgcn_readfirstlane(kdst + so)); glds16(VCb + row * 64 + vofC, (unsigned)__builtin_amdgcn_readfirstlane(vdst + so)); } \
        else { int j; const bf16* kb_; if (ipos < sS) { j = qt - (ipos - sW); kb_ = KVb + 4 * 256; } else { j = 63 - __builtin_clzll(iss_uni); iss_uni &= ~(1ull << j); kb_ = KVb + 2 * 256; } \
               const bf16* p_ = kb_ + (size_t)j * 64 * KVW; glds16(p_ + kofT, (unsigned)__builtin_amdgcn_readfirstlane(kdst + so)); glds16(p_ + 256 + vofT, (unsigned)__builtin_amdgcn_readfirstlane(vdst + so)); } \
        ++ipos; } } while (0)
#define ATT_STEP_END(cpos) do { const int ahead = ipos - (cpos) - 2; if (ahead >= 2) ATT_WAIT_BAR(4); else if (ahead == 1) ATT_WAIT_BAR(2); else ATT_WAIT_BAR(0); } while (0)
    ATT_ISSUE(); ATT_ISSUE();
    bf16x8 qf[4];
    {
        const bf16* qp = (const bf16*)(ws + WS_QB) + m * DM + head * 64 + 8 * hi; const float* qng = A.in[3] + 8 * hi;
        v4u w[4]; float ss = 0.f;
#pragma unroll
        for (int ks = 0; ks < 4; ++ks) { w[ks] = *(const v4u*)(qp + 16 * ks); float v[8]; unpack_bf8(w[ks], v);
#pragma unroll
            for (int e = 0; e < 8; ++e) ss += v[e] * v[e]; }
        ss += __shfl_xor(ss, 32);
        const float rs = C2 / sqrtf(ss * (1.f / 64) + EPS);
#pragma unroll
        for (int ks = 0; ks < 4; ++ks) { float v[8]; unpack_bf8(w[ks], v);
#pragma unroll
            for (int e = 0; e < 8; ++e) v[e] *= rs * qng[16 * ks + e];
            qf[ks] = pack_bf8(v); }
    }
    const float sl2 = exp2f(-0.5f * (float)(head + 1)) * LOG2E;
    const bf16* NGp = (const bf16*)(ws + WS_NG) + m * 48 + head * 3;
    const float gate_c = bf2f(NGp[0]), gate_s = bf2f(NGp[1]), gate_w = bf2f(NGp[2]);
    f32x16 o[2];
    unsigned oaccp[2][8];
#pragma unroll
    for (int i = 0; i < 8; ++i) { oaccp[0][i] = 0u; oaccp[1][i] = 0u; }
#define ATT_FOLD(sc_) do { _Pragma("unroll") for (int d_ = 0; d_ < 2; ++d_) _Pragma("unroll") for (int i_ = 0; i_ < 8; ++i_) { \
        const float a_ = bflo(oaccp[d_][i_]) + (sc_) * o[d_][2 * i_], b_ = bfhi(oaccp[d_][i_]) + (sc_) * o[d_][2 * i_ + 1]; oaccp[d_][i_] = cvtpk(a_, b_); } } while (0)
    ATT_WAIT_BAR(0);
    int cpos = 0;
#if PROBE_ID
    unsigned* pc = (unsigned*)(ws + WS_CTL) + 8192; unsigned long long ts0 = __builtin_amdgcn_s_memtime();
#define PROBE_MARK(k) do { const unsigned long long ts1 = __builtin_amdgcn_s_memtime(); if (F.tid == 0) atomicAdd(pc + (k), (unsigned)((ts1 - ts0) >> 4)); ts0 = ts1; } while (0)
#else
#define PROBE_MARK(k) do {} while (0)
#endif
#define ATT_K(cpos) (lds + (unsigned)((cpos) & (NSLOT - 1)) * SLOTB)
#define ATT_V(cpos) (lds + (unsigned)((cpos) & (NSLOT - 1)) * SLOTB + 8192)
    {
        const int nmax = (t - 31) >> 4;
        float mref = MREF0, l = 0.f, mk[4] = {0.f, 0.f, 0.f, 0.f};
#pragma unroll
        for (int r = 0; r < 16; ++r) { o[0][r] = 0.f; o[1][r] = 0.f; }
        LAS _Float16* impw = (LAS _Float16*)(lds + IMP_OFF) + (hh * 64 + u) * IMP_LD;
        float ecarry = 0.f;
#pragma unroll
        for (int kt = 0; kt < 4; ++kt) {
            if (kt < nct) {
                ATT_ISSUE();
                f32x16 p0, p1;
                qk_tile(ATT_K(cpos), qf, sl2 * 16.f, sl2 * (float)(1024 * kt + 31 - t0) - mref, p0, p1, r32, hi);
                bf16x8 vf[4]; v_load(ATT_V(cpos), 0, vf, lane, hi);
                mask_tile<true>(p0, p1, nmax - 64 * kt, hi);
                ecarry *= softmax_step(p0, p1, mref, l, o, true);
                mk[kt] = mref;
                float Eo[2][4];
#pragma unroll
                for (int a4 = 0; a4 < 4; ++a4) { Eo[0][a4] = __shfl_xor(p0[4 * a4 + 3], 32); Eo[1][a4] = __shfl_xor(p1[4 * a4 + 3], 32); }
#pragma unroll
                for (int s = 0; s < 2; ++s)
#pragma unroll
                    for (int a4 = 0; a4 < 4; ++a4) {
                        const float G = s == 0 ? (p0[4 * a4] + p0[4 * a4 + 1]) + (p0[4 * a4 + 2] + p0[4 * a4 + 3]) : (p1[4 * a4] + p1[4 * a4 + 1]) + (p1[4 * a4 + 2] + p1[4 * a4 + 3]);
                        const float prev = a4 >= 1 ? Eo[s][a4 - 1] : (s == 1 ? Eo[0][3] : ecarry);
                        impw[16 * kt + 8 * s + 2 * a4 + hi] = (_Float16)(G + (hi ? Eo[s][a4] : prev));
                    }
                ecarry = Eo[1][3];
                pv_mma(ATT_V(cpos), vf, p0, p1, o, lane, hi);
                ATT_STEP_END(cpos); ++cpos;
            }
        }
        l += __shfl_xor(l, 32);
        const float inv = l > 0.f ? 1.0f / l : 0.f;
        if (hi == 0) { f32x4 sc; sc[0] = __builtin_amdgcn_exp2f(mk[0] - mref) * inv; sc[1] = __builtin_amdgcn_exp2f(mk[1] - mref) * inv; sc[2] = __builtin_amdgcn_exp2f(mk[2] - mref) * inv; sc[3] = __builtin_amdgcn_exp2f(mk[3] - mref) * inv;
            *(LAS f32x4*)(lds + SC_OFF + (hh * 64 + u) * 16) = sc; }
        const float gsc = gate_c * inv;
        ATT_FOLD(gsc);
        asm volatile("s_waitcnt lgkmcnt(0)\n\ts_barrier" ::: "memory");
    }
    PROBE_MARK(0);
    {
        const int q = lane >> 3, kg = lane & 7, uq = 8 * wid + q, tq = t0 + uq;
        float v[8];
#pragma unroll
        for (int i = 0; i < 8; ++i) v[i] = 0.f;
#pragma unroll
        for (int h4 = 0; h4 < 4; ++h4) { typedef _Float16 h8 __attribute__((ext_vector_type(8)));
            const h8 x = *(const LAS h8*)(lds + IMP_OFF + ((h4 * 64 + uq) * IMP_LD + 8 * kg) * 2);
            const float sc = *(const LAS float*)(lds + SC_OFF + (h4 * 64 + uq) * 16 + 4 * (kg >> 1));
#pragma unroll
            for (int i = 0; i < 8; ++i) v[i] += (float)x[i] * sc; }
        unsigned key[8];
#pragma unroll
        for (int i = 0; i < 8; ++i) { const int j = 8 * kg + i; const bool valid = (64 * j <= tq), forced = (j == 0) || (j == qt) || (j == qt - 1);
            const float val = v[i] + (forced ? 1e4f : 0.f);
            key[i] = valid ? (((__float_as_uint(val) >> 16) << 6) | (unsigned)(63 - j)) : 0u; }
        unsigned thr = 0u;
#pragma unroll 1
        for (int bit = 20; bit >= 0; --bit) {
            const unsigned cand = thr | (1u << bit); int c = 0;
#pragma unroll
            for (int i = 0; i < 8; ++i) c += (key[i] >= cand) ? 1 : 0;
            c += __builtin_amdgcn_update_dpp(0, c, 0xB1, 0xF, 0xF, true);
            c += __builtin_amdgcn_update_dpp(0, c, 0x4E, 0xF, 0xF, true);
            c += __builtin_amdgcn_update_dpp(0, c, 0x141, 0xF, 0xF, true);
            thr = c >= 16 ? cand : thr;
        }
        unsigned m8 = 0u;
#pragma unroll
        for (int i = 0; i < 8; ++i) m8 |= ((key[i] != 0u && key[i] >= thr) ? 1u : 0u) << i;
        *(LAS unsigned char*)(lds + MSK_OFF + 8 * uq + kg) = (unsigned char)m8;
        __hip_atomic_fetch_or((LAS unsigned*)(lds + UNI_OFF + 4 * (kg >> 2)), m8 << (8 * (kg & 3)), __ATOMIC_RELAXED, __HIP_MEMORY_SCOPE_WORKGROUP);
        asm volatile("s_waitcnt lgkmcnt(0)\n\ts_barrier" ::: "memory");
    }
    const unsigned mlo = *(const LAS unsigned*)(lds + MSK_OFF + 8 * u), mhi = *(const LAS unsigned*)(lds + MSK_OFF + 8 * u + 4);
    const unsigned long long mymask = ((unsigned long long)mhi << 32) | mlo;
    unsigned long long cmp_uni = ((unsigned long long)(unsigned)__builtin_amdgcn_readfirstlane((int)*(const LAS unsigned*)(lds + UNI_OFF + 4)) << 32) | (unsigned)__builtin_amdgcn_readfirstlane((int)*(const LAS unsigned*)(lds + UNI_OFF));
    iss_uni = cmp_uni; total = sS + __builtin_popcountll(cmp_uni);
    PROBE_MARK(1);
#if PROBE_ID
    if (F.tid == 0) { atomicAdd(pc + 4, (unsigned)__builtin_popcountll(cmp_uni)); atomicAdd(pc + 5, (unsigned)(2 * nct + nw)); }
#endif
#define ATT_WS_LOOP(DEFER) { \
        float mref = MREF0, l = 0.f; \
        _Pragma("unroll") for (int r = 0; r < 16; ++r) { o[0][r] = 0.f; o[1][r] = 0.f; } \
        bf16x8 pa[4]; \
        const int nsteps = nw + __builtin_popcountll(cmp_uni); \
        for (int st = 0; st < nsteps; ++st, ++cpos) { \
            int j; bool win; \
            if (st < nw) { j = qt - st; win = true; } else { j = 63 - __builtin_clzll(cmp_uni); cmp_uni &= ~(1ull << j); win = false; } \
            if (DEFER && st > 0) { bf16x8 vf[4]; v_load(ATT_V(cpos - 1), 0, vf, lane, hi); pv_mma_packed(ATT_V(cpos - 1), vf, pa, o, lane, hi); } \
            if (st == nw) { \
                PROBE_MARK(2); \
                l += __shfl_xor(l, 32); \
                const float sc = l > 0.f ? gate_w / l : 0.f; \
                ATT_FOLD(sc); \
                _Pragma("unroll") for (int r = 0; r < 16; ++r) { o[0][r] = 0.f; o[1][r] = 0.f; } \
                mref = MREF0; l = 0.f; \
            } \
            ATT_ISSUE(); \
            f32x16 p0, p1; \
            const float selb = (win || ((mymask >> j) & 1ull)) ? 0.f : NEGBIG; \
            qk_tile(ATT_K(cpos), qf, sl2, sl2 * (float)(64 * j - t0) - mref + selb, p0, p1, r32, hi); \
            if (!DEFER) { \
                bf16x8 vf[4]; v_load(ATT_V(cpos), 0, vf, lane, hi); \
                if (j == qt) mask_tile<true>(p0, p1, u, hi); \
                if (win && j == qt - 8) mask_tile<false>(p0, p1, u + 1, hi); \
                softmax_step(p0, p1, mref, l, o, true); \
                pv_mma(ATT_V(cpos), vf, p0, p1, o, lane, hi); \
            } else { \
                if (j == qt) mask_tile<true>(p0, p1, u, hi); \
                if (win && j == qt - 8) mask_tile<false>(p0, p1, u + 1, hi); \
                softmax_step(p0, p1, mref, l, o, true); \
                pack_p(p0, p1, pa); \
            } \
            ATT_STEP_END(cpos); \
        } \
        if (DEFER) { bf16x8 vf[4]; v_load(ATT_V(cpos - 1), 0, vf, lane, hi); pv_mma_packed(ATT_V(cpos - 1), vf, pa, o, lane, hi); } \
        l += __shfl_xor(l, 32); \
        const float sc = l > 0.f ? gate_s / l : 0.f; \
        ATT_FOLD(sc); \
    }
    if (F.grp != 0) ATT_WS_LOOP(true) else ATT_WS_LOOP(false)
#undef ATT_WS_LOOP
    PROBE_MARK(3);
    bf16* op = (bf16*)(ws + WS_QB) + m * DM + head * 64 + 4 * hi;
#pragma unroll
    for (int d0 = 0; d0 < 2; ++d0)
#pragma unroll
        for (int a = 0; a < 4; ++a) { v2u pk; pk.x = oaccp[d0][2 * a]; pk.y = oaccp[d0][2 * a + 1]; *(v2u*)(op + 32 * d0 + 8 * a) = pk; }
#undef ATT_FOLD
#undef ATT_ISSUE
#undef ATT_STEP_END
#undef ATT_K
#undef ATT_V
}
#undef ATT_WAIT_BAR
#undef ATT_WAIT_BAR_NOVM
#undef ATT_SB
}

__device__ __forceinline__ void phase3(Frame& F, const Args& A) {
    for (int it = F.vcu; it < 256; it += F.G) lru_pass2(F, A, it);
#if FAST_ATTN
    __syncthreads();
    {
        const bool lab8 = (F.G % 8) == 0; const int nq = lab8 ? 8 : 1, lab = lab8 ? (int)(blockIdx.x & 7) : 0, per = 1024 / nq;
        unsigned* head = (unsigned*)(F.ws + WS_CTL) + CW_QUEUE + 64 * lab;
        volatile LAS unsigned* slotw = (volatile LAS unsigned*)(F.lds + MISC_OFF + 96);
        for (;;) {
            if (F.tid == 0) *slotw = __hip_atomic_fetch_add(head, 1u, __ATOMIC_RELAXED, __HIP_MEMORY_SCOPE_AGENT);
            __syncthreads();
            const int i = (int)*slotw;
            __syncthreads();
            if (i >= per) break;
            const int nbg = 16 / nq, bg = lab * nbg + (i % nbg), qt = 63 - i / nbg;
            att::attn_unit(F, A, bg, qt);
            __syncthreads();
        }
    }
#endif
}
constexpr int N_PHASES = 8;

__global__ void __launch_bounds__(NWAVES * 64, 2) fwd_kernel(Args args) {
    extern __shared__ __attribute__((aligned(16))) unsigned char lds[];
    Frame F;
    F.lds = (LAS unsigned char*)lds;
    F.MISC = (volatile LAS unsigned*)(F.lds + MISC_OFF);
    F.tid = threadIdx.x; F.lane = F.tid & 63; F.wave = __builtin_amdgcn_readfirstlane(F.tid >> 6);
    F.G = gridDim.x; { const int bx = blockIdx.x; F.vcu = (F.G % 8 == 0) ? (bx % 8) * (F.G / 8) + bx / 8 : bx; }
    F.out = args.out; F.ws = args.ws; unsigned char* ws = args.ws;
    F.ctl = (gu32*)(ws + WS_CTL);
    for (int u = F.tid; u < (LDS_BYTES - LDSCTL_OFF) / 4; u += NWAVES * 64) ((LAS unsigned*)(F.lds + LDSCTL_OFF))[u] = 0u;
    __syncthreads();
    { const unsigned simd = ((unsigned)__builtin_amdgcn_s_getreg((1 << 11) | (4 << 6) | 4)) & 3u;
      int slot = 0; if (F.lane == 0) slot = (int)__hip_atomic_fetch_add((LAS unsigned*)(F.lds + MISC_OFF + 64 + 4 * simd), 1u, __ATOMIC_RELAXED, __HIP_MEMORY_SCOPE_WORKGROUP);
      F.grp = __builtin_amdgcn_readfirstlane(slot) & 1; }
    const int lo = args.ph_lo, hi = args.ph_hi;
    const bool multi = (hi - lo) > 1;
    XcdBarrier bar; bar.bar = (unsigned*)(F.ctl + CW_BAR); bar.x = 0; bar.st = nullptr;
    if (multi) bar = xcd_barrier_post((unsigned*)(F.ctl + CW_BAR), F.MISC + 8);
    unsigned* labw = (unsigned*)(F.ctl + CW_LAB) + 64 * (blockIdx.x & 7);
    if (multi && F.tid == 0) (void)__hip_atomic_fetch_or(labw + 16, 1u << xb_xcc_id(), __ATOMIC_RELAXED, __HIP_MEMORY_SCOPE_AGENT);
    bool lab_local = false;
#ifdef ONLY
#define IN(k) ((k) == ONLY && lo <= (k) && (k) < hi)
#else
#define IN(k) (lo <= (k) && (k) < hi)
#endif
#if PROBE_ID >= 10
#define STAMP(k) do { if (blockIdx.x == 0 && F.tid == 0) F.MISC[12 + (k)] = (unsigned)__builtin_amdgcn_s_memrealtime(); } while (0)
#else
#define STAMP(k) do {} while (0)
#endif
#define PIN(n) asm volatile(".p2align 8\n\t.fill " #n ", 4, 0xBF800000" ::: "memory")
#define SEAM_L(k) do { if (IN(k) && IN((k) + 1)) { if (lab_local) label_barrier(labw, 32u, bar.bar); else xcd_barrier(bar); } STAMP((k) + 1); } while (0)
#define SEAM(k) do { if (IN(k) && IN((k) + 1)) xcd_barrier(bar); STAMP((k) + 1); } while (0)
    using namespace pg8;
    PG8_LAS unsigned char* ring = (PG8_LAS unsigned char*)lds;

#ifndef REP_PHASE
#define REP_PHASE -1
#endif
#define NREP(k) ((k) == REP_PHASE ? 2 : 1)
    STAMP(0);
    if (IN(0)) { p0_prologue<false>(F, args); SEAM(0); }

    if (IN(1)) {
        Gemm g{2 * DM, 128, 2 * DM, 128, DM / 64};
        SchedSimple S; S.T.init(M_ROWS, NPROJ, F.G, (int)blockIdx.x); S.A = (const char*)(ws + WS_XB); S.B = (const char*)(ws + WS_WIN); S.tA = (size_t)256 * 2 * DM; S.tB = (size_t)256 * 2 * DM;
        EpiProj E{(const float*)(ws + WS_RSTD1), (bf16_t*)(ws + WS_QB), (bf16_t*)(ws + WS_KVB), (bf16_t*)(ws + WS_NG), (bf16_t*)(ws + WS_LX), (bf16_t*)(ws + WS_LGG), (bf16_t*)F.out};
        gemm_phase<EpiProj, SchedSimple, GEMM_ALIGN_P1>(ring, g, S, E);
        {
            const int nwg = S.T.nwg, G = F.G, rem = nwg % G, c = (int)blockIdx.x;
            if (rem == 0) p0_prologue<true>(F, args, c, G);
            else if (c >= rem) p0_prologue<true>(F, args, c - rem, G - rem);
        }
        SEAM(1);
    }
    if (IN(2)) { PIN(38); phase2(F, args); SEAM(2); }
    if (IN(3)) { PIN(53); phase3(F, args); SEAM(3); }
    if (multi && F.G == 256) {
        bool ok = true;
#pragma unroll
        for (int j = 0; j < 8; ++j) { const unsigned mk = xb_ld((unsigned*)(F.ctl + CW_LAB) + 64 * j + 16); ok = ok && (mk != 0u) && ((mk & (mk - 1u)) == 0u); }
        lab_local = __builtin_amdgcn_readfirstlane((int)ok) != 0;
    }
    if (IN(4)) { PIN(55);
        Gemm g{2 * DM, 128, 2 * DM, 128, DM / 64};
        SchedMerge S; S.T.init(M_ROWS, DM, F.G, (int)blockIdx.x); S.A0 = (const char*)(ws + WS_QB); S.A1 = (const char*)(ws + WS_LGG); S.B0 = (const char*)(ws + WS_WOA); S.B1 = (const char*)(ws + WS_WOL);
        S.tA = (size_t)256 * 2 * DM; S.tB = (size_t)256 * 2 * DM;
        EpiMerge E{(const bf16_t*)F.out, (bf16_t*)(ws + WS_LX)};
        for (int rep = 0; rep < NREP(4); ++rep) gemm_phase<EpiMerge, SchedMerge>(ring, g, S, E);
        SEAM_L(4);
    }
    if (IN(5)) { PIN(54);
        Gemm g{2 * DM, 128, 2 * DM, 128, DM / 64};
        SchedSimple S; S.T.init(M_ROWS, DM, F.G, (int)blockIdx.x); S.A = (const char*)(ws + WS_LX); S.B = (const char*)(ws + WS_WOUT); S.tA = (size_t)256 * 2 * DM; S.tB = (size_t)256 * 2 * DM;
        EpiWout E{args.in[0], F.out, (bf16_t*)(ws + WS_XB), (float*)(ws + WS_SSQ)};
        for (int rep = 0; rep < NREP(5); ++rep) gemm_phase<EpiWout, SchedSimple>(ring, g, S, E);
        SEAM_L(5);
    }
    if (IN(6)) { PIN(33);
        Gemm g{2 * DM, 128, 2 * DM, 128, DM / 64};
        SchedHalfTail S; S.T.init(M_ROWS, NGU, F.G, (int)blockIdx.x); S.A = (const char*)(ws + WS_XB); S.B = (const char*)(ws + WS_WGU); S.tA = (size_t)256 * 2 * DM; S.tB = (size_t)256 * 2 * DM;
        S.full = (F.G % 8 == 0 && 2 * (S.T.nwg % F.G) <= F.G) ? S.T.nwg / F.G : (S.T.nwg + F.G - 1) / F.G;
        EpiGU E{(const float*)(ws + WS_SSQ), (bf16_t*)(ws + WS_FF)};
        for (int rep = 0; rep < NREP(6); ++rep) gemm_phase<EpiGU, SchedHalfTail, GEMM_ALIGN_P6>(ring, g, S, E);
        SEAM_L(6);
    }
    if (IN(7)) { PIN(39);
        Gemm g{2 * DFF, 128, 2 * DFF, 128, DFF / 64};
        SchedSimple S; S.T.init(M_ROWS, DM, F.G, (int)blockIdx.x); S.A = (const char*)(ws + WS_FF); S.B = (const char*)(ws + WS_WDN); S.tA = (size_t)256 * 2 * DFF; S.tB = (size_t)256 * 2 * DFF;
        EpiDown E{F.out, (const bf16_t*)(ws + WS_XB)};
        gemm_phase<EpiDown, SchedSimple>(ring, g, S, E);
#if PROBE_ID
        const unsigned now_ = (unsigned)__builtin_amdgcn_s_memrealtime();
        xcd_barrier(bar);
        if (blockIdx.x == 0 && F.tid == 0) { const unsigned* pc = (const unsigned*)(ws + WS_CTL) + 8192; float v = 0.f;
            const float c0 = (float)__hip_atomic_load(pc + 0, RLX_AGENT), c1 = (float)__hip_atomic_load(pc + 1, RLX_AGENT), c2 = (float)__hip_atomic_load(pc + 2, RLX_AGENT), c3 = (float)__hip_atomic_load(pc + 3, RLX_AGENT);
            const float c4 = (float)__hip_atomic_load(pc + 4, RLX_AGENT), c5 = (float)__hip_atomic_load(pc + 5, RLX_AGENT);
            if (PROBE_ID == 1) v = c4 / 1024.f;
            if (PROBE_ID == 2) v = 100.f * c0 / (c0 + c1 + c2 + c3);
            if (PROBE_ID == 3) v = 100.f * c1 / (c0 + c1 + c2 + c3);
            if (PROBE_ID == 4) v = 100.f * c2 / (c0 + c1 + c2 + c3);
            if (PROBE_ID == 5) v = 100.f * c3 / (c0 + c1 + c2 + c3);
            if (PROBE_ID == 6) v = 16.f * (c0 + c2 + c3) / (c4 + c5) / 100.f;
            if (PROBE_ID == 7) v = 16.f * c1 / 1024.f / 100.f;
            if (PROBE_ID >= 20 && PROBE_ID < 27) { float tot = 0.f, mine = 0.f;
                for (int i = 0; i < 7; ++i) { const float ci = (float)__hip_atomic_load(pc + 8 + i, RLX_AGENT); tot += ci; if (i == PROBE_ID - 20) mine = ci; }
                v = 100.f * mine / tot; }
            if (PROBE_ID >= 10 && PROBE_ID < 18) { const unsigned now = now_; const int k = PROBE_ID - 10;
                const unsigned t1 = k == 7 ? now : F.MISC[12 + k + 1], t0_ = F.MISC[12 + k]; v = (float)(t1 - t0_) * 0.01f; if (PROBE_ID == 10 || PROBE_ID == 16) v = 10.f + floorf(v / 20.f); if (PROBE_ID == 13) v = floorf(v * 0.5f) - 80.f; if (PROBE_ID == 14) v = 2.f * floorf(v * 0.5f); if (PROBE_ID == 11) v = 2.f * floorf((v - 150.f) * 0.5f); if (PROBE_ID == 15) v = 2.f * floorf(v * 0.5f); }
            const float y0 = __hip_atomic_load(F.out, RLX_AGENT); F.out[0] = y0 + v; }
#endif
    }
#undef IN
#undef SEAM
}

extern "C" void kernel_launch(void* const* d_in, const int* in_sizes, int n_in, void* d_out, int out_size, void* d_ws, size_t ws_size, hipStream_t stream) {
    static int grid = 0;
    if (grid == 0) {
        if (n_in != 29 || out_size != M_ROWS * DM || ws_size < WS_END) { fprintf(stderr, "kernel_launch: unexpected problem (n_in %d, out %d, ws %zu)\n", n_in, out_size, ws_size); grid = -1; return; }
        int dev = 0, cus = 0, per_cu = 0;
        if (hipGetDevice(&dev) != hipSuccess || hipDeviceGetAttribute(&cus, hipDeviceAttributeMultiprocessorCount, dev) != hipSuccess) { grid = -1; return; }
        if (hipFuncSetAttribute((const void*)fwd_kernel, hipFuncAttributeMaxDynamicSharedMemorySize, LDS_BYTES) != hipSuccess) { fprintf(stderr, "kernel_launch: hipFuncSetAttribute failed\n"); grid = -1; return; }
        if (hipOccupancyMaxActiveBlocksPerMultiprocessor(&per_cu, (const void*)fwd_kernel, NWAVES * 64, LDS_BYTES) != hipSuccess || per_cu < 1) { fprintf(stderr, "kernel_launch: occupancy query says %d blocks per CU\n", per_cu); grid = -1; return; }
        (void)hipGetLastError();
        grid = cus;
        if (grid > 256) grid = 256;
    }
    if (grid < 0) return;
    (void)hipMemsetAsync((char*)d_ws + WS_CTL, 0, CTL_ZERO_BYTES, stream);
    Args a{};
    for (int i = 0; i < 29; ++i) a.in[i] = (const float*)d_in[i];
    a.out = (float*)d_out; a.ws = (unsigned char*)d_ws;
#if N_LAUNCHES == 1
    a.ph_lo = 0; a.ph_hi = N_PHASES;
    hipLaunchKernelGGL(fwd_kernel, dim3(grid), dim3(NWAVES * 64), LDS_BYTES, stream, a);
#else
    for (int p = 0; p < N_PHASES; ++p) {
        a.ph_lo = p; a.ph_hi = p + 1;
        hipLaunchKernelGGL(fwd_kernel, dim3(grid), dim3(NWAVES * 64), LDS_BYTES, stream, a);
    }
#endif
}
```

```cpp
#include <hip/hip_runtime.h>
#include <cstdio>
#include <cstdint>
#ifndef N_LAUNCHES
#define N_LAUNCHES 1
#endif
#define NAIVE_P2 0
#define NAIVE_ATTN 0
#define FAST_ATTN 1
#define USE_NAIVE 0
#ifndef REP_PHASE
#define REP_PHASE -1
#endif
#ifndef PROBE_ID
#define PROBE_ID 0
#endif
#ifndef GEMM_ALIGN_P1
#define GEMM_ALIGN_P1 true
#endif
#ifndef GEMM_ALIGN_P6
#define GEMM_ALIGN_P6 true
#endif
#define PIN_(n) asm volatile(".p2align 8\n\t.fill " #n ", 4, 0xBF800000" ::: "memory")
#define PIN(n) PIN_(n)
#ifndef PIN_ATT
#define PIN_ATT 48
#endif
namespace pg8 {
#define PG8_LAS __attribute__((address_space(3)))
typedef unsigned short bf16_t;
typedef short bf16x8 __attribute__((ext_vector_type(8)));
typedef float f32x4 __attribute__((ext_vector_type(4)));
typedef float f32x2 __attribute__((ext_vector_type(2)));
typedef unsigned u32x4 __attribute__((ext_vector_type(4)));
typedef unsigned u32x2 __attribute__((ext_vector_type(2)));
constexpr int BM = 256, BK = 64, HALF = 128, HTB = HALF * BK * 2  , STAGE_BYTES = 8 * HTB, NXCD = 8, WGM = 8;

__host__ __device__ __forceinline__ int lds_byte(int r, int c) { const int st = (r >> 4) * 2 + (c >> 5), rr = r & 15, cc = c & 31, ob = rr * 64 + cc * 2; return st * 1024 + (ob ^ (((ob >> 9) & 1) << 5)); }
__host__ __device__ __forceinline__ void stage_rc(int b, int& R, int& C) { const int st = b / 1024, sb = b % 1024, swz = sb ^ (((sb >> 9) & 1) << 5); R = (st >> 1) * 16 + swz / 64; C = (st & 1) * 32 + (swz % 64) / 2; }
__host__ __device__ __forceinline__ int perm32(int rho) { const int n = rho >> 4, i = rho & 15; return 8 * (i >> 2) + 4 * n + (i & 3); }

struct Unit { int pm, pn, kind, r0, half; };
struct Gemm { int rowA, kstepA, rowB, kstepB, nt; };

struct TileOrder {
    int nM, nN, nwg, G, c;
    __device__ void init(int M, int N, int G_, int c_) { nM = M / BM; nN = N / BM; nwg = nM * nN; G = G_; c = c_; }
    __device__ bool tile(int i, int& pm, int& pn) const { return tileL((long)i * G + c, pm, pn); }
    __device__ bool tileL(long L, int& pm, int& pn) const {
        if (L >= nwg) return false;
        int wgid = (int)L; { const int q = nwg / NXCD, r = nwg % NXCD, xcd = wgid % NXCD, off = wgid / NXCD; wgid = (xcd < r ? xcd * (q + 1) : r * (q + 1) + (xcd - r) * q) + off; }
        const int nig = WGM * nN, gid = wgid / nig, fm = gid * WGM, gsz = (nM - fm) < WGM ? (nM - fm) : WGM;
        pm = fm + ((wgid % nig) % gsz); pn = (wgid % nig) / gsz; return true;
    }
};

__device__ __forceinline__ unsigned cvt_pk_bf16(float lo, float hi) { unsigned r; asm volatile("v_cvt_pk_bf16_f32 %0, %1, %2" : "=v"(r) : "v"(lo), "v"(hi)); return r; }

struct NoSeam { static constexpr bool ACTIVE = false; };
template <class Epi, class Sched, bool ALIGN_EPI = true, class Seam = NoSeam>
__device__ __forceinline__ void gemm_phase(PG8_LAS unsigned char* lds, const Gemm g, const Sched& S, const Epi& E, const Seam seam = Seam()) {
    const int tid = threadIdx.x, wid = __builtin_amdgcn_readfirstlane(tid >> 6), lane = tid & 63, wr = wid >> 2, wc = wid & 3, fr = lane & 15, fq = lane >> 4;
    const int nt = g.nt;
    unsigned voffA[2], voffB[2];
#pragma unroll
    for (int i = 0; i < 2; ++i) { int R, C; stage_rc(tid * 16 + i * 8192, R, C); const int Rb = Epi::PERM ? ((R & ~31) + perm32(R & 31)) : R;
        voffA[i] = (unsigned)(R * g.rowA + C * 2); voffB[i] = (unsigned)(Rb * g.rowB + C * 2); }
    const size_t kstepA = (size_t)g.kstepA, kstepB = (size_t)g.kstepB;
    const size_t hstepA = (size_t)HALF * g.rowA, hstepB = (size_t)HALF * g.rowB;
    const unsigned ldsw = (unsigned)wid * 1024u;
    const int aoff = lds_byte(wr * 64 + fr, fq * 8), boff = lds_byte(wc * 32 + fr, fq * 8);
#define PG8_SA(b, h) (((b) * 2 + (h)) * HTB)
#define PG8_SB(b, h) ((4 + (b) * 2 + (h)) * HTB)
#define PG8_STAGE(bufoff, gbase, voff) do { _Pragma("unroll") for (int _i = 0; _i < 2; ++_i) \
        __builtin_amdgcn_global_load_lds((const unsigned*)((const char*)(gbase) + (voff)[_i]), (PG8_LAS unsigned*)(lds + (bufoff) + ldsw + _i * 8192), 16, 0, 0); } while (0)
#define PG8_LDA(dst, b, h) do { _Pragma("unroll") for (int m = 0; m < 4; ++m) _Pragma("unroll") for (int k = 0; k < 2; ++k) dst[m][k] = *(const PG8_LAS bf16x8*)(lds + PG8_SA(b, h) + aoff + m * 2048 + k * 1024); } while (0)
#define PG8_LDB(dst, b, h) do { _Pragma("unroll") for (int n = 0; n < 2; ++n) _Pragma("unroll") for (int k = 0; k < 2; ++k) dst[n][k] = *(const PG8_LAS bf16x8*)(lds + PG8_SB(b, h) + boff + n * 2048 + k * 1024); } while (0)
#define PG8_MMA(ai, bj, At, Bt) do { __builtin_amdgcn_s_setprio(1); _Pragma("unroll") for (int m = 0; m < 4; ++m) _Pragma("unroll") for (int n = 0; n < 2; ++n) _Pragma("unroll") for (int k = 0; k < 2; ++k) \
        acc[ai][bj][m][n] = __builtin_amdgcn_mfma_f32_16x16x32_bf16(Bt[n][k], At[m][k], acc[ai][bj][m][n], 0, 0, 0); __builtin_amdgcn_s_setprio(0); } while (0)
#define PG8_WAIT_V(n) asm volatile("s_waitcnt vmcnt(" #n ")" ::: "memory")
#define PG8_WAIT_L(n) asm volatile("s_waitcnt lgkmcnt(" #n ")" ::: "memory")
#define PG8_BAR __builtin_amdgcn_s_barrier()
#define PG8_SCHED __builtin_amdgcn_sched_barrier(0)
    Unit cur, nxt; int ui = 0;
    const bool has0 = S.next(0, cur);
    f32x4 acc[2][2][4][2];
    if constexpr (Seam::ACTIVE) {
        if (seam.early()) { seam.enter(); if (has0) E.init(acc, cur, wr, wc, fr, fq); seam.finish(); }
        else { seam.full(); if (has0) E.init(acc, cur, wr, wc, fr, fq); }
        if (!has0) return;
    } else {
        if (!has0) return;
#pragma unroll
        for (int a = 0; a < 2; ++a)
#pragma unroll
            for (int b = 0; b < 2; ++b)
#pragma unroll
                for (int m = 0; m < 4; ++m)
#pragma unroll
                    for (int n = 0; n < 2; ++n) acc[a][b][m][n] = (f32x4){0.f, 0.f, 0.f, 0.f};
    }
    bf16x8 At[4][2], B0[2][2], B1[2][2];
    const char* cA = S.abase(cur); const char* cB = S.bbase(cur);
    PG8_STAGE(PG8_SB(0, 0), cB, voffB); PG8_STAGE(PG8_SB(0, 1), cB + hstepB, voffB); PG8_STAGE(PG8_SA(0, 0), cA, voffA); PG8_STAGE(PG8_SA(0, 1), cA + hstepA, voffA);
    if (wr == 1) PG8_BAR;
    PG8_WAIT_V(2); PG8_BAR;
    PG8_STAGE(PG8_SB(1, 0), cB + kstepB, voffB); PG8_STAGE(PG8_SA(1, 0), cA + kstepA, voffA); PG8_STAGE(PG8_SB(1, 1), cB + hstepB + kstepB, voffB);
    PG8_WAIT_V(6); PG8_BAR;
    for (;;) {
        const bool has_next = S.next(ui + 1, nxt);
        const char* nA = has_next ? S.abase(nxt) : cA; const char* nB = has_next ? S.bbase(nxt) : cB;
        asm volatile(".p2align 8\n\ts_nop 0\n\ts_nop 0\n\ts_nop 0\n\ts_nop 0\n\ts_nop 0\n\ts_nop 0");
        for (int t = 0; t < nt; t += 2) {
            const bool last = (t == nt - 2);
            const char* a1 = cA + (size_t)(t + 1) * kstepA;
            const char* a2 = last ? nA : cA + (size_t)(t + 2) * kstepA; const char* b2 = last ? nB : cB + (size_t)(t + 2) * kstepB;
            const char* a3 = a2 + kstepA; const char* b3 = b2 + kstepB;
            PG8_LDB(B0, 0, 0); PG8_LDB(B1, 0, 1); PG8_SCHED; PG8_LDA(At, 0, 0); PG8_STAGE(PG8_SA(1, 1), a1 + hstepA, voffA);
            PG8_WAIT_V(8); PG8_WAIT_L(0); PG8_BAR; PG8_MMA(0, 0, At, B0); PG8_MMA(0, 1, At, B1); PG8_BAR; PG8_SCHED;
            PG8_LDA(At, 0, 1); PG8_STAGE(PG8_SB(0, 0), b2, voffB); PG8_STAGE(PG8_SB(0, 1), b2 + hstepB, voffB); PG8_STAGE(PG8_SA(0, 0), a2, voffA);
            PG8_WAIT_V(8); PG8_WAIT_L(0); PG8_BAR; if (!cur.half) { PG8_MMA(1, 0, At, B0); PG8_MMA(1, 1, At, B1); } PG8_BAR; PG8_SCHED;
            PG8_LDB(B0, 1, 0); PG8_LDB(B1, 1, 1); PG8_SCHED; PG8_LDA(At, 1, 0); PG8_STAGE(PG8_SA(0, 1), a2 + hstepA, voffA);
            PG8_WAIT_V(8); PG8_WAIT_L(0); PG8_BAR; PG8_MMA(0, 0, At, B0); PG8_MMA(0, 1, At, B1); PG8_BAR; PG8_SCHED;
            PG8_LDA(At, 1, 1); PG8_STAGE(PG8_SB(1, 0), b3, voffB); PG8_STAGE(PG8_SB(1, 1), b3 + hstepB, voffB); PG8_STAGE(PG8_SA(1, 0), a3, voffA);
            PG8_WAIT_V(8); PG8_WAIT_L(0); PG8_BAR; if (!cur.half) { PG8_MMA(1, 0, At, B0); PG8_MMA(1, 1, At, B1); } PG8_BAR; PG8_SCHED;
        }
        if constexpr (ALIGN_EPI) { if (wr == 0) PG8_BAR; }
        const bool keep = E(acc, cur, wr, wc, fr, fq);
        if (!has_next) break;
        if constexpr (Seam::ACTIVE) { if (!keep) E.init(acc, nxt, wr, wc, fr, fq); }
        else if (!keep) {
#pragma unroll
        for (int a = 0; a < 2; ++a)
#pragma unroll
            for (int b = 0; b < 2; ++b)
#pragma unroll
                for (int m = 0; m < 4; ++m)
#pragma unroll
                    for (int n = 0; n < 2; ++n) acc[a][b][m][n] = (f32x4){0.f, 0.f, 0.f, 0.f};
        }
        cur = nxt; cA = nA; cB = nB; ++ui;
        if constexpr (ALIGN_EPI) { if (wr == 1) PG8_BAR; }
    }
    PG8_WAIT_V(0);
    if constexpr (!ALIGN_EPI) { if (wr == 0) PG8_BAR; }
    PG8_BAR;
#undef PG8_SA
#undef PG8_SB
#undef PG8_STAGE
#undef PG8_LDA
#undef PG8_LDB
#undef PG8_MMA
#undef PG8_WAIT_V
#undef PG8_WAIT_L
#undef PG8_BAR
#undef PG8_SCHED
}
}
constexpr int BATCH = 4, SEQ = 4096, DM = 1024, M_ROWS = BATCH * SEQ;
constexpr int NH = 16, HD = 64, NKV = 4, HPG = 4, KVW = 1536;
constexpr int IN_DIM = 6704, NPROJ = 6912;
constexpr int DFF = 2816, NGU = 2 * DFF;
constexpr int NCMP = 255, NCP = 256;
constexpr float EPS = 1e-6f;
constexpr float LOG2E = 1.4426950408889634f;

__device__ __forceinline__ float fast_sigmoid(float x) { return __builtin_amdgcn_rcpf(1.f + __builtin_amdgcn_exp2f(-LOG2E * x)); }
__device__ __forceinline__ float gelu_tanh(float x) { return x * fast_sigmoid(x * (1.5957691216f + 0.0713548163f * x * x)); }

namespace pg8 {
struct SchedSimple {
    TileOrder T; const char* A; const char* B; size_t tA, tB;
    __device__ __forceinline__ bool next(int i, Unit& u) const { u.kind = 0; u.half = 0; const bool ok = T.tile(i, u.pm, u.pn); u.r0 = u.pm * BM; return ok; }
    __device__ __forceinline__ const char* abase(const Unit& u) const { return A + (size_t)u.pm * tA; }
    __device__ __forceinline__ const char* bbase(const Unit& u) const { return B + (size_t)u.pn * tB; }
};
struct SchedHalfTail {
    TileOrder T; const char* A; const char* B; size_t tA, tB; int full;
    __device__ __forceinline__ bool next(int i, Unit& u) const {
        u.kind = 0;
        if (i < full) { u.half = 0; const bool ok = T.tile(i, u.pm, u.pn); u.r0 = u.pm * BM; return ok; }
        if (i > full) return false;
        const int idx = T.c >> 3, lab = T.c & 7;
        const bool ok = T.tileL((long)full * T.G + 8 * (idx >> 1) + lab, u.pm, u.pn); u.half = 1; u.r0 = u.pm * BM + (idx & 1) * HALF; return ok;
    }
    __device__ __forceinline__ const char* abase(const Unit& u) const { return A + (size_t)u.r0 * (tA / BM); }
    __device__ __forceinline__ const char* bbase(const Unit& u) const { return B + (size_t)u.pn * tB; }
};
struct SchedMerge {
    TileOrder T; const char* A0; const char* A1; const char* B0; const char* B1; size_t tA, tB;
    __device__ __forceinline__ bool next(int i, Unit& u) const { u.kind = i & 1; u.half = 0; const bool ok = T.tile(i >> 1, u.pm, u.pn); u.r0 = u.pm * BM; return ok; }
    __device__ __forceinline__ const char* abase(const Unit& u) const { return (u.kind ? A1 : A0) + (size_t)u.pm * tA; }
    __device__ __forceinline__ const char* bbase(const Unit& u) const { return (u.kind ? B1 : B0) + (size_t)u.pn * tB; }
};

typedef f32x4 Acc[2][2][4][2];
#define EPI_ROW(ai, m) (u.r0 + (ai) * HALF + wr * 64 + (m) * 16 + fr)
#define EPI_CT(bj) ((bj) * HALF + wc * 32 + 8 * fq)

__device__ __forceinline__ u32x4 pack8(f32x4 a, f32x4 b) { u32x4 w; w.x = cvt_pk_bf16(a[0], a[1]); w.y = cvt_pk_bf16(a[2], a[3]); w.z = cvt_pk_bf16(b[0], b[1]); w.w = cvt_pk_bf16(b[2], b[3]); return w; }

struct EpiProj {
    static constexpr bool PERM = true;
    const float* rstd; bf16_t *QB, *KVB, *NG, *LX, *LGG, *MG;
    __device__ __forceinline__ bool operator()(Acc& acc, const Unit& u, int wr, int wc, int fr, int fq) const {
        const int pn = u.pn; bf16_t* dst; int ld, c0, act = 0, lim = 256;
        if (pn < 4) { dst = QB; ld = DM; c0 = pn * 256; }
        else if (pn < 10) { dst = KVB; ld = KVW; c0 = (pn - 4) * 256; }
        else if (pn == 10) { dst = NG; ld = 48; c0 = 0; act = 1; lim = 48; }
        else if (pn < 15) { dst = LX; ld = DM; c0 = (pn - 11) * 256; act = 3; }
        else if (pn < 19) { dst = LGG; ld = DM; c0 = (pn - 15) * 256; act = 2; }
        else {
            bf16_t* MGp = MG + (pn - 19) * 128;
#pragma unroll
            for (int ai = 0; ai < 2; ++ai)
#pragma unroll
                for (int m = 0; m < 4; ++m) {
                    const int row = EPI_ROW(ai, m); const float rs = rstd[row];
                    f32x4 a0 = acc[ai][0][m][0] * rs, a1 = acc[ai][0][m][1] * rs, b0 = acc[ai][1][m][0] * rs, b1 = acc[ai][1][m][1] * rs;
#pragma unroll
                    for (int e = 0; e < 4; ++e) { a0[e] = fast_sigmoid(a0[e]); a1[e] = fast_sigmoid(a1[e]); b0[e] = fast_sigmoid(b0[e]); b1[e] = fast_sigmoid(b1[e]); }
                    const u32x4 w1 = pack8(b0, b1);
                    b0[0] = __uint_as_float(w1.x << 16); b0[1] = __uint_as_float(w1.x & 0xffff0000u); b0[2] = __uint_as_float(w1.y << 16); b0[3] = __uint_as_float(w1.y & 0xffff0000u);
                    b1[0] = __uint_as_float(w1.z << 16); b1[1] = __uint_as_float(w1.z & 0xffff0000u); b1[2] = __uint_as_float(w1.w << 16); b1[3] = __uint_as_float(w1.w & 0xffff0000u);
#pragma unroll
                    for (int e = 0; e < 4; ++e) { a0[e] *= __builtin_amdgcn_rcpf(fmaxf(b0[e], 8.6736174e-19f)); a1[e] *= __builtin_amdgcn_rcpf(fmaxf(b1[e], 8.6736174e-19f)); }
                    bf16_t* q = MGp + (size_t)row * (2 * DM) + wc * 32 + 8 * fq;
                    *(u32x4*)q = pack8(a0, a1); *(u32x4*)(q + DM) = w1;
                }
            return false;
        }
#pragma unroll
        for (int ai = 0; ai < 2; ++ai)
#pragma unroll
            for (int m = 0; m < 4; ++m) {
                const int row = EPI_ROW(ai, m); const float rs = rstd[row];
#pragma unroll
                for (int bj = 0; bj < 2; ++bj) {
                    const int ct = EPI_CT(bj);
                    f32x4 v0 = acc[ai][bj][m][0] * rs, v1 = acc[ai][bj][m][1] * rs;
                    if (act == 1) {
#pragma unroll
                        for (int e = 0; e < 4; ++e) { v0[e] = fast_sigmoid(v0[e]); v1[e] = fast_sigmoid(v1[e]); }
                    } else if (act == 2) {
#pragma unroll
                        for (int e = 0; e < 4; ++e) { v0[e] = gelu_tanh(v0[e]); v1[e] = gelu_tanh(v1[e]); }
                    }
                    u32x4 pk;
                    if (act == 3) { pk.x = __builtin_bit_cast(unsigned, __builtin_amdgcn_cvt_pkrtz(v0[0], v0[1])); pk.y = __builtin_bit_cast(unsigned, __builtin_amdgcn_cvt_pkrtz(v0[2], v0[3]));
                                    pk.z = __builtin_bit_cast(unsigned, __builtin_amdgcn_cvt_pkrtz(v1[0], v1[1])); pk.w = __builtin_bit_cast(unsigned, __builtin_amdgcn_cvt_pkrtz(v1[2], v1[3])); }
                    else pk = pack8(v0, v1);
                    if (ct + 8 <= lim) *(u32x4*)(dst + (size_t)row * ld + c0 + ct) = pk;
                }
            }
        return false;
    }
};

struct EpiMerge {
    static constexpr bool PERM = true;
    const bf16_t* MG; bf16_t* MRG;
    __device__ __forceinline__ bool operator()(Acc& acc, const Unit& u, int wr, int wc, int fr, int fq) const {
        const bf16_t* MGp = MG; bf16_t* MRGp = MRG;
        asm volatile("" : "+s"(MGp), "+s"(MRGp));
#pragma unroll
        for (int ai = 0; ai < 2; ++ai)
#pragma unroll
            for (int m = 0; m < 4; ++m) {
                const int row = EPI_ROW(ai, m);
#pragma unroll
                for (int bj = 0; bj < 2; ++bj) {
                    const int col = u.pn * BM + EPI_CT(bj);
                    if (u.kind == 0) {
                        const u32x4 w0 = *(const u32x4*)(MGp + (size_t)row * (2 * DM) + col);
                        f32x4 a0, a1;
                        a0[0] = __uint_as_float(w0.x << 16); a0[1] = __uint_as_float(w0.x & 0xffff0000u); a0[2] = __uint_as_float(w0.y << 16); a0[3] = __uint_as_float(w0.y & 0xffff0000u);
                        a1[0] = __uint_as_float(w0.z << 16); a1[1] = __uint_as_float(w0.z & 0xffff0000u); a1[2] = __uint_as_float(w0.w << 16); a1[3] = __uint_as_float(w0.w & 0xffff0000u);
                        acc[ai][bj][m][0] *= a0; acc[ai][bj][m][1] *= a1;
                    } else {
                        const u32x4 w1 = *(const u32x4*)(MGp + (size_t)row * (2 * DM) + DM + col);
                        f32x4 b0, b1;
                        b0[0] = __uint_as_float(w1.x << 16); b0[1] = __uint_as_float(w1.x & 0xffff0000u); b0[2] = __uint_as_float(w1.y << 16); b0[3] = __uint_as_float(w1.y & 0xffff0000u);
                        b1[0] = __uint_as_float(w1.z << 16); b1[1] = __uint_as_float(w1.z & 0xffff0000u); b1[2] = __uint_as_float(w1.w << 16); b1[3] = __uint_as_float(w1.w & 0xffff0000u);
#pragma unroll
                        for (int e = 0; e < 4; ++e) { b0[e] = fmaxf(b0[e], 8.6736174e-19f); b1[e] = fmaxf(b1[e], 8.6736174e-19f); }
                        *(u32x4*)(MRGp + (size_t)row * DM + col) = pack8(acc[ai][bj][m][0] * b0, acc[ai][bj][m][1] * b1);
                    }
                }
                asm volatile("" ::: "memory");
            }
        return u.kind == 0;
    }
};

struct EpiWout {
    static constexpr bool PERM = true;
    const float* x; float* out; bf16_t* X1B; float* ssq;
    __device__ __forceinline__ void init(Acc& acc, const Unit& u, int wr, int wc, int fr, int fq) const {
        const float* xp = x; asm volatile("" : "+s"(xp));
#pragma unroll
        for (int ai = 0; ai < 2; ++ai)
#pragma unroll
            for (int m = 0; m < 4; ++m) {
                const int row = EPI_ROW(ai, m);
#pragma unroll
                for (int bj = 0; bj < 2; ++bj) {
                    const size_t off = (size_t)row * DM + u.pn * BM + EPI_CT(bj);
                    const __attribute__((address_space(1))) f32x4* gp = (const __attribute__((address_space(1))) f32x4*)(xp + off);
                    acc[ai][bj][m][0] = __builtin_nontemporal_load(gp); acc[ai][bj][m][1] = __builtin_nontemporal_load(gp + 1);
                }
            }
    }
    __device__ __forceinline__ bool operator()(Acc& acc, const Unit& u, int wr, int wc, int fr, int fq) const {
#pragma unroll
        for (int ai = 0; ai < 2; ++ai)
#pragma unroll
            for (int m = 0; m < 4; ++m) {
                const int row = EPI_ROW(ai, m); float s = 0.f;
#pragma unroll
                for (int bj = 0; bj < 2; ++bj) {
                    const int col = u.pn * BM + EPI_CT(bj); const size_t off = (size_t)row * DM + col;
                    const f32x4 v0 = acc[ai][bj][m][0], v1 = acc[ai][bj][m][1];
                    *(u32x4*)(X1B + off) = pack8(v0, v1);
                    s += (v0[0] * v0[0] + v0[1] * v0[1]) + (v0[2] * v0[2] + v0[3] * v0[3]) + (v1[0] * v1[0] + v1[1] * v1[1]) + (v1[2] * v1[2] + v1[3] * v1[3]);
                }
                s += __shfl_xor(s, 16); s += __shfl_xor(s, 32);
                if (fq == 0) ssq[(size_t)row * 16 + u.pn * 4 + wc] = s;
            }
        return false;
    }
};

struct EpiGU {
    static constexpr bool PERM = true;
    const float* ssq; bf16_t* FF;
    __device__ __forceinline__ bool operator()(Acc& acc, const Unit& u, int wr, int wc, int fr, int fq) const {
#pragma unroll
        for (int ai = 0; ai < 2; ++ai)
            if (ai == 0 || !u.half)
#pragma unroll
            for (int m = 0; m < 4; ++m) {
                const int row = EPI_ROW(ai, m);
                const f32x4* sp = (const f32x4*)(ssq + (size_t)row * 16);
                const f32x4 s0 = sp[0], s1 = sp[1], s2 = sp[2], s3 = sp[3];
                const float tot = ((s0[0] + s0[1]) + (s0[2] + s0[3])) + ((s1[0] + s1[1]) + (s1[2] + s1[3])) + ((s2[0] + s2[1]) + (s2[2] + s2[3])) + ((s3[0] + s3[1]) + (s3[2] + s3[3]));
                const float rs = __builtin_amdgcn_rsqf(tot * (1.f / DM) + EPS);
                f32x4 o[2];
#pragma unroll
                for (int n = 0; n < 2; ++n)
#pragma unroll
                    for (int e = 0; e < 4; ++e) { const float g = acc[ai][0][m][n][e] * rs, up = acc[ai][1][m][n][e] * rs; o[n][e] = g * fast_sigmoid(g) * up; }
                *(u32x4*)(FF + (size_t)row * DFF + u.pn * HALF + wc * 32 + 8 * fq) = pack8(o[0], o[1]);
            }
        return false;
    }
};

struct EpiDown {
    static constexpr bool PERM = true;
    float* out; const bf16_t* X1B;
    __device__ __forceinline__ bool operator()(Acc& acc, const Unit& u, int wr, int wc, int fr, int fq) const {
#pragma unroll
        for (int ai = 0; ai < 2; ++ai)
#pragma unroll
            for (int m = 0; m < 4; ++m) {
                const int row = EPI_ROW(ai, m);
#pragma unroll
                for (int bj = 0; bj < 2; ++bj) {
                    const size_t off = (size_t)row * DM + u.pn * BM + EPI_CT(bj);
                    const u32x4 xw = *(const u32x4*)(X1B + off);
                    f32x4 x0, x1;
                    x0[0] = __uint_as_float(xw.x << 16); x0[1] = __uint_as_float(xw.x & 0xffff0000u); x0[2] = __uint_as_float(xw.y << 16); x0[3] = __uint_as_float(xw.y & 0xffff0000u);
                    x1[0] = __uint_as_float(xw.z << 16); x1[1] = __uint_as_float(xw.z & 0xffff0000u); x1[2] = __uint_as_float(xw.w << 16); x1[3] = __uint_as_float(xw.w & 0xffff0000u);
                    *(f32x4*)(out + off) = x0 + acc[ai][bj][m][0]; *(f32x4*)(out + off + 4) = x1 + acc[ai][bj][m][1];
                }
            }
        return false;
    }
};
#undef EPI_ROW
#undef EPI_CT
}
constexpr size_t MiB = 1u << 20;
constexpr size_t WS_CTL = 0, CTL_ZERO_BYTES = 1 * MiB;
constexpr size_t WS_NG = 1 * MiB;
constexpr size_t WS_RSTD1 = 3 * MiB;
constexpr size_t WS_SSQ = 4 * MiB;
constexpr size_t WS_KC = 5 * MiB;
constexpr size_t WS_VC = 5 * MiB + 512 * 1024;
constexpr size_t WS_LSUM = 6 * MiB;
constexpr size_t WS_CW2 = 7 * MiB;
constexpr size_t WS_LW = 7 * MiB + 256 * 1024;
constexpr size_t WS_HID = 8 * MiB;
constexpr size_t WS_CW1 = 12 * MiB;
constexpr size_t WS_WOA = 14 * MiB, WS_WOL = 16 * MiB, WS_WOUT = 18 * MiB;
constexpr size_t WS_WDN = 20 * MiB;
constexpr size_t WS_WGU = 26 * MiB;
constexpr size_t WS_WIN = 37 * MiB;
constexpr size_t WS_XB = 51 * MiB;
constexpr size_t WS_HL = 51 * MiB;
constexpr size_t WS_PC0 = 227 * MiB;
constexpr size_t WS_PC3 = 37 * MiB;
constexpr size_t WS_QB = 83 * MiB;
constexpr size_t WS_KVB = 115 * MiB;
constexpr size_t WS_LX = 163 * MiB;
constexpr size_t WS_LGG = 195 * MiB;
constexpr size_t WS_MRGF = 83 * MiB;
constexpr size_t WS_FF = 83 * MiB;
constexpr size_t WS_END = 251 * MiB;

constexpr int CW_BAR = 4096;
constexpr int CW_QUEUE = 16384;

constexpr int RING_BYTES = 131072;
constexpr int LDSCTL_OFF = RING_BYTES, MISC_OFF = LDSCTL_OFF + 320;
constexpr int LDS_BYTES = 147456;
constexpr int NWAVES = 8;

#define GAS __attribute__((address_space(1)))
#define LAS __attribute__((address_space(3)))
typedef unsigned short bf16;
typedef unsigned v4u __attribute__((ext_vector_type(4)));
typedef unsigned v2u __attribute__((ext_vector_type(2)));
typedef float f32x4 __attribute__((ext_vector_type(4)));
typedef short bf16x8 __attribute__((ext_vector_type(8)));
typedef GAS unsigned gu32;
#define RLX_AGENT __ATOMIC_RELAXED, __HIP_MEMORY_SCOPE_AGENT
#define LDS_WAIT() asm volatile("s_waitcnt lgkmcnt(0)" ::: "memory")
#define VM_WAIT() asm volatile("s_waitcnt vmcnt(0)" ::: "memory")
__device__ __forceinline__ unsigned f2bf(float f) { unsigned u = __builtin_bit_cast(unsigned, f); return (u + 0x7fffu + ((u >> 16) & 1u)) >> 16; }
__device__ __forceinline__ unsigned pk2(float lo, float hi) { return f2bf(lo) | (f2bf(hi) << 16); }
__device__ __forceinline__ float bf2f(unsigned short h) { return __uint_as_float((unsigned)h << 16); }
__device__ __forceinline__ float bflo(unsigned w) { return __uint_as_float(w << 16); }
__device__ __forceinline__ float bfhi(unsigned w) { return __uint_as_float(w & 0xffff0000u); }

#define XB_TMO      128
#define XB_XCNT(j)  (256  + 64 * (j))
#define XB_XSUB(j)  (1280 + 64 * (j))
#define XB_XGEN(j)  (2304 + 64 * (j))
#define XB_TOP      3328
#define XB_TOPGEN   3392
#define XCD_BAR_WORDS 3456
#define XB_SPIN_CAP (1u << 20)
__device__ __forceinline__ unsigned xb_ld(unsigned* p)              { return __hip_atomic_load(p, __ATOMIC_RELAXED, __HIP_MEMORY_SCOPE_AGENT); }
__device__ __forceinline__ unsigned xb_add(unsigned* p, unsigned v) { return __hip_atomic_fetch_add(p, v, __ATOMIC_RELAXED, __HIP_MEMORY_SCOPE_AGENT); }
__device__ __forceinline__ unsigned xb_xcc_id() { return (unsigned)__builtin_amdgcn_s_getreg((3 << 11) | 20) & 0xFu; }
#define XB_SPIN(cond, bar) do { unsigned _sp = 0; while (cond) { __builtin_amdgcn_s_sleep(1); \
    if ((++_sp & 255u) == 0u) { if (xb_ld(&(bar)[XB_TMO])) break; if (_sp > XB_SPIN_CAP) { atomicAdd(&(bar)[XB_TMO], 1u); break; } } } } while (0)
struct XcdBarrier { unsigned* bar; unsigned x; volatile LAS unsigned* st; };
__device__ __forceinline__ XcdBarrier xcd_barrier_post(unsigned* bar, volatile LAS unsigned* st) {
    XcdBarrier b; b.bar = bar; b.x = xb_xcc_id(); b.st = st;
    if (threadIdx.x == 0) (void)xb_add(&bar[XB_XCNT(b.x)], 1u);
    return b;
}
__device__ __forceinline__ void xcd_barrier_complete(unsigned* bar, unsigned x, unsigned& nloc, unsigned& nx) {
    const unsigned G = gridDim.x * gridDim.y * gridDim.z;
    unsigned sum, cnt, mine, sp = 0u;
    for (;;) {
        sum = 0u; cnt = 0u; mine = 0u;
#pragma unroll
        for (unsigned j = 0; j < 16; ++j) { const unsigned c = xb_ld(&bar[XB_XCNT(j)]); sum += c; cnt += (c > 0u) ? 1u : 0u; mine = (j == x) ? c : mine; }
        if (sum == G) break;
        __builtin_amdgcn_s_sleep(1);
        if ((++sp & 255u) == 0u) { if (xb_ld(&bar[XB_TMO])) break; if (sp > XB_SPIN_CAP) { atomicAdd(&bar[XB_TMO], 1u); break; } }
    }
    nloc = mine > 0u ? mine : 1u; nx = cnt > 0u ? cnt : 1u;
}
__device__ __forceinline__ void xcd_barrier(const XcdBarrier& b) {
    asm volatile("s_waitcnt vmcnt(0)" ::: "memory");
    __syncthreads();
    if (threadIdx.x == 0) {
        unsigned* bar = b.bar;
        __builtin_amdgcn_s_waitcnt(0);
        unsigned nloc = b.st[0], nx = b.st[1];
        if (nloc == 0u) { xcd_barrier_complete(bar, b.x, nloc, nx); b.st[0] = nloc; b.st[1] = nx; }
        const unsigned old = xb_add(&bar[XB_XSUB(b.x)], 1u);
        const unsigned gen = old / nloc;
        if (old + 1u == (gen + 1u) * nloc) {
            __builtin_amdgcn_fence(__ATOMIC_RELEASE, "agent");
            asm volatile("s_waitcnt vmcnt(0)" ::: "memory");
            const unsigned og = xb_add(&bar[XB_TOP], 1u);
            const unsigned tg = og / nx;
            if (og + 1u == (tg + 1u) * nx) xb_add(&bar[XB_TOPGEN], 1u);
            else XB_SPIN(xb_ld(&bar[XB_TOPGEN]) == tg, bar);
            __builtin_amdgcn_fence(__ATOMIC_ACQUIRE, "agent");
            xb_add(&bar[XB_XGEN(b.x)], 1u);
            asm volatile("s_waitcnt vmcnt(0)" ::: "memory");
        } else {
            XB_SPIN(xb_ld(&bar[XB_XGEN(b.x)]) == gen, bar);
            __builtin_amdgcn_fence(__ATOMIC_ACQUIRE, "agent");
            asm volatile("s_waitcnt vmcnt(0)" ::: "memory");
        }
    }
    __syncthreads();
}

constexpr int CW_LAB = 20480;
__device__ __forceinline__ void label_barrier(unsigned* cnt, unsigned members, unsigned* bar) {
    asm volatile("s_waitcnt vmcnt(0)" ::: "memory");
    __syncthreads();
    if (threadIdx.x == 0) {
        const unsigned old = xb_add(cnt, 1u);
        const unsigned target = (old / members + 1u) * members;
        XB_SPIN(xb_ld(cnt) < target, bar);
        __builtin_amdgcn_fence(__ATOMIC_ACQUIRE, "agent");
        asm volatile("s_waitcnt vmcnt(0)" ::: "memory");
    }
    __syncthreads();
}

struct LabelSeam {
    static constexpr bool ACTIVE = true;
    bool on, local; unsigned* cnt; unsigned target; XcdBarrier bar;
    __device__ __forceinline__ bool early() const { return on && local; }
    __device__ __forceinline__ void enter() const { asm volatile("s_waitcnt vmcnt(0)" ::: "memory"); __builtin_amdgcn_s_barrier(); asm volatile("" ::: "memory"); }
    __device__ __forceinline__ void finish() const {
        asm volatile("" ::: "memory");
        if (threadIdx.x == 0) {
            (void)__hip_atomic_fetch_add(cnt, 1u, __ATOMIC_RELAXED, __HIP_MEMORY_SCOPE_AGENT);
            XB_SPIN(xb_ld(cnt) < target, bar.bar);
            __builtin_amdgcn_fence(__ATOMIC_ACQUIRE, "agent");
            asm volatile("s_waitcnt vmcnt(0)" ::: "memory");
        }
        __builtin_amdgcn_s_barrier(); asm volatile("" ::: "memory");
    }
    __device__ __forceinline__ void full() const { if (on) xcd_barrier(bar); }
};

struct Frame {
    LAS unsigned char* lds;
    volatile LAS unsigned* MISC;
    gu32* ctl;
    int tid, lane, wave, vcu, G, grp;
    float* out; unsigned char* ws;
};
struct Args { const float* in[29]; float* out; unsigned char* ws; int ph_lo, ph_hi; };
__device__ __forceinline__ float wave_sum(float v) {
#pragma unroll
    for (int o = 1; o < 64; o <<= 1) v += __shfl_xor(v, o);
    return v;
}

struct ConvItem { const float* W; const float* gk; bf16* WT; int ldw, k0, nsrc, nvalid, ldt, ndst, fragmajor; };
constexpr int I_IN = (NPROJ / 32) * 16, I_SQ = 32 * 16, I_GU = (DFF / 32) * 16, I_DN = 32 * (DFF / 64), I_C1 = 8 * 32, I_C2 = 2 * 4, I_LW = 16 * 2;
constexpr int I_EARLY = I_IN + 2 * I_C1 + 2 * I_C2 + 2 * I_LW + I_GU, I_LATE = I_GU + 3 * I_SQ + I_DN;
__device__ __forceinline__ ConvItem p0_item(const Args& A, unsigned char* ws, int r) {
    ConvItem d; d.gk = nullptr; d.nvalid = 32; d.fragmajor = 0;
    if (r < I_IN) { const int nb = r % (NPROJ / 32), kb = r / (NPROJ / 32); int nsrc, nv = 32;
        if (nb < 80) nsrc = 32 * nb; else if (nb < 88) { nsrc = 2560 + 32 * (nb - 80); nv = 48 - 32 * (nb - 80); nv = nv < 0 ? 0 : (nv > 32 ? 32 : nv); } else if (nb < 152) nsrc = 2608 + 32 * (nb - 88);
        else { const int dc = 32 * (nb - 152), j = dc >> 8, w = dc & 255; nsrc = 2608 + 2048 + (w >> 7) * 1024 + 128 * j + (w & 127); }
        d.W = A.in[2]; d.ldw = IN_DIM; d.k0 = 64 * kb; d.nsrc = nsrc; d.nvalid = nv; d.WT = (bf16*)(ws + WS_WIN); d.ldt = DM; d.ndst = 32 * nb; d.gk = A.in[1]; return d; }
    r -= I_IN;
    if (r < 2 * I_C1) { const int w = r / I_C1, q = r % I_C1, nb = q % 8, kb = q / 8;
        d.W = w == 0 ? A.in[6] : A.in[11]; d.ldw = 256; d.k0 = 64 * kb; d.nsrc = 32 * nb; d.WT = (bf16*)(ws + WS_CW1) + (size_t)w * 256 * 2048; d.ldt = 2048; d.ndst = 32 * nb; d.fragmajor = 1; return d; }
    r -= 2 * I_C1;
    if (r < 2 * I_C2) { const int w = r / I_C2, q = r % I_C2, nb = q % 2, kb = q / 2;
        d.W = w == 0 ? A.in[8] : A.in[13]; d.ldw = 64; d.k0 = 64 * kb; d.nsrc = 32 * nb; d.WT = (bf16*)(ws + WS_CW2) + (size_t)w * 64 * 256; d.ldt = 256; d.ndst = 32 * nb; return d; }
    r -= 2 * I_C2;
    if (r < 2 * I_LW) { const int w = r / I_LW, q = r % I_LW, nb = q % 2, blk = q / 2;
        d.W = (w == 0 ? A.in[17] : A.in[19]) + (size_t)blk * 4096; d.ldw = 64; d.k0 = 0; d.nsrc = 32 * nb; d.WT = (bf16*)(ws + WS_LW) + (size_t)(w * 16 + blk) * 4096; d.ldt = 64; d.ndst = 32 * nb; return d; }
    r -= 2 * I_LW;
    if (r < 2 * I_GU) { const int w = r / I_GU, q = r % I_GU, nb = q % (DFF / 32), kb = q / (DFF / 32); const int c = 32 * nb;
        d.W = w == 0 ? A.in[26] : A.in[27]; d.ldw = DFF; d.k0 = 64 * kb; d.nsrc = c; d.WT = (bf16*)(ws + WS_WGU); d.ldt = DM; d.ndst = 256 * (c / 128) + (c % 128) + 128 * w; d.gk = A.in[25]; return d; }
    r -= 2 * I_GU;
    if (r < 3 * I_SQ) { const int w = r / I_SQ, q = r % I_SQ, nb = q % 32, kb = q / 32;
        d.W = w == 0 ? A.in[22] : (w == 1 ? A.in[23] : A.in[24]); d.WT = (bf16*)(ws + (w == 0 ? WS_WOA : (w == 1 ? WS_WOL : WS_WOUT)));
        d.ldw = DM; d.k0 = 64 * kb; d.nsrc = 32 * nb; d.ldt = DM; d.ndst = 32 * nb; return d; }
    r -= 3 * I_SQ;
    { const int nb = r % 32, kb = r / 32;
        d.W = A.in[28]; d.ldw = DM; d.k0 = 64 * kb; d.nsrc = 32 * nb; d.WT = (bf16*)(ws + WS_WDN); d.ldt = DFF; d.ndst = 32 * nb; return d; }
}
__device__ __forceinline__ void p0_item_load(const ConvItem& d, f32x4* v, int lane) {
    const int kr = lane >> 3, cc = lane & 7; const bool ok = 4 * cc < d.nvalid;
    const float* wp = d.W + (size_t)(d.k0 + kr) * d.ldw + d.nsrc + (ok ? 4 * cc : 0);
#pragma unroll
    for (int i = 0; i < 8; ++i) v[i] = __builtin_nontemporal_load((const f32x4*)(wp + (size_t)(8 * i) * d.ldw));
}
__device__ __forceinline__ void p0_item_finish(const ConvItem& d, const f32x4* v, LAS float* scr, int lane) {
    { const int kr = lane >> 3, cc = lane & 7; const bool ok = 4 * cc < d.nvalid;
#pragma unroll
      for (int i = 0; i < 8; ++i) { const int kk = 8 * i + kr; f32x4 x = ok ? v[i] : (f32x4){0.f, 0.f, 0.f, 0.f}; if (d.gk) x = x * d.gk[d.k0 + kk];
          LAS float* q = scr + kk * 33 + 4 * cc; q[0] = x[0]; q[1] = x[1]; q[2] = x[2]; q[3] = x[3]; } }
    LDS_WAIT(); asm volatile("" ::: "memory");
    const int c = lane & 7;
#pragma unroll
    for (int j = 0; j < 4; ++j) { const int n = (lane >> 3) + 8 * j; const LAS float* s = scr + (8 * c) * 33 + n;
        v4u o; o.x = pk2(s[0 * 33], s[1 * 33]); o.y = pk2(s[2 * 33], s[3 * 33]); o.z = pk2(s[4 * 33], s[5 * 33]); o.w = pk2(s[6 * 33], s[7 * 33]);
        if (d.fragmajor) { const int nn = d.ndst + n, k8 = (d.k0 >> 3) + c;
            *(GAS v4u*)(d.WT + ((((size_t)(nn >> 5) * (d.ldt >> 4) + (k8 >> 1)) * 64 + (k8 & 1) * 32 + (nn & 31)) << 3)) = o; }
        else *(GAS v4u*)(d.WT + (size_t)(d.ndst + n) * d.ldt + d.k0 + 8 * c) = o; }
    LDS_WAIT(); asm volatile("" ::: "memory");
}
template <bool LATE>
__device__ __forceinline__ void p0_prologue(Frame& F, const Args& A, int hrank = 0, int nhelp = 0) {
    LAS float* scr = (LAS float*)(F.lds + F.wave * 16384);
    const int gw = LATE ? hrank * NWAVES + F.wave : F.vcu * NWAVES + F.wave, NGW = LATE ? nhelp * NWAVES : F.G * NWAVES;
    unsigned char* ws = F.ws;
    const int NITEMS = LATE ? I_LATE : I_EARLY, ibase = LATE ? I_EARLY : 0;
    if (gw < NITEMS) {
        f32x4 v[8]; ConvItem cur = p0_item(A, ws, ibase + gw); p0_item_load(cur, v, F.lane);
        for (int it = gw; it < NITEMS; it += NGW) {
            const int nx = it + NGW; f32x4 vn[8]; ConvItem nxt = cur;
            if (nx < NITEMS) nxt = p0_item(A, ws, ibase + nx);
            p0_item_load(nxt, vn, F.lane);
            p0_item_finish(cur, v, scr, F.lane);
            cur = nxt;
#pragma unroll
            for (int i = 0; i < 8; ++i) v[i] = vn[i];
        }
    }
    if (LATE) return;
    const float* x = A.in[0]; bf16* XB = (bf16*)(ws + WS_XB); float* rstd = (float*)(ws + WS_RSTD1);
    for (int rep_ = 0; rep_ < (REP_PHASE == 31 ? 2 : 1); ++rep_)
    for (int m0 = gw; m0 < M_ROWS; m0 += 4 * NGW) {
        f32x4 v[4][4];
#pragma unroll
        for (int r = 0; r < 4; ++r) { const int m = m0 + r * NGW < M_ROWS ? m0 + r * NGW : m0; const GAS f32x4* xr = (const GAS f32x4*)(x + (size_t)m * DM) + 2 * F.lane;
#pragma unroll
            for (int j = 0; j < 4; ++j) v[r][j] = __builtin_nontemporal_load(xr + 128 * (j >> 1) + (j & 1)); }
#pragma unroll
        for (int r = 0; r < 4; ++r) { const int m = m0 + r * NGW; if (m < M_ROWS) {
            float s = 0.f;
#pragma unroll
            for (int j = 0; j < 4; ++j) s += (v[r][j].x * v[r][j].x + v[r][j].y * v[r][j].y) + (v[r][j].z * v[r][j].z + v[r][j].w * v[r][j].w);
            s = wave_sum(s);
            if (F.lane == 0) rstd[m] = 1.0f / sqrtf(s * (1.f / DM) + EPS);
            GAS v4u* o16 = (GAS v4u*)(XB + (size_t)m * DM) + F.lane;
#pragma unroll
            for (int hf = 0; hf < 2; ++hf) { v4u o; o.x = pk2(v[r][2 * hf].x, v[r][2 * hf].y); o.y = pk2(v[r][2 * hf].z, v[r][2 * hf].w); o.z = pk2(v[r][2 * hf + 1].x, v[r][2 * hf + 1].y); o.w = pk2(v[r][2 * hf + 1].z, v[r][2 * hf + 1].w);
                o16[64 * hf] = o; } } }
    }
}
typedef float f32x16 __attribute__((ext_vector_type(16)));
typedef short s16x4 __attribute__((ext_vector_type(4)));
__device__ __forceinline__ int crow(int r, int hi) { return (r & 3) + 8 * (r >> 2) + 4 * hi; }
__device__ __forceinline__ unsigned cvtpk(float lo, float hi) { unsigned r; asm volatile("v_cvt_pk_bf16_f32 %0, %1, %2" : "=v"(r) : "v"(lo), "v"(hi)); return r; }
__device__ __forceinline__ bf16x8 pack_bf8(const float* v) { v4u w; w.x = cvtpk(v[0], v[1]); w.y = cvtpk(v[2], v[3]); w.z = cvtpk(v[4], v[5]); w.w = cvtpk(v[6], v[7]); return __builtin_bit_cast(bf16x8, w); }
__device__ __forceinline__ void unpack_bf8(v4u w, float* v) { v[0] = bflo(w.x); v[1] = bfhi(w.x); v[2] = bflo(w.y); v[3] = bfhi(w.y); v[4] = bflo(w.z); v[5] = bfhi(w.z); v[6] = bflo(w.w); v[7] = bfhi(w.w); }

__device__ __forceinline__ void p2_knorm(Frame& F, const Args& A) {
    const int idx = F.vcu * 512 + F.tid;
    for (int it = idx; it < M_ROWS * 8; it += F.G * 512) {
        const int m = it >> 3, s = (it >> 2) & 1, g = it & 3, set = s ? 4 : 2;
        bf16* p = (bf16*)(F.ws + WS_KVB) + (size_t)m * KVW + set * 256 + g * 64; const float* gw = A.in[4] + (s ? 2 : 1) * 64;
        v4u w[8]; float ss = 0.f;
#pragma unroll
        for (int c = 0; c < 8; ++c) { w[c] = *(const v4u*)(p + 8 * c); float v[8]; unpack_bf8(w[c], v);
#pragma unroll
            for (int e = 0; e < 8; ++e) ss += v[e] * v[e]; }
        const float r = 1.0f / sqrtf(ss * (1.f / 64) + EPS);
#pragma unroll
        for (int c = 0; c < 8; ++c) { float v[8]; unpack_bf8(w[c], v); const f32x4 g0 = *(const f32x4*)(gw + 8 * c), g1 = *(const f32x4*)(gw + 8 * c + 4);
            v[0] *= r * g0[0]; v[1] *= r * g0[1]; v[2] *= r * g0[2]; v[3] *= r * g0[3]; v[4] *= r * g1[0]; v[5] *= r * g1[1]; v[6] *= r * g1[2]; v[7] *= r * g1[3];
            *(bf16x8*)(p + 8 * c) = pack_bf8(v); }
    }
}

constexpr int HID_LD = 264, CMP_A_OFF = 0, CMP_POS_OFF = 528 * 128, CMP_HID_OFF = 113664;
__device__ __forceinline__ void p2_compress(Frame& F, const Args& A, int unit) {
    const int set = unit >> 7, bg = (unit >> 3) & 15, oct = unit & 7, b = bg >> 2, g = bg & 3;
    const int lane = F.lane, w = F.wave, r32 = lane & 31, hi = lane >> 5, n0 = oct * 32;
    LAS unsigned char* lds = F.lds;
    { const bf16* kvb = (const bf16*)(F.ws + WS_KVB) + (size_t)(b * SEQ + 16 * n0) * KVW + set * 256 + g * 64;
      for (int q = w; q < 66; q += NWAVES) { const int R = 8 * q + (lane >> 3), c = (lane & 7) ^ ((R >> 4) & 7);
          __builtin_amdgcn_global_load_lds((const unsigned*)(kvb + (size_t)R * KVW + c * 8), (LAS unsigned*)(lds + CMP_A_OFF + q * 1024), 16, 0, 0); } }
    { const float* pos = set ? A.in[10] : A.in[5]; const f32x4 p = *(const f32x4*)(pos + 4 * F.tid); v2u pk; pk.x = cvtpk(p[0], p[1]); pk.y = cvtpk(p[2], p[3]);
      *(LAS v2u*)(lds + CMP_POS_OFF + 8 * F.tid) = pk; }
    const bf16* w1f = (const bf16*)(F.ws + WS_CW1) + ((size_t)(set * 8 + w) * 128 * 64 + lane) * 8;
    bf16x8 bq[8];
#pragma unroll
    for (int i = 0; i < 8; ++i) bq[i] = *(const bf16x8*)(w1f + (size_t)i * 512);
    asm volatile("s_waitcnt vmcnt(8)" ::: "memory");
    __syncthreads();
    f32x16 acc, acc2;
#pragma unroll
    for (int i = 0; i < 16; ++i) { acc[i] = 0.f; acc2[i] = 0.f; }
    const LAS unsigned char* arow = lds + CMP_A_OFF + r32 * 2048;
    const LAS unsigned char* prow = lds + CMP_POS_OFF + 16 * hi;
#pragma unroll 1
    for (int k8 = 0; k8 < 16; ++k8) {
        bf16x8 bn[8];
        const int kn = k8 < 15 ? k8 + 1 : 15;
#pragma unroll
        for (int i = 0; i < 8; ++i) bn[i] = *(const bf16x8*)(w1f + (size_t)(kn * 8 + i) * 512);
#pragma unroll
        for (int i = 0; i < 8; ++i) {
            const int lt = 2 * k8 + (i >> 2), kq = i & 3;
            const int key = (r32 + (k8 >> 3)) & 7;
            const bf16x8 af = *(const LAS bf16x8*)(arow + lt * 128 + (((2 * kq + hi) ^ key) << 4));
            const bf16x8 pf = *(const LAS bf16x8*)(prow + lt * 128 + kq * 32);
            acc = __builtin_amdgcn_mfma_f32_32x32x16_bf16(af, bq[i], acc, 0, 0, 0);
            acc2 = __builtin_amdgcn_mfma_f32_32x32x16_bf16(pf, bq[i], acc2, 0, 0, 0);
        }
#pragma unroll
        for (int i = 0; i < 8; ++i) bq[i] = bn[i];
    }
    LAS bf16* hid = (LAS bf16*)(lds + CMP_HID_OFF);
    { const float b1 = (set ? A.in[12] : A.in[7])[w * 32 + r32];
#pragma unroll
      for (int r = 0; r < 16; ++r) hid[crow(r, hi) * HID_LD + w * 32 + r32] = (bf16)f2bf(gelu_tanh(acc[r] + acc2[r] + b1)); }
    __syncthreads();
    if (w == 0) {
        const bf16* w2t = (const bf16*)(F.ws + WS_CW2) + (size_t)set * 64 * 256;
        f32x16 o[2];
#pragma unroll
        for (int mt = 0; mt < 2; ++mt)
#pragma unroll
            for (int i = 0; i < 16; ++i) o[mt][i] = 0.f;
#pragma unroll
        for (int k4 = 0; k4 < 4; ++k4) {
            bf16x8 wa[4][2];
#pragma unroll
            for (int i = 0; i < 4; ++i)
#pragma unroll
                for (int mt = 0; mt < 2; ++mt) wa[i][mt] = *(const bf16x8*)(w2t + (size_t)(32 * mt + r32) * 256 + 16 * (4 * k4 + i) + 8 * hi);
#pragma unroll
            for (int i = 0; i < 4; ++i) {
                const bf16x8 hb = *(const LAS bf16x8*)(hid + r32 * HID_LD + 16 * (4 * k4 + i) + 8 * hi);
#pragma unroll
                for (int mt = 0; mt < 2; ++mt) o[mt] = __builtin_amdgcn_mfma_f32_32x32x16_bf16(wa[i][mt], hb, o[mt], 0, 0, 0);
            }
        }
        const float* b2 = set ? A.in[14] : A.in[9]; float ss = 0.f;
#pragma unroll
        for (int mt = 0; mt < 2; ++mt)
#pragma unroll
            for (int r = 0; r < 16; ++r) { o[mt][r] += b2[32 * mt + crow(r, hi)]; ss += o[mt][r] * o[mt][r]; }
        ss += __shfl_xor(ss, 32);
        const float rs = 1.0f / sqrtf(ss * (1.f / 64) + EPS);
        const int n = n0 + r32;
        bf16* dst = (bf16*)(F.ws + (set ? WS_VC : WS_KC)) + ((size_t)bg * NCP + n) * 64;
#pragma unroll
        for (int mt = 0; mt < 2; ++mt)
#pragma unroll
            for (int a = 0; a < 4; ++a) { float v[4];
#pragma unroll
                for (int e = 0; e < 4; ++e) { const int d = 32 * mt + 8 * a + 4 * hi + e; float x = o[mt][4 * a + e]; if (set == 0) x *= rs * A.in[4][d]; if (n >= NCMP) x = 0.f; v[e] = x; }
                v2u pk; pk.x = cvtpk(v[0], v[1]); pk.y = cvtpk(v[2], v[3]);
                *(v2u*)(dst + 32 * mt + 8 * a + 4 * hi) = pk; }
    }
}

typedef _Float16 h8v __attribute__((ext_vector_type(8)));
typedef _Float16 h2v __attribute__((ext_vector_type(2)));
__device__ __forceinline__ unsigned pkh(float a, float b) { return __builtin_bit_cast(unsigned, __builtin_amdgcn_cvt_pkrtz(a, b)); }
constexpr int LRU_SEG = 128, LRU_NSEG = SEQ / LRU_SEG, LRU_BW_OFF = 0, LRU_CW_OFF = 16384, LRU_X_OFF = 20480;
__device__ __forceinline__ void lru_wg(Frame& F, const Args& A, int item) {
    const int n = item & 15, b = (item >> 4) & 3, seg = (item >> 6) * 8 + F.wave;
    int lane = F.lane, tid = F.tid; asm volatile("" : "+v"(lane), "+v"(tid));
    const int r32 = lane & 31, hi = lane >> 5;
    LAS v4u* BWL = (LAS v4u*)(F.lds + LRU_BW_OFF); LAS _Float16* cwH = (LAS _Float16*)(F.lds + LRU_CW_OFF);
    { const bf16* lw = (const bf16*)(F.ws + WS_LW);
      for (int e = tid; e < 1024; e += NWAVES * 64) { const int fr = e >> 6, ln = e & 63, gt = fr >> 3, nt = (fr >> 2) & 1, ks = fr & 3;
          const v4u w = *(const v4u*)(lw + ((size_t)(gt * 16 + n) * 64 + 32 * nt + (ln & 31)) * 64 + 16 * ks + 8 * (ln >> 5));
          float wv[8]; unpack_bf8(w, wv);
#pragma unroll
          for (int i = 0; i < 8; ++i) wv[i] *= -LOG2E;
          v4u o; o.x = pkh(wv[0], wv[1]); o.y = pkh(wv[2], wv[3]); o.z = pkh(wv[4], wv[5]); o.w = pkh(wv[6], wv[7]);
          BWL[e] = o; }
      if (tid < 320) { const int tap = tid >> 6, ln = tid & 63; cwH[tid] = (_Float16)(tap < 4 ? A.in[15][tap * 1024 + n * 64 + ln] : A.in[16][n * 64 + ln]); } }
    __syncthreads();
    bf16x8 ID0, ID1;
    { const bool mine = (hi == ((r32 >> 3) & 1));
#pragma unroll
      for (int j = 0; j < 8; ++j) { const short one = (mine && j == (r32 & 7)) ? (short)0x3C00 : (short)0; ID0[j] = (r32 < 16) ? one : (short)0; ID1[j] = (r32 >= 16) ? one : (short)0; } }
    float L2A[2], bar_[2], bi_[2], carry[2], Aseg[2];
#pragma unroll
    for (int nt = 0; nt < 2; ++nt) { const int cj = n * 64 + 32 * nt + r32; const float lam = A.in[21][cj];
        L2A[nt] = -8.0f * log1pf(expf(-lam)) * LOG2E; bar_[nt] = -LOG2E * A.in[18][cj]; bi_[nt] = -LOG2E * A.in[20][cj]; carry[nt] = 0.f; Aseg[nt] = 1.f; }
    const bf16* LXb = (const bf16*)(F.ws + WS_LX) + (size_t)b * SEQ * DM + n * 64; _Float16* HL = (_Float16*)(F.ws + WS_HL); _Float16* PC = (_Float16*)(F.ws + (b < 3 ? WS_PC0 : WS_PC3)) - (size_t)(b < 3 ? 0 : 3) * (SEQ / 32) * 16 * 2 * 1024;
    LAS unsigned char* xbuf = F.lds + LRU_X_OFF + F.wave * 10240;
#define LRU_DMA(tile_) do { const bf16* p_ = LXb + ((long)(seg * LRU_SEG + (tile_) * 32 + (lane >> 3)) - 3) * DM + (((lane & 7) ^ ((lane >> 3) & 7)) << 3); \
        _Pragma("unroll") for (int q = 0; q < 5; ++q) __builtin_amdgcn_global_load_lds((const unsigned*)(p_ + (size_t)q * 8 * DM), (LAS unsigned*)(xbuf + ((tile_) & 1) * 5120 + q * 1024), 16, 0, 0); } while (0)
    LRU_DMA(0);
#pragma unroll 1
    for (int tile = 0; tile < LRU_SEG / 32; ++tile) {
        const int t0 = seg * LRU_SEG + tile * 32, t = t0 + r32;
        asm volatile("s_waitcnt vmcnt(0)" ::: "memory");
        if (tile + 1 < LRU_SEG / 32) LRU_DMA(tile + 1);
        const LAS unsigned char* xb = xbuf + (tile & 1) * 5120;


        h8v AX[4];
        v4u xw[4][4]; v4u wv[4][5];
#pragma unroll
        for (int ks = 0; ks < 4; ++ks) {
#pragma unroll
            for (int tap = 0; tap < 4; ++tap) { const int Rl = r32 + tap; xw[ks][tap] = *(const LAS v4u*)(xb + Rl * 128 + (((2 * ks + hi) ^ (Rl & 7)) << 4)); }
#pragma unroll
            for (int tap = 0; tap < 5; ++tap) wv[ks][tap] = *(const LAS v4u*)(cwH + tap * 64 + 16 * ks + 8 * hi);
        }
        __builtin_amdgcn_sched_barrier(0);
#pragma unroll
        for (int ks = 0; ks < 4; ++ks) {
            h8v acc = __builtin_bit_cast(h8v, wv[ks][4]);
#pragma unroll
            for (int tap = 0; tap < 4; ++tap) {
                v4u x4 = xw[ks][tap];
                if (t - 3 + tap < 0) x4 = (v4u){0u, 0u, 0u, 0u};
                acc = __builtin_bit_cast(h8v, wv[ks][tap]) * __builtin_bit_cast(h8v, x4) + acc;
            }
            AX[ks] = acc;
        }
#pragma unroll
        for (int nt = 0; nt < 2; ++nt) {
            f32x16 ar, ai, xq;
#pragma unroll
            for (int i = 0; i < 16; ++i) { ar[i] = 0.f; ai[i] = 0.f; xq[i] = 0.f; }
            h8v bwr[4], bwi[4];
#pragma unroll
            for (int ks = 0; ks < 4; ++ks) { bwr[ks] = __builtin_bit_cast(h8v, BWL[((0 * 2 + nt) * 4 + ks) * 64 + lane]); bwi[ks] = __builtin_bit_cast(h8v, BWL[((1 * 2 + nt) * 4 + ks) * 64 + lane]); }
            __builtin_amdgcn_sched_barrier(0);
#pragma unroll
            for (int ks = 0; ks < 4; ++ks) { ar = __builtin_amdgcn_mfma_f32_32x32x16_f16(AX[ks], bwr[ks], ar, 0, 0, 0); ai = __builtin_amdgcn_mfma_f32_32x32x16_f16(AX[ks], bwi[ks], ai, 0, 0, 0); }
            xq = __builtin_amdgcn_mfma_f32_32x32x16_f16(AX[2 * nt], __builtin_bit_cast(h8v, ID0), xq, 0, 0, 0);
            xq = __builtin_amdgcn_mfma_f32_32x32x16_f16(AX[2 * nt + 1], __builtin_bit_cast(h8v, ID1), xq, 0, 0, 0);
            float av[16], bv[16];
#pragma unroll
            for (int r = 0; r < 16; ++r) {
                const float ea = 1.f + __builtin_amdgcn_exp2f(ar[r] + bar_[nt]), eb = 1.f + __builtin_amdgcn_exp2f(ai[r] + bi_[nt]);
                const float rc = __builtin_amdgcn_rcpf(ea * eb), rr = rc * eb, ii = rc * ea;
                const float a = __builtin_amdgcn_exp2f(rr * L2A[nt]);
                av[r] = a; bv[r] = __builtin_amdgcn_sqrtf(fmaxf(1.f - a * a, 0.f)) * (ii * xq[r]);
            }
            float Ag[4], Bg[4];
#pragma unroll
            for (int a = 0; a < 4; ++a) { Ag[a] = (av[4 * a] * av[4 * a + 1]) * (av[4 * a + 2] * av[4 * a + 3]);
                Bg[a] = ((bv[4 * a] * av[4 * a + 1] + bv[4 * a + 1]) * av[4 * a + 2] + bv[4 * a + 2]) * av[4 * a + 3] + bv[4 * a + 3]; }
            float st = carry[nt], pr = Aseg[nt], hst[4], pst[4];
#pragma unroll
            for (int a = 0; a < 4; ++a) {
                const float Ap = __shfl_xor(Ag[a], 32), Bp = __shfl_xor(Bg[a], 32);
                const float Alo = hi ? Ap : Ag[a], Blo = hi ? Bp : Bg[a], Ahi = hi ? Ag[a] : Ap, Bhi = hi ? Bg[a] : Bp;
                const float s_lo = st; st = Alo * st + Blo; const float s_hi = st; st = Ahi * st + Bhi;
                const float p_lo = pr; pr *= Alo; const float p_hi = pr; pr *= Ahi;
                hst[a] = hi ? s_hi : s_lo; pst[a] = hi ? p_hi : p_lo;
            }
            carry[nt] = st; Aseg[nt] = pr;
            {
                float hv[16], pv[16];
#pragma unroll
                for (int a = 0; a < 4; ++a) { float h = hst[a], p = pst[a];
#pragma unroll
                    for (int e = 0; e < 4; ++e) { const int r = 4 * a + e; h = av[r] * h + bv[r]; p *= av[r]; hv[r] = h; pv[r] = p; } }
                const size_t toff = ((size_t)((b * (SEQ / 32) + seg * (LRU_SEG / 32) + tile) * 16 + n) * 2 + nt) * 1024 + lane * 16;
                v4u w0, w1;
                w0.x = pkh(hv[0], hv[1]); w0.y = pkh(hv[2], hv[3]); w0.z = pkh(hv[4], hv[5]); w0.w = pkh(hv[6], hv[7]); w1.x = pkh(hv[8], hv[9]); w1.y = pkh(hv[10], hv[11]); w1.z = pkh(hv[12], hv[13]); w1.w = pkh(hv[14], hv[15]);
                *(v4u*)(HL + toff) = w0; *(v4u*)(HL + toff + 8) = w1;
                w0.x = pkh(pv[0], pv[1]); w0.y = pkh(pv[2], pv[3]); w0.z = pkh(pv[4], pv[5]); w0.w = pkh(pv[6], pv[7]); w1.x = pkh(pv[8], pv[9]); w1.y = pkh(pv[10], pv[11]); w1.z = pkh(pv[12], pv[13]); w1.w = pkh(pv[14], pv[15]);
                *(v4u*)(PC + toff) = w0; *(v4u*)(PC + toff + 8) = w1;
            }
        }
    }
#undef LRU_DMA
    if (hi == 0) {
        float* ls = (float*)(F.ws + WS_LSUM);
#pragma unroll
        for (int nt = 0; nt < 2; ++nt) *(float2*)(ls + ((size_t)(b * LRU_NSEG + seg) * 1024 + n * 64 + 32 * nt + r32) * 2) = make_float2(Aseg[nt], carry[nt]);
    }
}

__device__ __forceinline__ void lru_pass2(Frame& F, const Args& A, int item) {
    const int half = item & 1, seg = (item >> 1) & 31, b = item >> 6, lane = F.lane, r32 = lane & 31, hi = lane >> 5;
    LAS float* hin = (LAS float*)F.lds;
    { const float* ls = (const float*)(F.ws + WS_LSUM) + ((size_t)b * LRU_NSEG * 1024 + half * 512 + F.tid) * 2; float h = 0.f;
      for (int s0 = 0; s0 < seg; s0 += 8) {
          float2 ab[8];
#pragma unroll
          for (int i = 0; i < 8; ++i) { const int s = (s0 + i < seg) ? s0 + i : seg - 1; ab[i] = *(const float2*)(ls + (size_t)s * 2048); }
#pragma unroll
          for (int i = 0; i < 8; ++i) if (s0 + i < seg) h = ab[i].x * h + ab[i].y;
      }
      hin[F.tid] = h; }
    __syncthreads();
    const int n = half * 8 + F.wave;
    const float h0 = hin[F.wave * 64 + r32], h1 = hin[F.wave * 64 + 32 + r32];
    LAS unsigned char* tb = F.lds + 4096 + F.wave * 4608;
    const _Float16* HL = (const _Float16*)(F.ws + WS_HL); const _Float16* PC = (const _Float16*)(F.ws + (b < 3 ? WS_PC0 : WS_PC3)) - (size_t)(b < 3 ? 0 : 3) * (SEQ / 32) * 16 * 2 * 1024;
    bf16* LR = (bf16*)(F.ws + WS_LGG);
    typedef _Float16 hh8 __attribute__((ext_vector_type(8)));
#pragma unroll 1
    for (int tile = 0; tile < LRU_SEG / 32; ++tile) {
        const int t0 = seg * LRU_SEG + tile * 32;
        const size_t toff = ((size_t)((b * (SEQ / 32) + seg * (LRU_SEG / 32) + tile) * 16 + n) * 2) * 1024 + lane * 16;
        hh8 hq[2][2], pq[2][2];
#pragma unroll
        for (int nt = 0; nt < 2; ++nt) { hq[nt][0] = *(const hh8*)(HL + toff + nt * 1024); hq[nt][1] = *(const hh8*)(HL + toff + nt * 1024 + 8); pq[nt][0] = *(const hh8*)(PC + toff + nt * 1024); pq[nt][1] = *(const hh8*)(PC + toff + nt * 1024 + 8); }
        v4u gw[4];
#pragma unroll
        for (int i = 0; i < 4; ++i) { const int q = lane + 64 * i; gw[i] = *(const v4u*)(LR + (size_t)(b * SEQ + t0 + (q >> 3)) * DM + n * 64 + 8 * (q & 7)); }
#pragma unroll
        for (int nt = 0; nt < 2; ++nt) { const float hc = nt ? h1 : h0;
#pragma unroll
            for (int r = 0; r < 16; ++r) { const float s = (float)hq[nt][r >> 3][r & 7] + (float)pq[nt][r >> 3][r & 7] * hc;
                *(LAS _Float16*)(tb + crow(r, hi) * 144 + (32 * nt + r32) * 2) = (_Float16)s; } }
        asm volatile("s_waitcnt lgkmcnt(0)" ::: "memory");
#pragma unroll
        for (int i = 0; i < 4; ++i) { const int q = lane + 64 * i;
            const hh8 sv = *(const LAS hh8*)(tb + (q >> 3) * 144 + 16 * (q & 7)); float g[8], o[8]; unpack_bf8(gw[i], g);
#pragma unroll
            for (int k = 0; k < 8; ++k) o[k] = (float)sv[k] * g[k];
            *(bf16x8*)(LR + (size_t)(b * SEQ + t0 + (q >> 3)) * DM + n * 64 + 8 * (q & 7)) = pack_bf8(o); }
        asm volatile("s_waitcnt lgkmcnt(0)" ::: "memory");
    }
    __syncthreads();
}

__device__ __forceinline__ void phase2(Frame& F, const Args& A) {
    p2_knorm(F, A);
    for (int rep = 0; rep < (REP_PHASE == 20 ? 2 : 1); ++rep)
    for (int u = F.vcu; u < 256; u += F.G) { p2_compress(F, A, u); __syncthreads(); }
    for (int rep = 0; rep < (REP_PHASE == 21 ? 2 : 1); ++rep)
    for (int it = F.vcu; it < 256; it += F.G) { lru_wg(F, A, it); __syncthreads(); }
}
namespace att {
constexpr int NSLOT = 4, SLOTB = 16384  , IMP_OFF = NSLOT * SLOTB, IMP_LD = 72, MSK_OFF = IMP_OFF + 4 * 64 * IMP_LD * 2, UNI_OFF = MSK_OFF + 512, SC_OFF = UNI_OFF + 16;
static_assert(SC_OFF + 4 * 64 * 4 * 4 <= RING_BYTES, "attention LDS map");
constexpr float NEGBIG = -1e30f, MREF0 = -8192.f, C2 = 0.125f * LOG2E, THR = 8.f;
constexpr int DIST = 2;

__device__ __forceinline__ void glds16(const void* gsrc, unsigned lds_dst) { unsigned keep;
    asm volatile("s_mov_b32 %0, m0\n\ts_mov_b32 m0, %2\n\ts_nop 0\n\tglobal_load_lds_dwordx4 %1, off\n\ts_mov_b32 m0, %0" : "=&s"(keep) : "v"(gsrc), "s"(lds_dst) : "memory"); }
#define ATT_WAIT_BAR(N) asm volatile("s_waitcnt vmcnt(" #N ") lgkmcnt(0)\n\ts_barrier" ::: "memory")
#define ATT_WAIT_BAR_NOVM() asm volatile("s_waitcnt lgkmcnt(0)\n\ts_barrier" ::: "memory")
__device__ __forceinline__ float fadd_s(float a, float b) { float r; asm("v_add_f32_e32 %0, %1, %2" : "=v"(r) : "v"(a), "v"(b)); return r; }
__device__ __forceinline__ float max3f(float a, float b, float c) { float r; asm("v_max3_f32 %0, %1, %2, %3" : "=v"(r) : "v"(a), "v"(b), "v"(c)); return r; }

#define ATT_SB() __builtin_amdgcn_sched_barrier(0)
__device__ __forceinline__ void qk_tile(const LAS unsigned char* kslot, const bf16x8* qf, float slk  , float base0, f32x16& p0, f32x16& p1, int r32, int hi) {
    const LAS unsigned char* kp = kslot + r32 * 128; const int kx = (r32 >> 1) & 7;
    bf16x8 kf[8];
#pragma unroll
    for (int d0 = 0; d0 < 4; ++d0) { const int so = ((2 * d0 + hi) ^ kx) << 4; kf[2 * d0] = *(const LAS bf16x8*)(kp + so); kf[2 * d0 + 1] = *(const LAS bf16x8*)(kp + 4096 + so); }
    ATT_SB();
    const float bl = base0 + slk * (float)(4 * hi), bh = bl + slk * 32.f;
#pragma unroll
    for (int r = 0; r < 16; ++r) { const float c = (float)((r & 3) + 8 * (r >> 2)); p0[r] = __builtin_fmaf(slk, c, bl); p1[r] = __builtin_fmaf(slk, c, bh); }
    ATT_SB();
    __builtin_amdgcn_s_setprio(1);
#pragma unroll
    for (int d0 = 0; d0 < 4; ++d0) {
        p0 = __builtin_amdgcn_mfma_f32_32x32x16_bf16(kf[2 * d0], qf[d0], p0, 0, 0, 0);
        p1 = __builtin_amdgcn_mfma_f32_32x32x16_bf16(kf[2 * d0 + 1], qf[d0], p1, 0, 0, 0);
    }
    __builtin_amdgcn_s_setprio(0);
    ATT_SB();
}
template <bool LE> __device__ __forceinline__ void mask_tile(f32x16& p0, f32x16& p1, int bound, int hi) {
    const int bb = bound - 4 * hi;
#pragma unroll
    for (int r = 0; r < 16; ++r) { const int c = (r & 3) + 8 * (r >> 2);
        if (LE) { if (c > bb) p0[r] = NEGBIG; if (c + 32 > bb) p1[r] = NEGBIG; }
        else { if (c < bb) p0[r] = NEGBIG; if (c + 32 < bb) p1[r] = NEGBIG; } }
}
__device__ __forceinline__ float row_max(const f32x16& p0, const f32x16& p1) {
    float a = max3f(p0[0], p0[1], p1[0]), b = max3f(p0[2], p0[3], p1[1]); a = max3f(a, p1[2], p1[3]);
#pragma unroll
    for (int r = 4; r < 16; r += 4) { a = max3f(a, p0[r], p0[r + 1]); b = max3f(b, p0[r + 2], p0[r + 3]); a = max3f(a, p1[r], p1[r + 1]); b = max3f(b, p1[r + 2], p1[r + 3]); }
    a = fmaxf(a, b);
    return fmaxf(a, __shfl_xor(a, 32));
}
__device__ __forceinline__ s16x4 vtr(const LAS unsigned char* p) { typedef short v4i16_t __attribute__((ext_vector_type(4))); return __builtin_bit_cast(s16x4, __builtin_amdgcn_ds_read_tr16_b64_v4i16((LAS v4i16_t*)p)); }
__device__ __forceinline__ void v_load(const LAS unsigned char* vslot, int d0, bf16x8* vf, int lane, int hi) {
    const int q4 = (lane & 15) >> 2, p4 = lane & 3, g2 = (lane >> 4) & 1;
    const LAS unsigned char* vp = vslot + (4 * hi + q4) * 128 + ((((4 * d0 + 2 * g2 + (p4 >> 1)) ^ ((q4 >> 1) << 2))) << 4) + 8 * (p4 & 1);
#pragma unroll
    for (int i = 0; i < 4; ++i) {
        const s16x4 lo = vtr(vp + i * 2048), hh = vtr(vp + i * 2048 + 1024);
        vf[i] = (bf16x8){lo[0], lo[1], lo[2], lo[3], hh[0], hh[1], hh[2], hh[3]};
    }
    ATT_SB();
}
__device__ __forceinline__ void pack_p(const f32x16& p0, const f32x16& p1, bf16x8* pa) {
    float t[8];
#pragma unroll
    for (int i = 0; i < 8; ++i) t[i] = p0[i];
    pa[0] = pack_bf8(t);
#pragma unroll
    for (int i = 0; i < 8; ++i) t[i] = p0[8 + i];
    pa[1] = pack_bf8(t);
#pragma unroll
    for (int i = 0; i < 8; ++i) t[i] = p1[i];
    pa[2] = pack_bf8(t);
#pragma unroll
    for (int i = 0; i < 8; ++i) t[i] = p1[8 + i];
    pa[3] = pack_bf8(t);
}
__device__ __forceinline__ void pv_mma_packed(const LAS unsigned char* vslot, const bf16x8* vf0, const bf16x8* pa, f32x16* o, int lane, int hi) {
    bf16x8 vf1[4]; v_load(vslot, 1, vf1, lane, hi);
    __builtin_amdgcn_s_setprio(1);
#pragma unroll
    for (int ks = 0; ks < 4; ++ks) o[0] = __builtin_amdgcn_mfma_f32_32x32x16_bf16(vf0[ks], pa[ks], o[0], 0, 0, 0);
#pragma unroll
    for (int ks = 0; ks < 4; ++ks) o[1] = __builtin_amdgcn_mfma_f32_32x32x16_bf16(vf1[ks], pa[ks], o[1], 0, 0, 0);
    __builtin_amdgcn_s_setprio(0);
    ATT_SB();
}
__device__ __forceinline__ void pv_mma(const LAS unsigned char* vslot, const bf16x8* vf0, const f32x16& p0, const f32x16& p1, f32x16* o, int lane, int hi) {
    bf16x8 pa[4]; pack_p(p0, p1, pa); ATT_SB();
    pv_mma_packed(vslot, vf0, pa, o, lane, hi);
}
__device__ __forceinline__ float softmax_exp(f32x16& p0, f32x16& p1, float& mref, float& l, f32x16* o, bool has_o) {
    const float rm = row_max(p0, p1); float fac = 1.f;
    if (__any(rm > THR)) {
        const float d = fmaxf(rm, 0.f), alpha = __builtin_amdgcn_exp2f(-d); mref += d; l *= alpha; fac = alpha;
#pragma unroll
        for (int r = 0; r < 16; ++r) { p0[r] -= d; p1[r] -= d; }
        if (has_o) {
#pragma unroll
            for (int r = 0; r < 16; ++r) { o[0][r] *= alpha; o[1][r] *= alpha; }
        }
    }
#pragma unroll
    for (int r = 0; r < 16; ++r) { p0[r] = __builtin_amdgcn_exp2f(p0[r]); p1[r] = __builtin_amdgcn_exp2f(p1[r]); }
    return fac;
}
__device__ __forceinline__ void softmax_sum(const f32x16& p0, const f32x16& p1, float& l) {
    float s0 = 0.f, s1 = 0.f;
#pragma unroll
    for (int r = 0; r < 16; ++r) { s0 += p0[r]; s1 += p1[r]; }
    l += s0 + s1;
}
__device__ __forceinline__ float softmax_step(f32x16& p0, f32x16& p1, float& mref, float& l, f32x16* o, bool has_o) { const float f = softmax_exp(p0, p1, mref, l, o, has_o); softmax_sum(p0, p1, l); return f; }

__device__ __forceinline__ void attn_unit(Frame& F, const Args& A, int bg, int qt) {
    int lane = F.lane; asm volatile("" : "+v"(lane));
    const int b = bg >> 2, g = bg & 3, wid = F.wave, r32 = lane & 31, hi = lane >> 5;
    const int hh = wid & 3, qh = wid >> 2, head = g * 4 + hh;
    const int t0 = qt * 64, u = 32 * qh + r32, t = t0 + u; const size_t m = (size_t)b * SEQ + t;
    LAS unsigned char* lds = F.lds;
    const unsigned lds0 = (unsigned)(uintptr_t)lds;
    unsigned char* ws = F.ws;
    if (F.tid == 0) { *(LAS unsigned*)(lds + UNI_OFF) = 0u; *(LAS unsigned*)(lds + UNI_OFF + 4) = 0u; }
    const bf16* KCb = (const bf16*)(ws + WS_KC) + (size_t)bg * NCP * 64; const bf16* VCb = (const bf16*)(ws + WS_VC) + (size_t)bg * NCP * 64;
    const bf16* KVb = (const bf16*)(ws + WS_KVB) + (size_t)b * SEQ * KVW + g * 64;
    const int rowl = 8 * wid + (lane >> 3), kch = (lane & 7) ^ ((rowl >> 1) & 7), vch = (lane & 7) ^ (((rowl >> 1) & 1) << 2);
    const int kofC = rowl * 64 + kch * 8, vofC = rowl * 64 + vch * 8;
    const int kofT = rowl * KVW + kch * 8, vofT = rowl * KVW + vch * 8;
    const int nct = (((t0 + 32) >> 4) >> 6) + 1;
    const int jlast = qt >= 8 ? qt - 8 : 0, nw = qt - jlast + 1;
    const int sW = nct, sS = sW + nw;
    int total = sS;
    int ipos = 0;
    unsigned long long iss_uni = 0ull;
    const unsigned kdst = lds0 + wid * 1024, vdst = lds0 + 8192 + wid * 1024;
#define ATT_ISSUE() do { if (ipos < total) { const unsigned so = (unsigned)(ipos & (NSLOT - 1)) * SLOTB; \
        if (ipos < sW) { const int row = 64 * ipos; glds16(KCb + row * 64 + kofC, (unsigned)__builtin_amdgcn_readfirstlane(kdst + so)); glds16(VCb + row * 64 + vofC, (unsigned)__builtin_amdgcn_readfirstlane(vdst + so)); } \
        else { int j; const bf16* kb_; if (ipos < sS) { j = qt - (ipos - sW); kb_ = KVb + 4 * 256; } else { j = 63 - __builtin_clzll(iss_uni); iss_uni &= ~(1ull << j); kb_ = KVb + 2 * 256; } \
               const bf16* p_ = kb_ + (size_t)j * 64 * KVW; glds16(p_ + kofT, (unsigned)__builtin_amdgcn_readfirstlane(kdst + so)); glds16(p_ + 256 + vofT, (unsigned)__builtin_amdgcn_readfirstlane(vdst + so)); } \
        ++ipos; } } while (0)
#define ATT_STEP_END(cpos) do { const int ahead = ipos - (cpos) - 2; if (ahead >= 2) ATT_WAIT_BAR(4); else if (ahead == 1) ATT_WAIT_BAR(2); else ATT_WAIT_BAR(0); } while (0)
    ATT_ISSUE(); ATT_ISSUE();
    bf16x8 qf[4];
    {
        const bf16* qp = (const bf16*)(ws + WS_QB) + m * DM + head * 64 + 8 * hi; const float* qng = A.in[3] + 8 * hi;
        v4u w[4]; float ss = 0.f;
#pragma unroll
        for (int ks = 0; ks < 4; ++ks) { w[ks] = *(const v4u*)(qp + 16 * ks); float v[8]; unpack_bf8(w[ks], v);
#pragma unroll
            for (int e = 0; e < 8; ++e) ss += v[e] * v[e]; }
        ss += __shfl_xor(ss, 32);
        const float rs = C2 / sqrtf(ss * (1.f / 64) + EPS);
#pragma unroll
        for (int ks = 0; ks < 4; ++ks) { float v[8]; unpack_bf8(w[ks], v);
#pragma unroll
            for (int e = 0; e < 8; ++e) v[e] *= rs * qng[16 * ks + e];
            qf[ks] = pack_bf8(v); }
    }
    const float sl2 = exp2f(-0.5f * (float)(head + 1)) * LOG2E;
    const bf16* NGp = (const bf16*)(ws + WS_NG) + m * 48 + head * 3;
    const float gate_c = bf2f(NGp[0]), gate_s = bf2f(NGp[1]), gate_w = bf2f(NGp[2]);
    f32x16 o[2];
    unsigned oaccp[2][8];
#pragma unroll
    for (int i = 0; i < 8; ++i) { oaccp[0][i] = 0u; oaccp[1][i] = 0u; }
#define ATT_FOLD(sc_) do { _Pragma("unroll") for (int d_ = 0; d_ < 2; ++d_) _Pragma("unroll") for (int i_ = 0; i_ < 8; ++i_) { \
        const float a_ = bflo(oaccp[d_][i_]) + (sc_) * o[d_][2 * i_], b_ = bfhi(oaccp[d_][i_]) + (sc_) * o[d_][2 * i_ + 1]; oaccp[d_][i_] = cvtpk(a_, b_); } } while (0)
    ATT_WAIT_BAR(0);
    int cpos = 0;
#if PROBE_ID
    unsigned* pc = (unsigned*)(ws + WS_CTL) + 8192; unsigned long long ts0 = __builtin_amdgcn_s_memtime();
#define PROBE_MARK(k) do { const unsigned long long ts1 = __builtin_amdgcn_s_memtime(); if (F.tid == 0) atomicAdd(pc + (k), (unsigned)((ts1 - ts0) >> 4)); ts0 = ts1; } while (0)
#else
#define PROBE_MARK(k) do {} while (0)
#endif
#define ATT_K(cpos) (lds + (unsigned)((cpos) & (NSLOT - 1)) * SLOTB)
#define ATT_V(cpos) (lds + (unsigned)((cpos) & (NSLOT - 1)) * SLOTB + 8192)
    {
        const int nmax = (t - 31) >> 4;
        float mref = MREF0, l = 0.f, mk[4] = {0.f, 0.f, 0.f, 0.f};
#pragma unroll
        for (int r = 0; r < 16; ++r) { o[0][r] = 0.f; o[1][r] = 0.f; }
        LAS _Float16* impw = (LAS _Float16*)(lds + IMP_OFF) + (hh * 64 + u) * IMP_LD;
        float ecarry = 0.f;
#pragma unroll
        for (int kt = 0; kt < 4; ++kt) {
            if (kt < nct) {
                ATT_ISSUE();
                f32x16 p0, p1;
                qk_tile(ATT_K(cpos), qf, sl2 * 16.f, sl2 * (float)(1024 * kt + 31 - t0) - mref, p0, p1, r32, hi);
                bf16x8 vf[4]; v_load(ATT_V(cpos), 0, vf, lane, hi);
                mask_tile<true>(p0, p1, nmax - 64 * kt, hi);
                ecarry *= softmax_step(p0, p1, mref, l, o, true);
                mk[kt] = mref;
                float Eo[2][4];
#pragma unroll
                for (int a4 = 0; a4 < 4; ++a4) { Eo[0][a4] = __shfl_xor(p0[4 * a4 + 3], 32); Eo[1][a4] = __shfl_xor(p1[4 * a4 + 3], 32); }
#pragma unroll
                for (int s = 0; s < 2; ++s)
#pragma unroll
                    for (int a4 = 0; a4 < 4; ++a4) {
                        const float G = s == 0 ? (p0[4 * a4] + p0[4 * a4 + 1]) + (p0[4 * a4 + 2] + p0[4 * a4 + 3]) : (p1[4 * a4] + p1[4 * a4 + 1]) + (p1[4 * a4 + 2] + p1[4 * a4 + 3]);
                        const float prev = a4 >= 1 ? Eo[s][a4 - 1] : (s == 1 ? Eo[0][3] : ecarry);
                        impw[16 * kt + 8 * s + 2 * a4 + hi] = (_Float16)(G + (hi ? Eo[s][a4] : prev));
                    }
                ecarry = Eo[1][3];
                pv_mma(ATT_V(cpos), vf, p0, p1, o, lane, hi);
                ATT_STEP_END(cpos); ++cpos;
            }
        }
        l += __shfl_xor(l, 32);
        const float inv = l > 0.f ? 1.0f / l : 0.f;
        if (hi == 0) { f32x4 sc; sc[0] = __builtin_amdgcn_exp2f(mk[0] - mref) * inv; sc[1] = __builtin_amdgcn_exp2f(mk[1] - mref) * inv; sc[2] = __builtin_amdgcn_exp2f(mk[2] - mref) * inv; sc[3] = __builtin_amdgcn_exp2f(mk[3] - mref) * inv;
            *(LAS f32x4*)(lds + SC_OFF + (hh * 64 + u) * 16) = sc; }
        const float gsc = gate_c * inv;
        ATT_FOLD(gsc);
        asm volatile("s_waitcnt lgkmcnt(0)\n\ts_barrier" ::: "memory");
    }
    PROBE_MARK(0);
    {
        const int q = lane >> 3, kg = lane & 7, uq = 8 * wid + q, tq = t0 + uq;
        float v[8];
#pragma unroll
        for (int i = 0; i < 8; ++i) v[i] = 0.f;
#pragma unroll
        for (int h4 = 0; h4 < 4; ++h4) { typedef _Float16 h8 __attribute__((ext_vector_type(8)));
            const h8 x = *(const LAS h8*)(lds + IMP_OFF + ((h4 * 64 + uq) * IMP_LD + 8 * kg) * 2);
            const float sc = *(const LAS float*)(lds + SC_OFF + (h4 * 64 + uq) * 16 + 4 * (kg >> 1));
#pragma unroll
            for (int i = 0; i < 8; ++i) v[i] += (float)x[i] * sc; }
        unsigned key[8];
#pragma unroll
        for (int i = 0; i < 8; ++i) { const int j = 8 * kg + i; const bool valid = (64 * j <= tq), forced = (j == 0) || (j == qt) || (j == qt - 1);
            const float val = v[i] + (forced ? 1e4f : 0.f);
            key[i] = valid ? (((__float_as_uint(val) >> 16) << 6) | (unsigned)(63 - j)) : 0u; }
        unsigned thr = 0u;
#pragma unroll 1
        for (int bit = 20; bit >= 0; --bit) {
            const unsigned cand = thr | (1u << bit); int c = 0;
#pragma unroll
            for (int i = 0; i < 8; ++i) c += (key[i] >= cand) ? 1 : 0;
            c += __builtin_amdgcn_update_dpp(0, c, 0xB1, 0xF, 0xF, true);
            c += __builtin_amdgcn_update_dpp(0, c, 0x4E, 0xF, 0xF, true);
            c += __builtin_amdgcn_update_dpp(0, c, 0x141, 0xF, 0xF, true);
            thr = c >= 16 ? cand : thr;
        }
        unsigned m8 = 0u;
#pragma unroll
        for (int i = 0; i < 8; ++i) m8 |= ((key[i] != 0u && key[i] >= thr) ? 1u : 0u) << i;
        *(LAS unsigned char*)(lds + MSK_OFF + 8 * uq + kg) = (unsigned char)m8;
        __hip_atomic_fetch_or((LAS unsigned*)(lds + UNI_OFF + 4 * (kg >> 2)), m8 << (8 * (kg & 3)), __ATOMIC_RELAXED, __HIP_MEMORY_SCOPE_WORKGROUP);
        asm volatile("s_waitcnt lgkmcnt(0)\n\ts_barrier" ::: "memory");
    }
    const unsigned mlo = *(const LAS unsigned*)(lds + MSK_OFF + 8 * u), mhi = *(const LAS unsigned*)(lds + MSK_OFF + 8 * u + 4);
    const unsigned long long mymask = ((unsigned long long)mhi << 32) | mlo;
    unsigned long long cmp_uni = ((unsigned long long)(unsigned)__builtin_amdgcn_readfirstlane((int)*(const LAS unsigned*)(lds + UNI_OFF + 4)) << 32) | (unsigned)__builtin_amdgcn_readfirstlane((int)*(const LAS unsigned*)(lds + UNI_OFF));
    iss_uni = cmp_uni; total = sS + __builtin_popcountll(cmp_uni);
    PROBE_MARK(1);
#if PROBE_ID
    if (F.tid == 0) { atomicAdd(pc + 4, (unsigned)__builtin_popcountll(cmp_uni)); atomicAdd(pc + 5, (unsigned)(2 * nct + nw)); }
#endif
#define ATT_WS_LOOP(DEFER) { \
        float mref = MREF0, l = 0.f; \
        _Pragma("unroll") for (int r = 0; r < 16; ++r) { o[0][r] = 0.f; o[1][r] = 0.f; } \
        bf16x8 pa[4]; \
        const int nsteps = nw + __builtin_popcountll(cmp_uni); \
        for (int st = 0; st < nsteps; ++st, ++cpos) { \
            int j; bool win; \
            if (st < nw) { j = qt - st; win = true; } else { j = 63 - __builtin_clzll(cmp_uni); cmp_uni &= ~(1ull << j); win = false; } \
            if (DEFER && st > 0) { bf16x8 vf[4]; v_load(ATT_V(cpos - 1), 0, vf, lane, hi); pv_mma_packed(ATT_V(cpos - 1), vf, pa, o, lane, hi); } \
            if (st == nw) { \
                PROBE_MARK(2); \
                l += __shfl_xor(l, 32); \
                const float sc = l > 0.f ? gate_w / l : 0.f; \
                ATT_FOLD(sc); \
                _Pragma("unroll") for (int r = 0; r < 16; ++r) { o[0][r] = 0.f; o[1][r] = 0.f; } \
                mref = MREF0; l = 0.f; \
            } \
            ATT_ISSUE(); \
            f32x16 p0, p1; \
            const float selb = (win || ((mymask >> j) & 1ull)) ? 0.f : NEGBIG; \
            qk_tile(ATT_K(cpos), qf, sl2, sl2 * (float)(64 * j - t0) - mref + selb, p0, p1, r32, hi); \
            if (!DEFER) { \
                bf16x8 vf[4]; v_load(ATT_V(cpos), 0, vf, lane, hi); \
                if (j == qt) mask_tile<true>(p0, p1, u, hi); \
                if (win && j == qt - 8) mask_tile<false>(p0, p1, u + 1, hi); \
                softmax_step(p0, p1, mref, l, o, true); \
                pv_mma(ATT_V(cpos), vf, p0, p1, o, lane, hi); \
            } else { \
                if (j == qt) mask_tile<true>(p0, p1, u, hi); \
                if (win && j == qt - 8) mask_tile<false>(p0, p1, u + 1, hi); \
                softmax_step(p0, p1, mref, l, o, true); \
                pack_p(p0, p1, pa); \
            } \
            ATT_STEP_END(cpos); \
        } \
        if (DEFER) { bf16x8 vf[4]; v_load(ATT_V(cpos - 1), 0, vf, lane, hi); pv_mma_packed(ATT_V(cpos - 1), vf, pa, o, lane, hi); } \
        l += __shfl_xor(l, 32); \
        const float sc = l > 0.f ? gate_s / l : 0.f; \
        ATT_FOLD(sc); \
    }
    if (F.grp != 0) ATT_WS_LOOP(true) else ATT_WS_LOOP(false)
#undef ATT_WS_LOOP
    PROBE_MARK(3);
    bf16* op = (bf16*)(ws + WS_QB) + m * DM + head * 64 + 4 * hi;
#pragma unroll
    for (int d0 = 0; d0 < 2; ++d0)
#pragma unroll
        for (int a = 0; a < 4; ++a) { v2u pk; pk.x = oaccp[d0][2 * a]; pk.y = oaccp[d0][2 * a + 1]; *(v2u*)(op + 32 * d0 + 8 * a) = pk; }
#undef ATT_FOLD
#undef ATT_ISSUE
#undef ATT_STEP_END
#undef ATT_K
#undef ATT_V
}
#undef ATT_WAIT_BAR
#undef ATT_WAIT_BAR_NOVM
#undef ATT_SB
}

__device__ __forceinline__ void phase3(Frame& F, const Args& A) {
    for (int it = F.vcu; it < 256; it += F.G) lru_pass2(F, A, it);
#if FAST_ATTN
    __syncthreads();
    {
        const bool lab8 = (F.G % 8) == 0; const int nq = lab8 ? 8 : 1, lab = lab8 ? (int)(blockIdx.x & 7) : 0, per = 1024 / nq;
        unsigned* head = (unsigned*)(F.ws + WS_CTL) + CW_QUEUE + 64 * lab;
        volatile LAS unsigned* slotw = (volatile LAS unsigned*)(F.lds + MISC_OFF + 96);
        PIN(PIN_ATT);
        for (;;) {
            if (F.tid == 0) *slotw = __hip_atomic_fetch_add(head, 1u, __ATOMIC_RELAXED, __HIP_MEMORY_SCOPE_AGENT);
            __syncthreads();
            const int i = (int)*slotw;
            __syncthreads();
            if (i >= per) break;
            const int nbg = 16 / nq, bg = lab * nbg + (i % nbg), qt = 63 - i / nbg;
            att::attn_unit(F, A, bg, qt);
            __syncthreads();
        }
    }
#endif
}
constexpr int N_PHASES = 8;

__global__ void __launch_bounds__(NWAVES * 64, 2) fwd_kernel(Args args) {
    extern __shared__ __attribute__((aligned(16))) unsigned char lds[];
    Frame F;
    F.lds = (LAS unsigned char*)lds;
    F.MISC = (volatile LAS unsigned*)(F.lds + MISC_OFF);
    F.tid = threadIdx.x; F.lane = F.tid & 63; F.wave = __builtin_amdgcn_readfirstlane(F.tid >> 6);
    F.G = gridDim.x; { const int bx = blockIdx.x; F.vcu = (F.G % 8 == 0) ? (bx % 8) * (F.G / 8) + bx / 8 : bx; }
    F.out = args.out; F.ws = args.ws; unsigned char* ws = args.ws;
    F.ctl = (gu32*)(ws + WS_CTL);
    for (int u = F.tid; u < (LDS_BYTES - LDSCTL_OFF) / 4; u += NWAVES * 64) ((LAS unsigned*)(F.lds + LDSCTL_OFF))[u] = 0u;
    __syncthreads();
    { const unsigned simd = ((unsigned)__builtin_amdgcn_s_getreg((1 << 11) | (4 << 6) | 4)) & 3u;
      int slot = 0; if (F.lane == 0) slot = (int)__hip_atomic_fetch_add((LAS unsigned*)(F.lds + MISC_OFF + 64 + 4 * simd), 1u, __ATOMIC_RELAXED, __HIP_MEMORY_SCOPE_WORKGROUP);
      F.grp = __builtin_amdgcn_readfirstlane(slot) & 1; }
    const int lo = args.ph_lo, hi = args.ph_hi;
    const bool multi = (hi - lo) > 1;
    XcdBarrier bar; bar.bar = (unsigned*)(F.ctl + CW_BAR); bar.x = 0; bar.st = nullptr;
    if (multi) bar = xcd_barrier_post((unsigned*)(F.ctl + CW_BAR), F.MISC + 8);
    unsigned* labw = (unsigned*)(F.ctl + CW_LAB) + 64 * (blockIdx.x & 7);
    if (multi && F.tid == 0) (void)__hip_atomic_fetch_or(labw + 16, 1u << xb_xcc_id(), __ATOMIC_RELAXED, __HIP_MEMORY_SCOPE_AGENT);
    bool lab_local = false;
#ifdef ONLY
#define IN(k) ((k) == ONLY && lo <= (k) && (k) < hi)
#else
#define IN(k) (lo <= (k) && (k) < hi)
#endif
#if PROBE_ID >= 10
#define STAMP(k) do { if (blockIdx.x == 0 && F.tid == 0) F.MISC[12 + (k)] = (unsigned)__builtin_amdgcn_s_memrealtime(); } while (0)
#else
#define STAMP(k) do {} while (0)
#endif
#define SEAM_L(k) do { if (IN(k) && IN((k) + 1)) { if (lab_local) label_barrier(labw, 32u, bar.bar); else xcd_barrier(bar); } STAMP((k) + 1); } while (0)
#define SEAM(k) do { if (IN(k) && IN((k) + 1)) xcd_barrier(bar); STAMP((k) + 1); } while (0)
    using namespace pg8;
    PG8_LAS unsigned char* ring = (PG8_LAS unsigned char*)lds;

#ifndef REP_PHASE
#define REP_PHASE -1
#endif
#define NREP(k) ((k) == REP_PHASE ? 2 : 1)
    STAMP(0);
    if (IN(0)) { p0_prologue<false>(F, args); SEAM(0); }

    if (IN(1)) {
        Gemm g{2 * DM, 128, 2 * DM, 128, DM / 64};
        SchedSimple S; S.T.init(M_ROWS, NPROJ, F.G, (int)blockIdx.x); S.A = (const char*)(ws + WS_XB); S.B = (const char*)(ws + WS_WIN); S.tA = (size_t)256 * 2 * DM; S.tB = (size_t)256 * 2 * DM;
        EpiProj E{(const float*)(ws + WS_RSTD1), (bf16_t*)(ws + WS_QB), (bf16_t*)(ws + WS_KVB), (bf16_t*)(ws + WS_NG), (bf16_t*)(ws + WS_LX), (bf16_t*)(ws + WS_LGG), (bf16_t*)F.out};
        gemm_phase<EpiProj, SchedSimple, GEMM_ALIGN_P1>(ring, g, S, E);
        {
            const int nwg = S.T.nwg, G = F.G, rem = nwg % G, c = (int)blockIdx.x;
            if (rem == 0) p0_prologue<true>(F, args, c, G);
            else if (c >= rem) p0_prologue<true>(F, args, c - rem, G - rem);
        }
        SEAM(1);
    }
    if (IN(2)) { PIN(38); phase2(F, args); SEAM(2); }
    if (IN(3)) { PIN(53); phase3(F, args); SEAM(3); }
    if (multi && F.G == 256) {
        bool ok = true;
#pragma unroll
        for (int j = 0; j < 8; ++j) { const unsigned mk = xb_ld((unsigned*)(F.ctl + CW_LAB) + 64 * j + 16); ok = ok && (mk != 0u) && ((mk & (mk - 1u)) == 0u); }
        lab_local = __builtin_amdgcn_readfirstlane((int)ok) != 0;
    }
    if (IN(4)) { PIN(55);
        Gemm g{2 * DM, 128, 2 * DM, 128, DM / 64};
        SchedMerge S; S.T.init(M_ROWS, DM, F.G, (int)blockIdx.x); S.A0 = (const char*)(ws + WS_QB); S.A1 = (const char*)(ws + WS_LGG); S.B0 = (const char*)(ws + WS_WOA); S.B1 = (const char*)(ws + WS_WOL);
        S.tA = (size_t)256 * 2 * DM; S.tB = (size_t)256 * 2 * DM;
        EpiMerge E{(const bf16_t*)F.out, (bf16_t*)(ws + WS_LX)};
        for (int rep = 0; rep < NREP(4); ++rep) gemm_phase<EpiMerge, SchedMerge>(ring, g, S, E);
        STAMP(5);
    }
    if (IN(5)) { PIN(54);
        Gemm g{2 * DM, 128, 2 * DM, 128, DM / 64};
        SchedSimple S; S.T.init(M_ROWS, DM, F.G, (int)blockIdx.x); S.A = (const char*)(ws + WS_LX); S.B = (const char*)(ws + WS_WOUT); S.tA = (size_t)256 * 2 * DM; S.tB = (size_t)256 * 2 * DM;
        EpiWout E{args.in[0], F.out, (bf16_t*)(ws + WS_XB), (float*)(ws + WS_SSQ)};
        LabelSeam sm{IN(4) && IN(5), lab_local, labw, 32u, bar};
        gemm_phase<EpiWout, SchedSimple, true, LabelSeam>(ring, g, S, E, sm);
        SEAM_L(5);
    }
    if (IN(6)) { PIN(33);
        Gemm g{2 * DM, 128, 2 * DM, 128, DM / 64};
        SchedHalfTail S; S.T.init(M_ROWS, NGU, F.G, (int)blockIdx.x); S.A = (const char*)(ws + WS_XB); S.B = (const char*)(ws + WS_WGU); S.tA = (size_t)256 * 2 * DM; S.tB = (size_t)256 * 2 * DM;
        S.full = (F.G % 8 == 0 && 2 * (S.T.nwg % F.G) <= F.G) ? S.T.nwg / F.G : (S.T.nwg + F.G - 1) / F.G;
        EpiGU E{(const float*)(ws + WS_SSQ), (bf16_t*)(ws + WS_FF)};
        for (int rep = 0; rep < NREP(6); ++rep) gemm_phase<EpiGU, SchedHalfTail, GEMM_ALIGN_P6>(ring, g, S, E);
        SEAM_L(6);
    }
    if (IN(7)) { PIN(39);
        Gemm g{2 * DFF, 128, 2 * DFF, 128, DFF / 64};
        SchedSimple S; S.T.init(M_ROWS, DM, F.G, (int)blockIdx.x); S.A = (const char*)(ws + WS_FF); S.B = (const char*)(ws + WS_WDN); S.tA = (size_t)256 * 2 * DFF; S.tB = (size_t)256 * 2 * DFF;
        EpiDown E{F.out, (const bf16_t*)(ws + WS_XB)};
        gemm_phase<EpiDown, SchedSimple>(ring, g, S, E);
#if PROBE_ID
        const unsigned now_ = (unsigned)__builtin_amdgcn_s_memrealtime();
        xcd_barrier(bar);
        if (blockIdx.x == 0 && F.tid == 0) { const unsigned* pc = (const unsigned*)(ws + WS_CTL) + 8192; float v = 0.f;
            const float c0 = (float)__hip_atomic_load(pc + 0, RLX_AGENT), c1 = (float)__hip_atomic_load(pc + 1, RLX_AGENT), c2 = (float)__hip_atomic_load(pc + 2, RLX_AGENT), c3 = (float)__hip_atomic_load(pc + 3, RLX_AGENT);
            const float c4 = (float)__hip_atomic_load(pc + 4, RLX_AGENT), c5 = (float)__hip_atomic_load(pc + 5, RLX_AGENT);
            if (PROBE_ID == 30) v = lab_local ? 64.f : 32.f;
            if (PROBE_ID == 1) v = c4 / 1024.f;
            if (PROBE_ID == 2) v = 100.f * c0 / (c0 + c1 + c2 + c3);
            if (PROBE_ID == 3) v = 100.f * c1 / (c0 + c1 + c2 + c3);
            if (PROBE_ID == 4) v = 100.f * c2 / (c0 + c1 + c2 + c3);
            if (PROBE_ID == 5) v = 100.f * c3 / (c0 + c1 + c2 + c3);
            if (PROBE_ID == 6) v = 16.f * (c0 + c2 + c3) / (c4 + c5) / 100.f;
            if (PROBE_ID == 7) v = 16.f * c1 / 1024.f / 100.f;
            if (PROBE_ID >= 20 && PROBE_ID < 27) { float tot = 0.f, mine = 0.f;
                for (int i = 0; i < 7; ++i) { const float ci = (float)__hip_atomic_load(pc + 8 + i, RLX_AGENT); tot += ci; if (i == PROBE_ID - 20) mine = ci; }
                v = 100.f * mine / tot; }
            if (PROBE_ID >= 10 && PROBE_ID < 18) { const unsigned now = now_; const int k = PROBE_ID - 10;
                const unsigned t1 = k == 7 ? now : F.MISC[12 + k + 1], t0_ = F.MISC[12 + k]; v = (float)(t1 - t0_) * 0.01f; if (PROBE_ID == 10 || PROBE_ID == 16) v = 10.f + floorf(v / 20.f); if (PROBE_ID == 13) v = floorf(v * 0.5f) - 80.f; if (PROBE_ID == 14) v = 2.f * floorf(v * 0.5f); if (PROBE_ID == 11) v = 2.f * floorf((v - 150.f) * 0.5f); if (PROBE_ID == 15) v = 2.f * floorf(v * 0.5f); }
            const float y0 = __hip_atomic_load(F.out, RLX_AGENT); F.out[0] = y0 + v; }
#endif
    }
#undef IN
#undef SEAM
}

extern "C" void kernel_launch(void* const* d_in, const int* in_sizes, int n_in, void* d_out, int out_size, void* d_ws, size_t ws_size, hipStream_t stream) {
    static int grid = 0;
    if (grid == 0) {
        if (n_in != 29 || out_size != M_ROWS * DM || ws_size < WS_END) { fprintf(stderr, "kernel_launch: unexpected problem (n_in %d, out %d, ws %zu)\n", n_in, out_size, ws_size); grid = -1; return; }
        int dev = 0, cus = 0, per_cu = 0;
        if (hipGetDevice(&dev) != hipSuccess || hipDeviceGetAttribute(&cus, hipDeviceAttributeMultiprocessorCount, dev) != hipSuccess) { grid = -1; return; }
        if (hipFuncSetAttribute((const void*)fwd_kernel, hipFuncAttributeMaxDynamicSharedMemorySize, LDS_BYTES) != hipSuccess) { fprintf(stderr, "kernel_launch: hipFuncSetAttribute failed\n"); grid = -1; return; }
        if (hipOccupancyMaxActiveBlocksPerMultiprocessor(&per_cu, (const void*)fwd_kernel, NWAVES * 64, LDS_BYTES) != hipSuccess || per_cu < 1) { fprintf(stderr, "kernel_launch: occupancy query says %d blocks per CU\n", per_cu); grid = -1; return; }
        (void)hipGetLastError();
        grid = cus;
        if (grid > 256) grid = 256;
    }
    if (grid < 0) return;
    (void)hipMemsetAsync((char*)d_ws + WS_CTL, 0, CTL_ZERO_BYTES, stream);
    Args a{};
    for (int i = 0; i < 29; ++i) a.in[i] = (const float*)d_in[i];
    a.out = (float*)d_out; a.ws = (unsigned char*)d_ws;
#if N_LAUNCHES == 1
    a.ph_lo = 0; a.ph_hi = N_PHASES;
    hipLaunchKernelGGL(fwd_kernel, dim3(grid), dim3(NWAVES * 64), LDS_BYTES, stream, a);
#else
    for (int p = 0; p < N_PHASES; ++p) {
        a.ph_lo = p; a.ph_hi = p + 1;
        hipLaunchKernelGGL(fwd_kernel, dim3(grid), dim3(NWAVES * 64), LDS_BYTES, stream, a);
    }
#endif
}
```

```cpp
#include <hip/hip_runtime.h>
#include <cstdio>
#include <cstdint>
#ifndef N_LAUNCHES
#define N_LAUNCHES 1
#endif
#define NAIVE_P2 0
#define NAIVE_ATTN 0
#define FAST_ATTN 1
#define USE_NAIVE 0
#ifndef REP_PHASE
#define REP_PHASE -1
#endif
#ifndef PROBE_ID
#define PROBE_ID 0
#endif
#ifndef GEMM_ALIGN_P1
#define GEMM_ALIGN_P1 true
#endif
#ifndef GEMM_ALIGN_P6
#define GEMM_ALIGN_P6 true
#endif
#define PIN_(n) asm volatile(".p2align 8\n\t.fill " #n ", 4, 0xBF800000" ::: "memory")
#define PIN(n) PIN_(n)
#ifndef PIN_ATT
#define PIN_ATT 48
#endif
namespace pg8 {
#define PG8_LAS __attribute__((address_space(3)))
typedef unsigned short bf16_t;
typedef short bf16x8 __attribute__((ext_vector_type(8)));
typedef float f32x4 __attribute__((ext_vector_type(4)));
typedef float f32x2 __attribute__((ext_vector_type(2)));
typedef unsigned u32x4 __attribute__((ext_vector_type(4)));
typedef unsigned u32x2 __attribute__((ext_vector_type(2)));
constexpr int BM = 256, BK = 64, HALF = 128, HTB = HALF * BK * 2  , STAGE_BYTES = 8 * HTB, NXCD = 8, WGM = 8;

__host__ __device__ __forceinline__ int lds_byte(int r, int c) { const int st = (r >> 4) * 2 + (c >> 5), rr = r & 15, cc = c & 31, ob = rr * 64 + cc * 2; return st * 1024 + (ob ^ (((ob >> 9) & 1) << 5)); }
__host__ __device__ __forceinline__ void stage_rc(int b, int& R, int& C) { const int st = b / 1024, sb = b % 1024, swz = sb ^ (((sb >> 9) & 1) << 5); R = (st >> 1) * 16 + swz / 64; C = (st & 1) * 32 + (swz % 64) / 2; }
__host__ __device__ __forceinline__ int perm32(int rho) { const int n = rho >> 4, i = rho & 15; return 8 * (i >> 2) + 4 * n + (i & 3); }

struct Unit { int pm, pn, kind, r0, half; };
struct Gemm { int rowA, kstepA, rowB, kstepB, nt; };

struct TileOrder {
    int nM, nN, nwg, G, c;
    __device__ void init(int M, int N, int G_, int c_) { nM = M / BM; nN = N / BM; nwg = nM * nN; G = G_; c = c_; }
    __device__ bool tile(int i, int& pm, int& pn) const { return tileL((long)i * G + c, pm, pn); }
    __device__ bool tileL(long L, int& pm, int& pn) const {
        if (L >= nwg) return false;
        int wgid = (int)L; { const int q = nwg / NXCD, r = nwg % NXCD, xcd = wgid % NXCD, off = wgid / NXCD; wgid = (xcd < r ? xcd * (q + 1) : r * (q + 1) + (xcd - r) * q) + off; }
        const int nig = WGM * nN, gid = wgid / nig, fm = gid * WGM, gsz = (nM - fm) < WGM ? (nM - fm) : WGM;
        pm = fm + ((wgid % nig) % gsz); pn = (wgid % nig) / gsz; return true;
    }
};

__device__ __forceinline__ unsigned cvt_pk_bf16(float lo, float hi) { unsigned r; asm volatile("v_cvt_pk_bf16_f32 %0, %1, %2" : "=v"(r) : "v"(lo), "v"(hi)); return r; }

struct NoSeam { static constexpr bool ACTIVE = false; };
template <class Epi, class Sched, bool ALIGN_EPI = true, class Seam = NoSeam>
__device__ __forceinline__ void gemm_phase(PG8_LAS unsigned char* lds, const Gemm g, const Sched& S, const Epi& E, const Seam seam = Seam()) {
    const int tid = threadIdx.x, wid = __builtin_amdgcn_readfirstlane(tid >> 6), lane = tid & 63, wr = wid >> 2, wc = wid & 3, fr = lane & 15, fq = lane >> 4;
    const int nt = g.nt;
    unsigned voffA[2], voffB[2];
#pragma unroll
    for (int i = 0; i < 2; ++i) { int R, C; stage_rc(tid * 16 + i * 8192, R, C); const int Rb = Epi::PERM ? ((R & ~31) + perm32(R & 31)) : R;
        voffA[i] = (unsigned)(R * g.rowA + C * 2); voffB[i] = (unsigned)(Rb * g.rowB + C * 2); }
    const size_t kstepA = (size_t)g.kstepA, kstepB = (size_t)g.kstepB;
    const size_t hstepA = (size_t)HALF * g.rowA, hstepB = (size_t)HALF * g.rowB;
    const unsigned ldsw = (unsigned)wid * 1024u;
    const int aoff = lds_byte(wr * 64 + fr, fq * 8), boff = lds_byte(wc * 32 + fr, fq * 8);
#define PG8_SA(b, h) (((b) * 2 + (h)) * HTB)
#define PG8_SB(b, h) ((4 + (b) * 2 + (h)) * HTB)
#define PG8_STAGE(bufoff, gbase, voff) do { _Pragma("unroll") for (int _i = 0; _i < 2; ++_i) \
        __builtin_amdgcn_global_load_lds((const unsigned*)((const char*)(gbase) + (voff)[_i]), (PG8_LAS unsigned*)(lds + (bufoff) + ldsw + _i * 8192), 16, 0, 0); } while (0)
#define PG8_LDA(dst, b, h) do { _Pragma("unroll") for (int m = 0; m < 4; ++m) _Pragma("unroll") for (int k = 0; k < 2; ++k) dst[m][k] = *(const PG8_LAS bf16x8*)(lds + PG8_SA(b, h) + aoff + m * 2048 + k * 1024); } while (0)
#define PG8_LDB(dst, b, h) do { _Pragma("unroll") for (int n = 0; n < 2; ++n) _Pragma("unroll") for (int k = 0; k < 2; ++k) dst[n][k] = *(const PG8_LAS bf16x8*)(lds + PG8_SB(b, h) + boff + n * 2048 + k * 1024); } while (0)
#define PG8_MMA(ai, bj, At, Bt) do { __builtin_amdgcn_s_setprio(1); _Pragma("unroll") for (int m = 0; m < 4; ++m) _Pragma("unroll") for (int n = 0; n < 2; ++n) _Pragma("unroll") for (int k = 0; k < 2; ++k) \
        acc[ai][bj][m][n] = __builtin_amdgcn_mfma_f32_16x16x32_bf16(Bt[n][k], At[m][k], acc[ai][bj][m][n], 0, 0, 0); __builtin_amdgcn_s_setprio(0); } while (0)
#define PG8_WAIT_V(n) asm volatile("s_waitcnt vmcnt(" #n ")" ::: "memory")
#define PG8_WAIT_L(n) asm volatile("s_waitcnt lgkmcnt(" #n ")" ::: "memory")
#define PG8_BAR __builtin_amdgcn_s_barrier()
#define PG8_SCHED __builtin_amdgcn_sched_barrier(0)
    Unit cur, nxt; int ui = 0;
    const bool has0 = S.next(0, cur);
    f32x4 acc[2][2][4][2];
    if constexpr (Seam::ACTIVE) {
        typename Epi::Pre pre;
        if (seam.early()) { seam.enter(); if (has0) E.init_issue(acc, pre, cur, wr, wc, fr, fq); seam.finish(); }
        else { seam.full(); if (has0) E.init_issue(acc, pre, cur, wr, wc, fr, fq); }
        if (!has0) return;
        E.init_finish(acc, pre);
    } else {
        if (!has0) return;
#pragma unroll
        for (int a = 0; a < 2; ++a)
#pragma unroll
            for (int b = 0; b < 2; ++b)
#pragma unroll
                for (int m = 0; m < 4; ++m)
#pragma unroll
                    for (int n = 0; n < 2; ++n) acc[a][b][m][n] = (f32x4){0.f, 0.f, 0.f, 0.f};
    }
    bf16x8 At[4][2], B0[2][2], B1[2][2];
    const char* cA = S.abase(cur); const char* cB = S.bbase(cur);
    PG8_STAGE(PG8_SB(0, 0), cB, voffB); PG8_STAGE(PG8_SB(0, 1), cB + hstepB, voffB); PG8_STAGE(PG8_SA(0, 0), cA, voffA); PG8_STAGE(PG8_SA(0, 1), cA + hstepA, voffA);
    if (wr == 1) PG8_BAR;
    PG8_WAIT_V(2); PG8_BAR;
    PG8_STAGE(PG8_SB(1, 0), cB + kstepB, voffB); PG8_STAGE(PG8_SA(1, 0), cA + kstepA, voffA); PG8_STAGE(PG8_SB(1, 1), cB + hstepB + kstepB, voffB);
    PG8_WAIT_V(6); PG8_BAR;
    for (;;) {
        const bool has_next = S.next(ui + 1, nxt);
        const char* nA = has_next ? S.abase(nxt) : cA; const char* nB = has_next ? S.bbase(nxt) : cB;
        asm volatile(".p2align 8\n\ts_nop 0\n\ts_nop 0\n\ts_nop 0\n\ts_nop 0\n\ts_nop 0\n\ts_nop 0");
        for (int t = 0; t < nt; t += 2) {
            const bool last = (t == nt - 2);
            const char* a1 = cA + (size_t)(t + 1) * kstepA;
            const char* a2 = last ? nA : cA + (size_t)(t + 2) * kstepA; const char* b2 = last ? nB : cB + (size_t)(t + 2) * kstepB;
            const char* a3 = a2 + kstepA; const char* b3 = b2 + kstepB;
            PG8_LDB(B0, 0, 0); PG8_LDB(B1, 0, 1); PG8_SCHED; PG8_LDA(At, 0, 0); PG8_STAGE(PG8_SA(1, 1), a1 + hstepA, voffA);
            PG8_WAIT_V(8); PG8_WAIT_L(0); PG8_BAR; PG8_MMA(0, 0, At, B0); PG8_MMA(0, 1, At, B1); PG8_BAR; PG8_SCHED;
            PG8_LDA(At, 0, 1); PG8_STAGE(PG8_SB(0, 0), b2, voffB); PG8_STAGE(PG8_SB(0, 1), b2 + hstepB, voffB); PG8_STAGE(PG8_SA(0, 0), a2, voffA);
            PG8_WAIT_V(8); PG8_WAIT_L(0); PG8_BAR; if (!cur.half) { PG8_MMA(1, 0, At, B0); PG8_MMA(1, 1, At, B1); } PG8_BAR; PG8_SCHED;
            PG8_LDB(B0, 1, 0); PG8_LDB(B1, 1, 1); PG8_SCHED; PG8_LDA(At, 1, 0); PG8_STAGE(PG8_SA(0, 1), a2 + hstepA, voffA);
            PG8_WAIT_V(8); PG8_WAIT_L(0); PG8_BAR; PG8_MMA(0, 0, At, B0); PG8_MMA(0, 1, At, B1); PG8_BAR; PG8_SCHED;
            PG8_LDA(At, 1, 1); PG8_STAGE(PG8_SB(1, 0), b3, voffB); PG8_STAGE(PG8_SB(1, 1), b3 + hstepB, voffB); PG8_STAGE(PG8_SA(1, 0), a3, voffA);
            PG8_WAIT_V(8); PG8_WAIT_L(0); PG8_BAR; if (!cur.half) { PG8_MMA(1, 0, At, B0); PG8_MMA(1, 1, At, B1); } PG8_BAR; PG8_SCHED;
        }
        if constexpr (ALIGN_EPI) { if (wr == 0) PG8_BAR; }
        const bool keep = E(acc, cur, wr, wc, fr, fq);
        if (!has_next) break;
        if constexpr (Seam::ACTIVE) { if (!keep) { typename Epi::Pre pre; E.init_issue(acc, pre, nxt, wr, wc, fr, fq); E.init_finish(acc, pre); } }
        else if (!keep) {
#pragma unroll
        for (int a = 0; a < 2; ++a)
#pragma unroll
            for (int b = 0; b < 2; ++b)
#pragma unroll
                for (int m = 0; m < 4; ++m)
#pragma unroll
                    for (int n = 0; n < 2; ++n) acc[a][b][m][n] = (f32x4){0.f, 0.f, 0.f, 0.f};
        }
        cur = nxt; cA = nA; cB = nB; ++ui;
        if constexpr (ALIGN_EPI) { if (wr == 1) PG8_BAR; }
    }
    PG8_WAIT_V(0);
    if constexpr (!ALIGN_EPI) { if (wr == 0) PG8_BAR; }
    PG8_BAR;
#undef PG8_SA
#undef PG8_SB
#undef PG8_STAGE
#undef PG8_LDA
#undef PG8_LDB
#undef PG8_MMA
#undef PG8_WAIT_V
#undef PG8_WAIT_L
#undef PG8_BAR
#undef PG8_SCHED
}
}
constexpr int BATCH = 4, SEQ = 4096, DM = 1024, M_ROWS = BATCH * SEQ;
constexpr int NH = 16, HD = 64, NKV = 4, HPG = 4, KVW = 1536;
constexpr int IN_DIM = 6704, NPROJ = 6912;
constexpr int DFF = 2816, NGU = 2 * DFF;
constexpr int NCMP = 255, NCP = 256;
constexpr float EPS = 1e-6f;
constexpr float LOG2E = 1.4426950408889634f;

__device__ __forceinline__ float fast_sigmoid(float x) { return __builtin_amdgcn_rcpf(1.f + __builtin_amdgcn_exp2f(-LOG2E * x)); }
__device__ __forceinline__ float gelu_tanh(float x) { return x * fast_sigmoid(x * (1.5957691216f + 0.0713548163f * x * x)); }

namespace pg8 {
struct SchedSimple {
    TileOrder T; const char* A; const char* B; size_t tA, tB;
    __device__ __forceinline__ bool next(int i, Unit& u) const { u.kind = 0; u.half = 0; const bool ok = T.tile(i, u.pm, u.pn); u.r0 = u.pm * BM; return ok; }
    __device__ __forceinline__ const char* abase(const Unit& u) const { return A + (size_t)u.pm * tA; }
    __device__ __forceinline__ const char* bbase(const Unit& u) const { return B + (size_t)u.pn * tB; }
};
struct SchedHalfTail {
    TileOrder T; const char* A; const char* B; size_t tA, tB; int full;
    __device__ __forceinline__ bool next(int i, Unit& u) const {
        u.kind = 0;
        if (i < full) { u.half = 0; const bool ok = T.tile(i, u.pm, u.pn); u.r0 = u.pm * BM; return ok; }
        if (i > full) return false;
        const int idx = T.c >> 3, lab = T.c & 7;
        const bool ok = T.tileL((long)full * T.G + 8 * (idx >> 1) + lab, u.pm, u.pn); u.half = 1; u.r0 = u.pm * BM + (idx & 1) * HALF; return ok;
    }
    __device__ __forceinline__ const char* abase(const Unit& u) const { return A + (size_t)u.r0 * (tA / BM); }
    __device__ __forceinline__ const char* bbase(const Unit& u) const { return B + (size_t)u.pn * tB; }
};
struct SchedMerge {
    TileOrder T; const char* A0; const char* A1; const char* B0; const char* B1; size_t tA, tB;
    __device__ __forceinline__ bool next(int i, Unit& u) const { u.kind = i & 1; u.half = 0; const bool ok = T.tile(i >> 1, u.pm, u.pn); u.r0 = u.pm * BM; return ok; }
    __device__ __forceinline__ const char* abase(const Unit& u) const { return (u.kind ? A1 : A0) + (size_t)u.pm * tA; }
    __device__ __forceinline__ const char* bbase(const Unit& u) const { return (u.kind ? B1 : B0) + (size_t)u.pn * tB; }
};

typedef f32x4 Acc[2][2][4][2];
#define EPI_ROW(ai, m) (u.r0 + (ai) * HALF + wr * 64 + (m) * 16 + fr)
#define EPI_CT(bj) ((bj) * HALF + wc * 32 + 8 * fq)

__device__ __forceinline__ u32x4 pack8(f32x4 a, f32x4 b) { u32x4 w; w.x = cvt_pk_bf16(a[0], a[1]); w.y = cvt_pk_bf16(a[2], a[3]); w.z = cvt_pk_bf16(b[0], b[1]); w.w = cvt_pk_bf16(b[2], b[3]); return w; }

struct EpiProj {
    static constexpr bool PERM = true;
    const float* rstd; bf16_t *QB, *KVB, *NG, *LX, *LGG, *MG;
    __device__ __forceinline__ bool operator()(Acc& acc, const Unit& u, int wr, int wc, int fr, int fq) const {
        const int pn = u.pn; bf16_t* dst; int ld, c0, act = 0, lim = 256;
        if (pn < 4) { dst = QB; ld = DM; c0 = pn * 256; }
        else if (pn < 10) { dst = KVB; ld = KVW; c0 = (pn - 4) * 256; }
        else if (pn == 10) { dst = NG; ld = 48; c0 = 0; act = 1; lim = 48; }
        else if (pn < 15) { dst = LX; ld = DM; c0 = (pn - 11) * 256; act = 3; }
        else if (pn < 19) { dst = LGG; ld = DM; c0 = (pn - 15) * 256; act = 2; }
        else {
            bf16_t* MGp = MG + (pn - 19) * 128;
#pragma unroll
            for (int ai = 0; ai < 2; ++ai)
#pragma unroll
                for (int m = 0; m < 4; ++m) {
                    const int row = EPI_ROW(ai, m); const float rs = rstd[row];
                    f32x4 a0 = acc[ai][0][m][0] * rs, a1 = acc[ai][0][m][1] * rs, b0 = acc[ai][1][m][0] * rs, b1 = acc[ai][1][m][1] * rs;
#pragma unroll
                    for (int e = 0; e < 4; ++e) { a0[e] = fast_sigmoid(a0[e]); a1[e] = fast_sigmoid(a1[e]); b0[e] = fast_sigmoid(b0[e]); b1[e] = fast_sigmoid(b1[e]); }
                    const u32x4 w1 = pack8(b0, b1);
                    b0[0] = __uint_as_float(w1.x << 16); b0[1] = __uint_as_float(w1.x & 0xffff0000u); b0[2] = __uint_as_float(w1.y << 16); b0[3] = __uint_as_float(w1.y & 0xffff0000u);
                    b1[0] = __uint_as_float(w1.z << 16); b1[1] = __uint_as_float(w1.z & 0xffff0000u); b1[2] = __uint_as_float(w1.w << 16); b1[3] = __uint_as_float(w1.w & 0xffff0000u);
#pragma unroll
                    for (int e = 0; e < 4; ++e) { a0[e] *= __builtin_amdgcn_rcpf(fmaxf(b0[e], 8.6736174e-19f)); a1[e] *= __builtin_amdgcn_rcpf(fmaxf(b1[e], 8.6736174e-19f)); }
                    bf16_t* q = MGp + (size_t)row * (2 * DM) + wc * 32 + 8 * fq;
                    *(u32x4*)q = pack8(a0, a1); *(u32x4*)(q + DM) = w1;
                }
            return false;
        }
#pragma unroll
        for (int ai = 0; ai < 2; ++ai)
#pragma unroll
            for (int m = 0; m < 4; ++m) {
                const int row = EPI_ROW(ai, m); const float rs = rstd[row];
#pragma unroll
                for (int bj = 0; bj < 2; ++bj) {
                    const int ct = EPI_CT(bj);
                    f32x4 v0 = acc[ai][bj][m][0] * rs, v1 = acc[ai][bj][m][1] * rs;
                    if (act == 1) {
#pragma unroll
                        for (int e = 0; e < 4; ++e) { v0[e] = fast_sigmoid(v0[e]); v1[e] = fast_sigmoid(v1[e]); }
                    } else if (act == 2) {
#pragma unroll
                        for (int e = 0; e < 4; ++e) { v0[e] = gelu_tanh(v0[e]); v1[e] = gelu_tanh(v1[e]); }
                    }
                    u32x4 pk;
                    if (act == 3) { pk.x = __builtin_bit_cast(unsigned, __builtin_amdgcn_cvt_pkrtz(v0[0], v0[1])); pk.y = __builtin_bit_cast(unsigned, __builtin_amdgcn_cvt_pkrtz(v0[2], v0[3]));
                                    pk.z = __builtin_bit_cast(unsigned, __builtin_amdgcn_cvt_pkrtz(v1[0], v1[1])); pk.w = __builtin_bit_cast(unsigned, __builtin_amdgcn_cvt_pkrtz(v1[2], v1[3])); }
                    else pk = pack8(v0, v1);
                    if (ct + 8 <= lim) *(u32x4*)(dst + (size_t)row * ld + c0 + ct) = pk;
                }
            }
        return false;
    }
};

struct EpiMerge {
    static constexpr bool PERM = true;
    const bf16_t* MG; bf16_t* MRG;
    __device__ __forceinline__ bool operator()(Acc& acc, const Unit& u, int wr, int wc, int fr, int fq) const {
        const bf16_t* MGp = MG; bf16_t* MRGp = MRG;
        asm volatile("" : "+s"(MGp), "+s"(MRGp));
#pragma unroll
        for (int ai = 0; ai < 2; ++ai)
#pragma unroll
            for (int m = 0; m < 4; ++m) {
                const int row = EPI_ROW(ai, m);
#pragma unroll
                for (int bj = 0; bj < 2; ++bj) {
                    const int col = u.pn * BM + EPI_CT(bj);
                    if (u.kind == 0) {
                        const u32x4 w0 = *(const u32x4*)(MGp + (size_t)row * (2 * DM) + col);
                        f32x4 a0, a1;
                        a0[0] = __uint_as_float(w0.x << 16); a0[1] = __uint_as_float(w0.x & 0xffff0000u); a0[2] = __uint_as_float(w0.y << 16); a0[3] = __uint_as_float(w0.y & 0xffff0000u);
                        a1[0] = __uint_as_float(w0.z << 16); a1[1] = __uint_as_float(w0.z & 0xffff0000u); a1[2] = __uint_as_float(w0.w << 16); a1[3] = __uint_as_float(w0.w & 0xffff0000u);
                        acc[ai][bj][m][0] *= a0; acc[ai][bj][m][1] *= a1;
                    } else {
                        const u32x4 w1 = *(const u32x4*)(MGp + (size_t)row * (2 * DM) + DM + col);
                        f32x4 b0, b1;
                        b0[0] = __uint_as_float(w1.x << 16); b0[1] = __uint_as_float(w1.x & 0xffff0000u); b0[2] = __uint_as_float(w1.y << 16); b0[3] = __uint_as_float(w1.y & 0xffff0000u);
                        b1[0] = __uint_as_float(w1.z << 16); b1[1] = __uint_as_float(w1.z & 0xffff0000u); b1[2] = __uint_as_float(w1.w << 16); b1[3] = __uint_as_float(w1.w & 0xffff0000u);
#pragma unroll
                        for (int e = 0; e < 4; ++e) { b0[e] = fmaxf(b0[e], 8.6736174e-19f); b1[e] = fmaxf(b1[e], 8.6736174e-19f); }
                        *(u32x4*)(MRGp + (size_t)row * DM + col) = pack8(acc[ai][bj][m][0] * b0, acc[ai][bj][m][1] * b1);
                    }
                }
                asm volatile("" ::: "memory");
            }
        return u.kind == 0;
    }
};

struct EpiWout {
    static constexpr bool PERM = true;
    const float* x; float* out; bf16_t* X1B; float* ssq;
    struct Pre {};
    __device__ __forceinline__ void init_finish(Acc&, const Pre&) const {}
    __device__ __forceinline__ void init_issue(Acc& acc, Pre&, const Unit& u, int wr, int wc, int fr, int fq) const {
        const float* xp = x; asm volatile("" : "+s"(xp));
#pragma unroll
        for (int ai = 0; ai < 2; ++ai)
#pragma unroll
            for (int m = 0; m < 4; ++m) {
                const int row = EPI_ROW(ai, m);
#pragma unroll
                for (int bj = 0; bj < 2; ++bj) {
                    const size_t off = (size_t)row * DM + u.pn * BM + EPI_CT(bj);
                    const __attribute__((address_space(1))) f32x4* gp = (const __attribute__((address_space(1))) f32x4*)(xp + off);
                    acc[ai][bj][m][0] = __builtin_nontemporal_load(gp); acc[ai][bj][m][1] = __builtin_nontemporal_load(gp + 1);
                }
            }
    }
    __device__ __forceinline__ bool operator()(Acc& acc, const Unit& u, int wr, int wc, int fr, int fq) const {
#pragma unroll
        for (int ai = 0; ai < 2; ++ai)
#pragma unroll
            for (int m = 0; m < 4; ++m) {
                const int row = EPI_ROW(ai, m); float s = 0.f;
#pragma unroll
                for (int bj = 0; bj < 2; ++bj) {
                    const int col = u.pn * BM + EPI_CT(bj); const size_t off = (size_t)row * DM + col;
                    const f32x4 v0 = acc[ai][bj][m][0], v1 = acc[ai][bj][m][1];
                    *(u32x4*)(X1B + off) = pack8(v0, v1);
                    s += (v0[0] * v0[0] + v0[1] * v0[1]) + (v0[2] * v0[2] + v0[3] * v0[3]) + (v1[0] * v1[0] + v1[1] * v1[1]) + (v1[2] * v1[2] + v1[3] * v1[3]);
                }
                s += __shfl_xor(s, 16); s += __shfl_xor(s, 32);
                if (fq == 0) ssq[(size_t)row * 16 + u.pn * 4 + wc] = s;
            }
        return false;
    }
};

struct EpiGU {
    static constexpr bool PERM = true;
    const float* ssq; bf16_t* FF;
    __device__ __forceinline__ bool operator()(Acc& acc, const Unit& u, int wr, int wc, int fr, int fq) const {
#pragma unroll
        for (int ai = 0; ai < 2; ++ai)
            if (ai == 0 || !u.half)
#pragma unroll
            for (int m = 0; m < 4; ++m) {
                const int row = EPI_ROW(ai, m);
                const f32x4* sp = (const f32x4*)(ssq + (size_t)row * 16);
                const f32x4 s0 = sp[0], s1 = sp[1], s2 = sp[2], s3 = sp[3];
                const float tot = ((s0[0] + s0[1]) + (s0[2] + s0[3])) + ((s1[0] + s1[1]) + (s1[2] + s1[3])) + ((s2[0] + s2[1]) + (s2[2] + s2[3])) + ((s3[0] + s3[1]) + (s3[2] + s3[3]));
                const float rs = __builtin_amdgcn_rsqf(tot * (1.f / DM) + EPS);
                f32x4 o[2];
#pragma unroll
                for (int n = 0; n < 2; ++n)
#pragma unroll
                    for (int e = 0; e < 4; ++e) { const float g = acc[ai][0][m][n][e] * rs, up = acc[ai][1][m][n][e] * rs; o[n][e] = g * fast_sigmoid(g) * up; }
                *(u32x4*)(FF + (size_t)row * DFF + u.pn * HALF + wc * 32 + 8 * fq) = pack8(o[0], o[1]);
            }
        return false;
    }
};

struct EpiDown {
    static constexpr bool PERM = true;
    float* out; const bf16_t* X1B;
    struct Pre { u32x4 w[2][4][2]; };
    __device__ __forceinline__ void init_issue(Acc&, Pre& pre, const Unit& u, int wr, int wc, int fr, int fq) const {
        const bf16_t* xp = X1B; asm volatile("" : "+s"(xp));
#pragma unroll
        for (int ai = 0; ai < 2; ++ai)
#pragma unroll
            for (int m = 0; m < 4; ++m) {
                const int row = EPI_ROW(ai, m);
#pragma unroll
                for (int bj = 0; bj < 2; ++bj)
                    pre.w[ai][m][bj] = *(const __attribute__((address_space(1))) u32x4*)(xp + (size_t)row * DM + u.pn * BM + EPI_CT(bj));
            }
    }
    __device__ __forceinline__ void init_finish(Acc& acc, const Pre& pre) const {
#pragma unroll
        for (int ai = 0; ai < 2; ++ai)
#pragma unroll
            for (int m = 0; m < 4; ++m)
#pragma unroll
                for (int bj = 0; bj < 2; ++bj) {
                    const u32x4 xw = pre.w[ai][m][bj];
                    f32x4 x0, x1;
                    x0[0] = __uint_as_float(xw.x << 16); x0[1] = __uint_as_float(xw.x & 0xffff0000u); x0[2] = __uint_as_float(xw.y << 16); x0[3] = __uint_as_float(xw.y & 0xffff0000u);
                    x1[0] = __uint_as_float(xw.z << 16); x1[1] = __uint_as_float(xw.z & 0xffff0000u); x1[2] = __uint_as_float(xw.w << 16); x1[3] = __uint_as_float(xw.w & 0xffff0000u);
                    acc[ai][bj][m][0] = x0; acc[ai][bj][m][1] = x1;
                }
    }
    __device__ __forceinline__ bool operator()(Acc& acc, const Unit& u, int wr, int wc, int fr, int fq) const {
#pragma unroll
        for (int ai = 0; ai < 2; ++ai)
#pragma unroll
            for (int m = 0; m < 4; ++m) {
                const int row = EPI_ROW(ai, m);
#pragma unroll
                for (int bj = 0; bj < 2; ++bj) {
                    const size_t off = (size_t)row * DM + u.pn * BM + EPI_CT(bj);
                    *(f32x4*)(out + off) = acc[ai][bj][m][0]; *(f32x4*)(out + off + 4) = acc[ai][bj][m][1];
                }
            }
        return false;
    }
};
#undef EPI_ROW
#undef EPI_CT
}
constexpr size_t MiB = 1u << 20;
constexpr size_t WS_CTL = 0, CTL_ZERO_BYTES = 1 * MiB;
constexpr size_t WS_NG = 1 * MiB;
constexpr size_t WS_RSTD1 = 3 * MiB;
constexpr size_t WS_SSQ = 4 * MiB;
constexpr size_t WS_KC = 5 * MiB;
constexpr size_t WS_VC = 5 * MiB + 512 * 1024;
constexpr size_t WS_LSUM = 6 * MiB;
constexpr size_t WS_CW2 = 7 * MiB;
constexpr size_t WS_LW = 7 * MiB + 256 * 1024;
constexpr size_t WS_HID = 8 * MiB;
constexpr size_t WS_CW1 = 12 * MiB;
constexpr size_t WS_WOA = 14 * MiB, WS_WOL = 16 * MiB, WS_WOUT = 18 * MiB;
constexpr size_t WS_WDN = 20 * MiB;
constexpr size_t WS_WGU = 26 * MiB;
constexpr size_t WS_WIN = 37 * MiB;
constexpr size_t WS_XB = 51 * MiB;
constexpr size_t WS_HL = 51 * MiB;
constexpr size_t WS_PC0 = 227 * MiB;
constexpr size_t WS_PC3 = 37 * MiB;
constexpr size_t WS_QB = 83 * MiB;
constexpr size_t WS_KVB = 115 * MiB;
constexpr size_t WS_LX = 163 * MiB;
constexpr size_t WS_LGG = 195 * MiB;
constexpr size_t WS_MRGF = 83 * MiB;
constexpr size_t WS_FF = 83 * MiB;
constexpr size_t WS_END = 251 * MiB;

constexpr int CW_BAR = 4096;
constexpr int CW_QUEUE = 16384;

constexpr int RING_BYTES = 131072;
constexpr int LDSCTL_OFF = RING_BYTES, MISC_OFF = LDSCTL_OFF + 320;
constexpr int LDS_BYTES = 147456;
constexpr int NWAVES = 8;

#define GAS __attribute__((address_space(1)))
#define LAS __attribute__((address_space(3)))
typedef unsigned short bf16;
typedef unsigned v4u __attribute__((ext_vector_type(4)));
typedef unsigned v2u __attribute__((ext_vector_type(2)));
typedef float f32x4 __attribute__((ext_vector_type(4)));
typedef short bf16x8 __attribute__((ext_vector_type(8)));
typedef GAS unsigned gu32;
#define RLX_AGENT __ATOMIC_RELAXED, __HIP_MEMORY_SCOPE_AGENT
#define LDS_WAIT() asm volatile("s_waitcnt lgkmcnt(0)" ::: "memory")
#define VM_WAIT() asm volatile("s_waitcnt vmcnt(0)" ::: "memory")
__device__ __forceinline__ unsigned f2bf(float f) { unsigned u = __builtin_bit_cast(unsigned, f); return (u + 0x7fffu + ((u >> 16) & 1u)) >> 16; }
__device__ __forceinline__ unsigned pk2(float lo, float hi) { return f2bf(lo) | (f2bf(hi) << 16); }
__device__ __forceinline__ float bf2f(unsigned short h) { return __uint_as_float((unsigned)h << 16); }
__device__ __forceinline__ float bflo(unsigned w) { return __uint_as_float(w << 16); }
__device__ __forceinline__ float bfhi(unsigned w) { return __uint_as_float(w & 0xffff0000u); }

#define XB_TMO      128
#define XB_XCNT(j)  (256  + 64 * (j))
#define XB_XSUB(j)  (1280 + 64 * (j))
#define XB_XGEN(j)  (2304 + 64 * (j))
#define XB_TOP      3328
#define XB_TOPGEN   3392
#define XCD_BAR_WORDS 3456
#define XB_SPIN_CAP (1u << 20)
__device__ __forceinline__ unsigned xb_ld(unsigned* p)              { return __hip_atomic_load(p, __ATOMIC_RELAXED, __HIP_MEMORY_SCOPE_AGENT); }
__device__ __forceinline__ unsigned xb_add(unsigned* p, unsigned v) { return __hip_atomic_fetch_add(p, v, __ATOMIC_RELAXED, __HIP_MEMORY_SCOPE_AGENT); }
__device__ __forceinline__ unsigned xb_xcc_id() { return (unsigned)__builtin_amdgcn_s_getreg((3 << 11) | 20) & 0xFu; }
#define XB_SPIN(cond, bar) do { unsigned _sp = 0; while (cond) { __builtin_amdgcn_s_sleep(1); \
    if ((++_sp & 255u) == 0u) { if (xb_ld(&(bar)[XB_TMO])) break; if (_sp > XB_SPIN_CAP) { atomicAdd(&(bar)[XB_TMO], 1u); break; } } } } while (0)
struct XcdBarrier { unsigned* bar; unsigned x; volatile LAS unsigned* st; };
__device__ __forceinline__ XcdBarrier xcd_barrier_post(unsigned* bar, volatile LAS unsigned* st) {
    XcdBarrier b; b.bar = bar; b.x = xb_xcc_id(); b.st = st;
    if (threadIdx.x == 0) (void)xb_add(&bar[XB_XCNT(b.x)], 1u);
    return b;
}
__device__ __forceinline__ void xcd_barrier_complete(unsigned* bar, unsigned x, unsigned& nloc, unsigned& nx) {
    const unsigned G = gridDim.x * gridDim.y * gridDim.z;
    unsigned sum, cnt, mine, sp = 0u;
    for (;;) {
        sum = 0u; cnt = 0u; mine = 0u;
#pragma unroll
        for (unsigned j = 0; j < 16; ++j) { const unsigned c = xb_ld(&bar[XB_XCNT(j)]); sum += c; cnt += (c > 0u) ? 1u : 0u; mine = (j == x) ? c : mine; }
        if (sum == G) break;
        __builtin_amdgcn_s_sleep(1);
        if ((++sp & 255u) == 0u) { if (xb_ld(&bar[XB_TMO])) break; if (sp > XB_SPIN_CAP) { atomicAdd(&bar[XB_TMO], 1u); break; } }
    }
    nloc = mine > 0u ? mine : 1u; nx = cnt > 0u ? cnt : 1u;
}
__device__ __forceinline__ void xcd_barrier(const XcdBarrier& b) {
    asm volatile("s_waitcnt vmcnt(0)" ::: "memory");
    __syncthreads();
    if (threadIdx.x == 0) {
        unsigned* bar = b.bar;
        __builtin_amdgcn_s_waitcnt(0);
        unsigned nloc = b.st[0], nx = b.st[1];
        if (nloc == 0u) { xcd_barrier_complete(bar, b.x, nloc, nx); b.st[0] = nloc; b.st[1] = nx; }
        const unsigned old = xb_add(&bar[XB_XSUB(b.x)], 1u);
        const unsigned gen = old / nloc;
        if (old + 1u == (gen + 1u) * nloc) {
            __builtin_amdgcn_fence(__ATOMIC_RELEASE, "agent");
            asm volatile("s_waitcnt vmcnt(0)" ::: "memory");
            const unsigned og = xb_add(&bar[XB_TOP], 1u);
            const unsigned tg = og / nx;
            if (og + 1u == (tg + 1u) * nx) xb_add(&bar[XB_TOPGEN], 1u);
            else XB_SPIN(xb_ld(&bar[XB_TOPGEN]) == tg, bar);
            __builtin_amdgcn_fence(__ATOMIC_ACQUIRE, "agent");
            xb_add(&bar[XB_XGEN(b.x)], 1u);
            asm volatile("s_waitcnt vmcnt(0)" ::: "memory");
        } else {
            XB_SPIN(xb_ld(&bar[XB_XGEN(b.x)]) == gen, bar);
            __builtin_amdgcn_fence(__ATOMIC_ACQUIRE, "agent");
            asm volatile("s_waitcnt vmcnt(0)" ::: "memory");
        }
    }
    __syncthreads();
}

constexpr int CW_LAB = 20480;
__device__ __forceinline__ void label_barrier(unsigned* cnt, unsigned members, unsigned* bar) {
    asm volatile("s_waitcnt vmcnt(0)" ::: "memory");
    __syncthreads();
    if (threadIdx.x == 0) {
        const unsigned old = xb_add(cnt, 1u);
        const unsigned target = (old / members + 1u) * members;
        XB_SPIN(xb_ld(cnt) < target, bar);
        __builtin_amdgcn_fence(__ATOMIC_ACQUIRE, "agent");
        asm volatile("s_waitcnt vmcnt(0)" ::: "memory");
    }
    __syncthreads();
}

struct LabelSeam {
    static constexpr bool ACTIVE = true;
    bool on, local; unsigned* cnt; unsigned target; XcdBarrier bar;
    __device__ __forceinline__ bool early() const { return on && local; }
    __device__ __forceinline__ void enter() const { asm volatile("s_waitcnt vmcnt(0)" ::: "memory"); __builtin_amdgcn_s_barrier(); asm volatile("" ::: "memory"); }
    __device__ __forceinline__ void finish() const {
        asm volatile("" ::: "memory");
        if (threadIdx.x == 0) {
            (void)__hip_atomic_fetch_add(cnt, 1u, __ATOMIC_RELAXED, __HIP_MEMORY_SCOPE_AGENT);
            XB_SPIN(xb_ld(cnt) < target, bar.bar);
            __builtin_amdgcn_fence(__ATOMIC_ACQUIRE, "agent");
            asm volatile("s_waitcnt vmcnt(0)" ::: "memory");
        }
        __builtin_amdgcn_s_barrier(); asm volatile("" ::: "memory");
    }
    __device__ __forceinline__ void full() const { if (on) xcd_barrier(bar); }
};

struct Frame {
    LAS unsigned char* lds;
    volatile LAS unsigned* MISC;
    gu32* ctl;
    int tid, lane, wave, vcu, G, grp;
    float* out; unsigned char* ws;
};
struct Args { const float* in[29]; float* out; unsigned char* ws; int ph_lo, ph_hi; };
__device__ __forceinline__ float wave_sum(float v) {
#pragma unroll
    for (int o = 1; o < 64; o <<= 1) v += __shfl_xor(v, o);
    return v;
}

struct ConvItem { const float* W; const float* gk; bf16* WT; int ldw, k0, nsrc, nvalid, ldt, ndst, fragmajor; };
constexpr int I_IN = (NPROJ / 32) * 16, I_SQ = 32 * 16, I_GU = (DFF / 32) * 16, I_DN = 32 * (DFF / 64), I_C1 = 8 * 32, I_C2 = 2 * 4, I_LW = 16 * 2;
constexpr int I_EARLY = I_IN + 2 * I_C1 + 2 * I_C2 + 2 * I_LW + I_GU, I_LATE = I_GU + 3 * I_SQ + I_DN;
__device__ __forceinline__ ConvItem p0_item(const Args& A, unsigned char* ws, int r) {
    ConvItem d; d.gk = nullptr; d.nvalid = 32; d.fragmajor = 0;
    if (r < I_IN) { const int nb = r % (NPROJ / 32), kb = r / (NPROJ / 32); int nsrc, nv = 32;
        if (nb < 80) nsrc = 32 * nb; else if (nb < 88) { nsrc = 2560 + 32 * (nb - 80); nv = 48 - 32 * (nb - 80); nv = nv < 0 ? 0 : (nv > 32 ? 32 : nv); } else if (nb < 152) nsrc = 2608 + 32 * (nb - 88);
        else { const int dc = 32 * (nb - 152), j = dc >> 8, w = dc & 255; nsrc = 2608 + 2048 + (w >> 7) * 1024 + 128 * j + (w & 127); }
        d.W = A.in[2]; d.ldw = IN_DIM; d.k0 = 64 * kb; d.nsrc = nsrc; d.nvalid = nv; d.WT = (bf16*)(ws + WS_WIN); d.ldt = DM; d.ndst = 32 * nb; d.gk = A.in[1]; return d; }
    r -= I_IN;
    if (r < 2 * I_C1) { const int w = r / I_C1, q = r % I_C1, nb = q % 8, kb = q / 8;
        d.W = w == 0 ? A.in[6] : A.in[11]; d.ldw = 256; d.k0 = 64 * kb; d.nsrc = 32 * nb; d.WT = (bf16*)(ws + WS_CW1) + (size_t)w * 256 * 2048; d.ldt = 2048; d.ndst = 32 * nb; d.fragmajor = 1; return d; }
    r -= 2 * I_C1;
    if (r < 2 * I_C2) { const int w = r / I_C2, q = r % I_C2, nb = q % 2, kb = q / 2;
        d.W = w == 0 ? A.in[8] : A.in[13]; d.ldw = 64; d.k0 = 64 * kb; d.nsrc = 32 * nb; d.WT = (bf16*)(ws + WS_CW2) + (size_t)w * 64 * 256; d.ldt = 256; d.ndst = 32 * nb; return d; }
    r -= 2 * I_C2;
    if (r < 2 * I_LW) { const int w = r / I_LW, q = r % I_LW, nb = q % 2, blk = q / 2;
        d.W = (w == 0 ? A.in[17] : A.in[19]) + (size_t)blk * 4096; d.ldw = 64; d.k0 = 0; d.nsrc = 32 * nb; d.WT = (bf16*)(ws + WS_LW) + (size_t)(w * 16 + blk) * 4096; d.ldt = 64; d.ndst = 32 * nb; return d; }
    r -= 2 * I_LW;
    if (r < 2 * I_GU) { const int w = r / I_GU, q = r % I_GU, nb = q % (DFF / 32), kb = q / (DFF / 32); const int c = 32 * nb;
        d.W = w == 0 ? A.in[26] : A.in[27]; d.ldw = DFF; d.k0 = 64 * kb; d.nsrc = c; d.WT = (bf16*)(ws + WS_WGU); d.ldt = DM; d.ndst = 256 * (c / 128) + (c % 128) + 128 * w; d.gk = A.in[25]; return d; }
    r -= 2 * I_GU;
    if (r < 3 * I_SQ) { const int w = r / I_SQ, q = r % I_SQ, nb = q % 32, kb = q / 32;
        d.W = w == 0 ? A.in[22] : (w == 1 ? A.in[23] : A.in[24]); d.WT = (bf16*)(ws + (w == 0 ? WS_WOA : (w == 1 ? WS_WOL : WS_WOUT)));
        d.ldw = DM; d.k0 = 64 * kb; d.nsrc = 32 * nb; d.ldt = DM; d.ndst = 32 * nb; return d; }
    r -= 3 * I_SQ;
    { const int nb = r % 32, kb = r / 32;
        d.W = A.in[28]; d.ldw = DM; d.k0 = 64 * kb; d.nsrc = 32 * nb; d.WT = (bf16*)(ws + WS_WDN); d.ldt = DFF; d.ndst = 32 * nb; return d; }
}
__device__ __forceinline__ void p0_item_load(const ConvItem& d, f32x4* v, int lane) {
    const int kr = lane >> 3, cc = lane & 7; const bool ok = 4 * cc < d.nvalid;
    const float* wp = d.W + (size_t)(d.k0 + kr) * d.ldw + d.nsrc + (ok ? 4 * cc : 0);
#pragma unroll
    for (int i = 0; i < 8; ++i) v[i] = __builtin_nontemporal_load((const f32x4*)(wp + (size_t)(8 * i) * d.ldw));
}
__device__ __forceinline__ void p0_item_finish(const ConvItem& d, const f32x4* v, LAS float* scr, int lane) {
    { const int kr = lane >> 3, cc = lane & 7; const bool ok = 4 * cc < d.nvalid;
#pragma unroll
      for (int i = 0; i < 8; ++i) { const int kk = 8 * i + kr; f32x4 x = ok ? v[i] : (f32x4){0.f, 0.f, 0.f, 0.f}; if (d.gk) x = x * d.gk[d.k0 + kk];
          LAS float* q = scr + kk * 33 + 4 * cc; q[0] = x[0]; q[1] = x[1]; q[2] = x[2]; q[3] = x[3]; } }
    LDS_WAIT(); asm volatile("" ::: "memory");
    const int c = lane & 7;
#pragma unroll
    for (int j = 0; j < 4; ++j) { const int n = (lane >> 3) + 8 * j; const LAS float* s = scr + (8 * c) * 33 + n;
        v4u o; o.x = pk2(s[0 * 33], s[1 * 33]); o.y = pk2(s[2 * 33], s[3 * 33]); o.z = pk2(s[4 * 33], s[5 * 33]); o.w = pk2(s[6 * 33], s[7 * 33]);
        if (d.fragmajor) { const int nn = d.ndst + n, k8 = (d.k0 >> 3) + c;
            *(GAS v4u*)(d.WT + ((((size_t)(nn >> 5) * (d.ldt >> 4) + (k8 >> 1)) * 64 + (k8 & 1) * 32 + (nn & 31)) << 3)) = o; }
        else *(GAS v4u*)(d.WT + (size_t)(d.ndst + n) * d.ldt + d.k0 + 8 * c) = o; }
    LDS_WAIT(); asm volatile("" ::: "memory");
}
template <bool LATE>
__device__ __forceinline__ void p0_prologue(Frame& F, const Args& A, int hrank = 0, int nhelp = 0) {
    LAS float* scr = (LAS float*)(F.lds + F.wave * 16384);
    const int gw = LATE ? hrank * NWAVES + F.wave : F.vcu * NWAVES + F.wave, NGW = LATE ? nhelp * NWAVES : F.G * NWAVES;
    unsigned char* ws = F.ws;
    const int NITEMS = LATE ? I_LATE : I_EARLY, ibase = LATE ? I_EARLY : 0;
    if (gw < NITEMS) {
        f32x4 v[8]; ConvItem cur = p0_item(A, ws, ibase + gw); p0_item_load(cur, v, F.lane);
        for (int it = gw; it < NITEMS; it += NGW) {
            const int nx = it + NGW; f32x4 vn[8]; ConvItem nxt = cur;
            if (nx < NITEMS) nxt = p0_item(A, ws, ibase + nx);
            p0_item_load(nxt, vn, F.lane);
            p0_item_finish(cur, v, scr, F.lane);
            cur = nxt;
#pragma unroll
            for (int i = 0; i < 8; ++i) v[i] = vn[i];
        }
    }
    if (LATE) return;
    const float* x = A.in[0]; bf16* XB = (bf16*)(ws + WS_XB); float* rstd = (float*)(ws + WS_RSTD1);
    for (int rep_ = 0; rep_ < (REP_PHASE == 31 ? 2 : 1); ++rep_)
    for (int m0 = gw; m0 < M_ROWS; m0 += 4 * NGW) {
        f32x4 v[4][4];
#pragma unroll
        for (int r = 0; r < 4; ++r) { const int m = m0 + r * NGW < M_ROWS ? m0 + r * NGW : m0; const GAS f32x4* xr = (const GAS f32x4*)(x + (size_t)m * DM) + 2 * F.lane;
#pragma unroll
            for (int j = 0; j < 4; ++j) v[r][j] = __builtin_nontemporal_load(xr + 128 * (j >> 1) + (j & 1)); }
#pragma unroll
        for (int r = 0; r < 4; ++r) { const int m = m0 + r * NGW; if (m < M_ROWS) {
            float s = 0.f;
#pragma unroll
            for (int j = 0; j < 4; ++j) s += (v[r][j].x * v[r][j].x + v[r][j].y * v[r][j].y) + (v[r][j].z * v[r][j].z + v[r][j].w * v[r][j].w);
            s = wave_sum(s);
            if (F.lane == 0) rstd[m] = 1.0f / sqrtf(s * (1.f / DM) + EPS);
            GAS v4u* o16 = (GAS v4u*)(XB + (size_t)m * DM) + F.lane;
#pragma unroll
            for (int hf = 0; hf < 2; ++hf) { v4u o; o.x = pk2(v[r][2 * hf].x, v[r][2 * hf].y); o.y = pk2(v[r][2 * hf].z, v[r][2 * hf].w); o.z = pk2(v[r][2 * hf + 1].x, v[r][2 * hf + 1].y); o.w = pk2(v[r][2 * hf + 1].z, v[r][2 * hf + 1].w);
                o16[64 * hf] = o; } } }
    }
}
typedef float f32x16 __attribute__((ext_vector_type(16)));
typedef short s16x4 __attribute__((ext_vector_type(4)));
__device__ __forceinline__ int crow(int r, int hi) { return (r & 3) + 8 * (r >> 2) + 4 * hi; }
__device__ __forceinline__ unsigned cvtpk(float lo, float hi) { unsigned r; asm volatile("v_cvt_pk_bf16_f32 %0, %1, %2" : "=v"(r) : "v"(lo), "v"(hi)); return r; }
__device__ __forceinline__ bf16x8 pack_bf8(const float* v) { v4u w; w.x = cvtpk(v[0], v[1]); w.y = cvtpk(v[2], v[3]); w.z = cvtpk(v[4], v[5]); w.w = cvtpk(v[6], v[7]); return __builtin_bit_cast(bf16x8, w); }
__device__ __forceinline__ void unpack_bf8(v4u w, float* v) { v[0] = bflo(w.x); v[1] = bfhi(w.x); v[2] = bflo(w.y); v[3] = bfhi(w.y); v[4] = bflo(w.z); v[5] = bfhi(w.z); v[6] = bflo(w.w); v[7] = bfhi(w.w); }

__device__ __forceinline__ void p2_knorm(Frame& F, const Args& A) {
    const int idx = F.vcu * 512 + F.tid;
    for (int it = idx; it < M_ROWS * 8; it += F.G * 512) {
        const int m = it >> 3, s = (it >> 2) & 1, g = it & 3, set = s ? 4 : 2;
        bf16* p = (bf16*)(F.ws + WS_KVB) + (size_t)m * KVW + set * 256 + g * 64; const float* gw = A.in[4] + (s ? 2 : 1) * 64;
        v4u w[8]; float ss = 0.f;
#pragma unroll
        for (int c = 0; c < 8; ++c) { w[c] = *(const v4u*)(p + 8 * c); float v[8]; unpack_bf8(w[c], v);
#pragma unroll
            for (int e = 0; e < 8; ++e) ss += v[e] * v[e]; }
        const float r = 1.0f / sqrtf(ss * (1.f / 64) + EPS);
#pragma unroll
        for (int c = 0; c < 8; ++c) { float v[8]; unpack_bf8(w[c], v); const f32x4 g0 = *(const f32x4*)(gw + 8 * c), g1 = *(const f32x4*)(gw + 8 * c + 4);
            v[0] *= r * g0[0]; v[1] *= r * g0[1]; v[2] *= r * g0[2]; v[3] *= r * g0[3]; v[4] *= r * g1[0]; v[5] *= r * g1[1]; v[6] *= r * g1[2]; v[7] *= r * g1[3];
            *(bf16x8*)(p + 8 * c) = pack_bf8(v); }
    }
}

constexpr int HID_LD = 264, CMP_A_OFF = 0, CMP_POS_OFF = 528 * 128, CMP_HID_OFF = 113664;
__device__ __forceinline__ void p2_compress(Frame& F, const Args& A, int unit) {
    const int set = unit >> 7, bg = (unit >> 3) & 15, oct = unit & 7, b = bg >> 2, g = bg & 3;
    const int lane = F.lane, w = F.wave, r32 = lane & 31, hi = lane >> 5, n0 = oct * 32;
    LAS unsigned char* lds = F.lds;
    { const bf16* kvb = (const bf16*)(F.ws + WS_KVB) + (size_t)(b * SEQ + 16 * n0) * KVW + set * 256 + g * 64;
      for (int q = w; q < 66; q += NWAVES) { const int R = 8 * q + (lane >> 3), c = (lane & 7) ^ ((R >> 4) & 7);
          __builtin_amdgcn_global_load_lds((const unsigned*)(kvb + (size_t)R * KVW + c * 8), (LAS unsigned*)(lds + CMP_A_OFF + q * 1024), 16, 0, 0); } }
    { const float* pos = set ? A.in[10] : A.in[5]; const f32x4 p = *(const f32x4*)(pos + 4 * F.tid); v2u pk; pk.x = cvtpk(p[0], p[1]); pk.y = cvtpk(p[2], p[3]);
      *(LAS v2u*)(lds + CMP_POS_OFF + 8 * F.tid) = pk; }
    const bf16* w1f = (const bf16*)(F.ws + WS_CW1) + ((size_t)(set * 8 + w) * 128 * 64 + lane) * 8;
    bf16x8 bq[8];
#pragma unroll
    for (int i = 0; i < 8; ++i) bq[i] = *(const bf16x8*)(w1f + (size_t)i * 512);
    asm volatile("s_waitcnt vmcnt(8)" ::: "memory");
    __syncthreads();
    f32x16 acc, acc2;
#pragma unroll
    for (int i = 0; i < 16; ++i) { acc[i] = 0.f; acc2[i] = 0.f; }
    const LAS unsigned char* arow = lds + CMP_A_OFF + r32 * 2048;
    const LAS unsigned char* prow = lds + CMP_POS_OFF + 16 * hi;
#pragma unroll 1
    for (int k8 = 0; k8 < 16; ++k8) {
        bf16x8 bn[8];
        const int kn = k8 < 15 ? k8 + 1 : 15;
#pragma unroll
        for (int i = 0; i < 8; ++i) bn[i] = *(const bf16x8*)(w1f + (size_t)(kn * 8 + i) * 512);
#pragma unroll
        for (int i = 0; i < 8; ++i) {
            const int lt = 2 * k8 + (i >> 2), kq = i & 3;
            const int key = (r32 + (k8 >> 3)) & 7;
            const bf16x8 af = *(const LAS bf16x8*)(arow + lt * 128 + (((2 * kq + hi) ^ key) << 4));
            const bf16x8 pf = *(const LAS bf16x8*)(prow + lt * 128 + kq * 32);
            acc = __builtin_amdgcn_mfma_f32_32x32x16_bf16(af, bq[i], acc, 0, 0, 0);
            acc2 = __builtin_amdgcn_mfma_f32_32x32x16_bf16(pf, bq[i], acc2, 0, 0, 0);
        }
#pragma unroll
        for (int i = 0; i < 8; ++i) bq[i] = bn[i];
    }
    LAS bf16* hid = (LAS bf16*)(lds + CMP_HID_OFF);
    { const float b1 = (set ? A.in[12] : A.in[7])[w * 32 + r32];
#pragma unroll
      for (int r = 0; r < 16; ++r) hid[crow(r, hi) * HID_LD + w * 32 + r32] = (bf16)f2bf(gelu_tanh(acc[r] + acc2[r] + b1)); }
    __syncthreads();
    if (w == 0) {
        const bf16* w2t = (const bf16*)(F.ws + WS_CW2) + (size_t)set * 64 * 256;
        f32x16 o[2];
#pragma unroll
        for (int mt = 0; mt < 2; ++mt)
#pragma unroll
            for (int i = 0; i < 16; ++i) o[mt][i] = 0.f;
#pragma unroll
        for (int k4 = 0; k4 < 4; ++k4) {
            bf16x8 wa[4][2];
#pragma unroll
            for (int i = 0; i < 4; ++i)
#pragma unroll
                for (int mt = 0; mt < 2; ++mt) wa[i][mt] = *(const bf16x8*)(w2t + (size_t)(32 * mt + r32) * 256 + 16 * (4 * k4 + i) + 8 * hi);
#pragma unroll
            for (int i = 0; i < 4; ++i) {
                const bf16x8 hb = *(const LAS bf16x8*)(hid + r32 * HID_LD + 16 * (4 * k4 + i) + 8 * hi);
#pragma unroll
                for (int mt = 0; mt < 2; ++mt) o[mt] = __builtin_amdgcn_mfma_f32_32x32x16_bf16(wa[i][mt], hb, o[mt], 0, 0, 0);
            }
        }
        const float* b2 = set ? A.in[14] : A.in[9]; float ss = 0.f;
#pragma unroll
        for (int mt = 0; mt < 2; ++mt)
#pragma unroll
            for (int r = 0; r < 16; ++r) { o[mt][r] += b2[32 * mt + crow(r, hi)]; ss += o[mt][r] * o[mt][r]; }
        ss += __shfl_xor(ss, 32);
        const float rs = 1.0f / sqrtf(ss * (1.f / 64) + EPS);
        const int n = n0 + r32;
        bf16* dst = (bf16*)(F.ws + (set ? WS_VC : WS_KC)) + ((size_t)bg * NCP + n) * 64;
#pragma unroll
        for (int mt = 0; mt < 2; ++mt)
#pragma unroll
            for (int a = 0; a < 4; ++a) { float v[4];
#pragma unroll
                for (int e = 0; e < 4; ++e) { const int d = 32 * mt + 8 * a + 4 * hi + e; float x = o[mt][4 * a + e]; if (set == 0) x *= rs * A.in[4][d]; if (n >= NCMP) x = 0.f; v[e] = x; }
                v2u pk; pk.x = cvtpk(v[0], v[1]); pk.y = cvtpk(v[2], v[3]);
                *(v2u*)(dst + 32 * mt + 8 * a + 4 * hi) = pk; }
    }
}

typedef _Float16 h8v __attribute__((ext_vector_type(8)));
typedef _Float16 h2v __attribute__((ext_vector_type(2)));
__device__ __forceinline__ unsigned pkh(float a, float b) { return __builtin_bit_cast(unsigned, __builtin_amdgcn_cvt_pkrtz(a, b)); }
constexpr int LRU_SEG = 128, LRU_NSEG = SEQ / LRU_SEG, LRU_BW_OFF = 0, LRU_CW_OFF = 16384, LRU_X_OFF = 20480;
__device__ __forceinline__ void lru_wg(Frame& F, const Args& A, int item) {
    const int n = item & 15, b = (item >> 4) & 3, seg = (item >> 6) * 8 + F.wave;
    int lane = F.lane, tid = F.tid; asm volatile("" : "+v"(lane), "+v"(tid));
    const int r32 = lane & 31, hi = lane >> 5;
    LAS v4u* BWL = (LAS v4u*)(F.lds + LRU_BW_OFF); LAS _Float16* cwH = (LAS _Float16*)(F.lds + LRU_CW_OFF);
    { const bf16* lw = (const bf16*)(F.ws + WS_LW);
      for (int e = tid; e < 1024; e += NWAVES * 64) { const int fr = e >> 6, ln = e & 63, gt = fr >> 3, nt = (fr >> 2) & 1, ks = fr & 3;
          const v4u w = *(const v4u*)(lw + ((size_t)(gt * 16 + n) * 64 + 32 * nt + (ln & 31)) * 64 + 16 * ks + 8 * (ln >> 5));
          float wv[8]; unpack_bf8(w, wv);
#pragma unroll
          for (int i = 0; i < 8; ++i) wv[i] *= -LOG2E;
          v4u o; o.x = pkh(wv[0], wv[1]); o.y = pkh(wv[2], wv[3]); o.z = pkh(wv[4], wv[5]); o.w = pkh(wv[6], wv[7]);
          BWL[e] = o; }
      if (tid < 320) { const int tap = tid >> 6, ln = tid & 63; cwH[tid] = (_Float16)(tap < 4 ? A.in[15][tap * 1024 + n * 64 + ln] : A.in[16][n * 64 + ln]); } }
    __syncthreads();
    bf16x8 ID0, ID1;
    { const bool mine = (hi == ((r32 >> 3) & 1));
#pragma unroll
      for (int j = 0; j < 8; ++j) { const short one = (mine && j == (r32 & 7)) ? (short)0x3C00 : (short)0; ID0[j] = (r32 < 16) ? one : (short)0; ID1[j] = (r32 >= 16) ? one : (short)0; } }
    float L2A[2], bar_[2], bi_[2], carry[2], Aseg[2];
#pragma unroll
    for (int nt = 0; nt < 2; ++nt) { const int cj = n * 64 + 32 * nt + r32; const float lam = A.in[21][cj];
        L2A[nt] = -8.0f * log1pf(expf(-lam)) * LOG2E; bar_[nt] = -LOG2E * A.in[18][cj]; bi_[nt] = -LOG2E * A.in[20][cj]; carry[nt] = 0.f; Aseg[nt] = 1.f; }
    const bf16* LXb = (const bf16*)(F.ws + WS_LX) + (size_t)b * SEQ * DM + n * 64; _Float16* HL = (_Float16*)(F.ws + WS_HL); _Float16* PC = (_Float16*)(F.ws + (b < 3 ? WS_PC0 : WS_PC3)) - (size_t)(b < 3 ? 0 : 3) * (SEQ / 32) * 16 * 2 * 1024;
    LAS unsigned char* xbuf = F.lds + LRU_X_OFF + F.wave * 10240;
#define LRU_DMA(tile_) do { const bf16* p_ = LXb + ((long)(seg * LRU_SEG + (tile_) * 32 + (lane >> 3)) - 3) * DM + (((lane & 7) ^ ((lane >> 3) & 7)) << 3); \
        _Pragma("unroll") for (int q = 0; q < 5; ++q) __builtin_amdgcn_global_load_lds((const unsigned*)(p_ + (size_t)q * 8 * DM), (LAS unsigned*)(xbuf + ((tile_) & 1) * 5120 + q * 1024), 16, 0, 0); } while (0)
    LRU_DMA(0);
#pragma unroll 1
    for (int tile = 0; tile < LRU_SEG / 32; ++tile) {
        const int t0 = seg * LRU_SEG + tile * 32, t = t0 + r32;
        asm volatile("s_waitcnt vmcnt(0)" ::: "memory");
        if (tile + 1 < LRU_SEG / 32) LRU_DMA(tile + 1);
        const LAS unsigned char* xb = xbuf + (tile & 1) * 5120;


        h8v AX[4];
        v4u xw[4][4]; v4u wv[4][5];
#pragma unroll
        for (int ks = 0; ks < 4; ++ks) {
#pragma unroll
            for (int tap = 0; tap < 4; ++tap) { const int Rl = r32 + tap; xw[ks][tap] = *(const LAS v4u*)(xb + Rl * 128 + (((2 * ks + hi) ^ (Rl & 7)) << 4)); }
#pragma unroll
            for (int tap = 0; tap < 5; ++tap) wv[ks][tap] = *(const LAS v4u*)(cwH + tap * 64 + 16 * ks + 8 * hi);
        }
        __builtin_amdgcn_sched_barrier(0);
#pragma unroll
        for (int ks = 0; ks < 4; ++ks) {
            h8v acc = __builtin_bit_cast(h8v, wv[ks][4]);
#pragma unroll
            for (int tap = 0; tap < 4; ++tap) {
                v4u x4 = xw[ks][tap];
                if (t - 3 + tap < 0) x4 = (v4u){0u, 0u, 0u, 0u};
                acc = __builtin_bit_cast(h8v, wv[ks][tap]) * __builtin_bit_cast(h8v, x4) + acc;
            }
            AX[ks] = acc;
        }
#pragma unroll
        for (int nt = 0; nt < 2; ++nt) {
            f32x16 ar, ai, xq;
#pragma unroll
            for (int i = 0; i < 16; ++i) { ar[i] = 0.f; ai[i] = 0.f; xq[i] = 0.f; }
            h8v bwr[4], bwi[4];
#pragma unroll
            for (int ks = 0; ks < 4; ++ks) { bwr[ks] = __builtin_bit_cast(h8v, BWL[((0 * 2 + nt) * 4 + ks) * 64 + lane]); bwi[ks] = __builtin_bit_cast(h8v, BWL[((1 * 2 + nt) * 4 + ks) * 64 + lane]); }
            __builtin_amdgcn_sched_barrier(0);
#pragma unroll
            for (int ks = 0; ks < 4; ++ks) { ar = __builtin_amdgcn_mfma_f32_32x32x16_f16(AX[ks], bwr[ks], ar, 0, 0, 0); ai = __builtin_amdgcn_mfma_f32_32x32x16_f16(AX[ks], bwi[ks], ai, 0, 0, 0); }
            xq = __builtin_amdgcn_mfma_f32_32x32x16_f16(AX[2 * nt], __builtin_bit_cast(h8v, ID0), xq, 0, 0, 0);
            xq = __builtin_amdgcn_mfma_f32_32x32x16_f16(AX[2 * nt + 1], __builtin_bit_cast(h8v, ID1), xq, 0, 0, 0);
            float av[16], bv[16];
#pragma unroll
            for (int r = 0; r < 16; ++r) {
                const float ea = 1.f + __builtin_amdgcn_exp2f(ar[r] + bar_[nt]), eb = 1.f + __builtin_amdgcn_exp2f(ai[r] + bi_[nt]);
                const float rc = __builtin_amdgcn_rcpf(ea * eb), rr = rc * eb, ii = rc * ea;
                const float a = __builtin_amdgcn_exp2f(rr * L2A[nt]);
                av[r] = a; bv[r] = __builtin_amdgcn_sqrtf(fmaxf(1.f - a * a, 0.f)) * (ii * xq[r]);
            }
            float Ag[4], Bg[4];
#pragma unroll
            for (int a = 0; a < 4; ++a) { Ag[a] = (av[4 * a] * av[4 * a + 1]) * (av[4 * a + 2] * av[4 * a + 3]);
                Bg[a] = ((bv[4 * a] * av[4 * a + 1] + bv[4 * a + 1]) * av[4 * a + 2] + bv[4 * a + 2]) * av[4 * a + 3] + bv[4 * a + 3]; }
            float st = carry[nt], pr = Aseg[nt], hst[4], pst[4];
#pragma unroll
            for (int a = 0; a < 4; ++a) {
                const float Ap = __shfl_xor(Ag[a], 32), Bp = __shfl_xor(Bg[a], 32);
                const float Alo = hi ? Ap : Ag[a], Blo = hi ? Bp : Bg[a], Ahi = hi ? Ag[a] : Ap, Bhi = hi ? Bg[a] : Bp;
                const float s_lo = st; st = Alo * st + Blo; const float s_hi = st; st = Ahi * st + Bhi;
                const float p_lo = pr; pr *= Alo; const float p_hi = pr; pr *= Ahi;
                hst[a] = hi ? s_hi : s_lo; pst[a] = hi ? p_hi : p_lo;
            }
            carry[nt] = st; Aseg[nt] = pr;
            {
                float hv[16], pv[16];
#pragma unroll
                for (int a = 0; a < 4; ++a) { float h = hst[a], p = pst[a];
#pragma unroll
                    for (int e = 0; e < 4; ++e) { const int r = 4 * a + e; h = av[r] * h + bv[r]; p *= av[r]; hv[r] = h; pv[r] = p; } }
                const size_t toff = ((size_t)((b * (SEQ / 32) + seg * (LRU_SEG / 32) + tile) * 16 + n) * 2 + nt) * 1024 + lane * 16;
                v4u w0, w1;
                w0.x = pkh(hv[0], hv[1]); w0.y = pkh(hv[2], hv[3]); w0.z = pkh(hv[4], hv[5]); w0.w = pkh(hv[6], hv[7]); w1.x = pkh(hv[8], hv[9]); w1.y = pkh(hv[10], hv[11]); w1.z = pkh(hv[12], hv[13]); w1.w = pkh(hv[14], hv[15]);
                *(v4u*)(HL + toff) = w0; *(v4u*)(HL + toff + 8) = w1;
                w0.x = pkh(pv[0], pv[1]); w0.y = pkh(pv[2], pv[3]); w0.z = pkh(pv[4], pv[5]); w0.w = pkh(pv[6], pv[7]); w1.x = pkh(pv[8], pv[9]); w1.y = pkh(pv[10], pv[11]); w1.z = pkh(pv[12], pv[13]); w1.w = pkh(pv[14], pv[15]);
                *(v4u*)(PC + toff) = w0; *(v4u*)(PC + toff + 8) = w1;
            }
        }
    }
#undef LRU_DMA
    if (hi == 0) {
        float* ls = (float*)(F.ws + WS_LSUM);
#pragma unroll
        for (int nt = 0; nt < 2; ++nt) *(float2*)(ls + ((size_t)(b * LRU_NSEG + seg) * 1024 + n * 64 + 32 * nt + r32) * 2) = make_float2(Aseg[nt], carry[nt]);
    }
}

__device__ __forceinline__ void lru_pass2(Frame& F, const Args& A, int item) {
    const int half = item & 1, seg = (item >> 1) & 31, b = item >> 6, lane = F.lane, r32 = lane & 31, hi = lane >> 5;
    LAS float* hin = (LAS float*)F.lds;
    { const float* ls = (const float*)(F.ws + WS_LSUM) + ((size_t)b * LRU_NSEG * 1024 + half * 512 + F.tid) * 2; float h = 0.f;
      for (int s0 = 0; s0 < seg; s0 += 8) {
          float2 ab[8];
#pragma unroll
          for (int i = 0; i < 8; ++i) { const int s = (s0 + i < seg) ? s0 + i : seg - 1; ab[i] = *(const float2*)(ls + (size_t)s * 2048); }
#pragma unroll
          for (int i = 0; i < 8; ++i) if (s0 + i < seg) h = ab[i].x * h + ab[i].y;
      }
      hin[F.tid] = h; }
    __syncthreads();
    const int n = half * 8 + F.wave;
    const float h0 = hin[F.wave * 64 + r32], h1 = hin[F.wave * 64 + 32 + r32];
    LAS unsigned char* tb = F.lds + 4096 + F.wave * 4608;
    const _Float16* HL = (const _Float16*)(F.ws + WS_HL); const _Float16* PC = (const _Float16*)(F.ws + (b < 3 ? WS_PC0 : WS_PC3)) - (size_t)(b < 3 ? 0 : 3) * (SEQ / 32) * 16 * 2 * 1024;
    bf16* LR = (bf16*)(F.ws + WS_LGG);
    typedef _Float16 hh8 __attribute__((ext_vector_type(8)));
#pragma unroll 1
    for (int tile = 0; tile < LRU_SEG / 32; ++tile) {
        const int t0 = seg * LRU_SEG + tile * 32;
        const size_t toff = ((size_t)((b * (SEQ / 32) + seg * (LRU_SEG / 32) + tile) * 16 + n) * 2) * 1024 + lane * 16;
        hh8 hq[2][2], pq[2][2];
#pragma unroll
        for (int nt = 0; nt < 2; ++nt) { hq[nt][0] = *(const hh8*)(HL + toff + nt * 1024); hq[nt][1] = *(const hh8*)(HL + toff + nt * 1024 + 8); pq[nt][0] = *(const hh8*)(PC + toff + nt * 1024); pq[nt][1] = *(const hh8*)(PC + toff + nt * 1024 + 8); }
        v4u gw[4];
#pragma unroll
        for (int i = 0; i < 4; ++i) { const int q = lane + 64 * i; gw[i] = *(const v4u*)(LR + (size_t)(b * SEQ + t0 + (q >> 3)) * DM + n * 64 + 8 * (q & 7)); }
#pragma unroll
        for (int nt = 0; nt < 2; ++nt) { const float hc = nt ? h1 : h0;
#pragma unroll
            for (int r = 0; r < 16; ++r) { const float s = (float)hq[nt][r >> 3][r & 7] + (float)pq[nt][r >> 3][r & 7] * hc;
                *(LAS _Float16*)(tb + crow(r, hi) * 144 + (32 * nt + r32) * 2) = (_Float16)s; } }
        asm volatile("s_waitcnt lgkmcnt(0)" ::: "memory");
#pragma unroll
        for (int i = 0; i < 4; ++i) { const int q = lane + 64 * i;
            const hh8 sv = *(const LAS hh8*)(tb + (q >> 3) * 144 + 16 * (q & 7)); float g[8], o[8]; unpack_bf8(gw[i], g);
#pragma unroll
            for (int k = 0; k < 8; ++k) o[k] = (float)sv[k] * g[k];
            *(bf16x8*)(LR + (size_t)(b * SEQ + t0 + (q >> 3)) * DM + n * 64 + 8 * (q & 7)) = pack_bf8(o); }
        asm volatile("s_waitcnt lgkmcnt(0)" ::: "memory");
    }
    __syncthreads();
}

__device__ __forceinline__ void phase2(Frame& F, const Args& A) {
    p2_knorm(F, A);
    for (int rep = 0; rep < (REP_PHASE == 20 ? 2 : 1); ++rep)
    for (int u = F.vcu; u < 256; u += F.G) { p2_compress(F, A, u); __syncthreads(); }
    for (int rep = 0; rep < (REP_PHASE == 21 ? 2 : 1); ++rep)
    for (int it = F.vcu; it < 256; it += F.G) { lru_wg(F, A, it); __syncthreads(); }
}
namespace att {
constexpr int NSLOT = 4, SLOTB = 16384  , IMP_OFF = NSLOT * SLOTB, IMP_LD = 72, MSK_OFF = IMP_OFF + 4 * 64 * IMP_LD * 2, UNI_OFF = MSK_OFF + 512, SC_OFF = UNI_OFF + 16;
static_assert(SC_OFF + 4 * 64 * 4 * 4 <= RING_BYTES, "attention LDS map");
constexpr float NEGBIG = -1e30f, MREF0 = -8192.f, C2 = 0.125f * LOG2E, THR = 8.f;
constexpr int DIST = 2;

__device__ __forceinline__ void glds16(const void* gsrc, unsigned lds_dst) { unsigned keep;
    asm volatile("s_mov_b32 %0, m0\n\ts_mov_b32 m0, %2\n\ts_nop 0\n\tglobal_load_lds_dwordx4 %1, off\n\ts_mov_b32 m0, %0" : "=&s"(keep) : "v"(gsrc), "s"(lds_dst) : "memory"); }
#define ATT_WAIT_BAR(N) asm volatile("s_waitcnt vmcnt(" #N ") lgkmcnt(0)\n\ts_barrier" ::: "memory")
#define ATT_WAIT_BAR_NOVM() asm volatile("s_waitcnt lgkmcnt(0)\n\ts_barrier" ::: "memory")
__device__ __forceinline__ float fadd_s(float a, float b) { float r; asm("v_add_f32_e32 %0, %1, %2" : "=v"(r) : "v"(a), "v"(b)); return r; }
__device__ __forceinline__ float max3f(float a, float b, float c) { float r; asm("v_max3_f32 %0, %1, %2, %3" : "=v"(r) : "v"(a), "v"(b), "v"(c)); return r; }

#define ATT_SB() __builtin_amdgcn_sched_barrier(0)
__device__ __forceinline__ void qk_tile(const LAS unsigned char* kslot, const bf16x8* qf, float slk  , float base0, f32x16& p0, f32x16& p1, int r32, int hi) {
    const LAS unsigned char* kp = kslot + r32 * 128; const int kx = (r32 >> 1) & 7;
    bf16x8 kf[8];
#pragma unroll
    for (int d0 = 0; d0 < 4; ++d0) { const int so = ((2 * d0 + hi) ^ kx) << 4; kf[2 * d0] = *(const LAS bf16x8*)(kp + so); kf[2 * d0 + 1] = *(const LAS bf16x8*)(kp + 4096 + so); }
    ATT_SB();
    const float bl = base0 + slk * (float)(4 * hi), bh = bl + slk * 32.f;
#pragma unroll
    for (int r = 0; r < 16; ++r) { const float c = (float)((r & 3) + 8 * (r >> 2)); p0[r] = __builtin_fmaf(slk, c, bl); p1[r] = __builtin_fmaf(slk, c, bh); }
    ATT_SB();
    __builtin_amdgcn_s_setprio(1);
#pragma unroll
    for (int d0 = 0; d0 < 4; ++d0) {
        p0 = __builtin_amdgcn_mfma_f32_32x32x16_bf16(kf[2 * d0], qf[d0], p0, 0, 0, 0);
        p1 = __builtin_amdgcn_mfma_f32_32x32x16_bf16(kf[2 * d0 + 1], qf[d0], p1, 0, 0, 0);
    }
    __builtin_amdgcn_s_setprio(0);
    ATT_SB();
}
template <bool LE> __device__ __forceinline__ void mask_tile(f32x16& p0, f32x16& p1, int bound, int hi) {
    const int bb = bound - 4 * hi;
#pragma unroll
    for (int r = 0; r < 16; ++r) { const int c = (r & 3) + 8 * (r >> 2);
        if (LE) { if (c > bb) p0[r] = NEGBIG; if (c + 32 > bb) p1[r] = NEGBIG; }
        else { if (c < bb) p0[r] = NEGBIG; if (c + 32 < bb) p1[r] = NEGBIG; } }
}
__device__ __forceinline__ float row_max(const f32x16& p0, const f32x16& p1) {
    float a = max3f(p0[0], p0[1], p1[0]), b = max3f(p0[2], p0[3], p1[1]); a = max3f(a, p1[2], p1[3]);
#pragma unroll
    for (int r = 4; r < 16; r += 4) { a = max3f(a, p0[r], p0[r + 1]); b = max3f(b, p0[r + 2], p0[r + 3]); a = max3f(a, p1[r], p1[r + 1]); b = max3f(b, p1[r + 2], p1[r + 3]); }
    a = fmaxf(a, b);
    return fmaxf(a, __shfl_xor(a, 32));
}
__device__ __forceinline__ s16x4 vtr(const LAS unsigned char* p) { typedef short v4i16_t __attribute__((ext_vector_type(4))); return __builtin_bit_cast(s16x4, __builtin_amdgcn_ds_read_tr16_b64_v4i16((LAS v4i16_t*)p)); }
__device__ __forceinline__ void v_load(const LAS unsigned char* vslot, int d0, bf16x8* vf, int lane, int hi) {
    const int q4 = (lane & 15) >> 2, p4 = lane & 3, g2 = (lane >> 4) & 1;
    const LAS unsigned char* vp = vslot + (4 * hi + q4) * 128 + ((((4 * d0 + 2 * g2 + (p4 >> 1)) ^ ((q4 >> 1) << 2))) << 4) + 8 * (p4 & 1);
#pragma unroll
    for (int i = 0; i < 4; ++i) {
        const s16x4 lo = vtr(vp + i * 2048), hh = vtr(vp + i * 2048 + 1024);
        vf[i] = (bf16x8){lo[0], lo[1], lo[2], lo[3], hh[0], hh[1], hh[2], hh[3]};
    }
    ATT_SB();
}
__device__ __forceinline__ void pack_p(const f32x16& p0, const f32x16& p1, bf16x8* pa) {
    float t[8];
#pragma unroll
    for (int i = 0; i < 8; ++i) t[i] = p0[i];
    pa[0] = pack_bf8(t);
#pragma unroll
    for (int i = 0; i < 8; ++i) t[i] = p0[8 + i];
    pa[1] = pack_bf8(t);
#pragma unroll
    for (int i = 0; i < 8; ++i) t[i] = p1[i];
    pa[2] = pack_bf8(t);
#pragma unroll
    for (int i = 0; i < 8; ++i) t[i] = p1[8 + i];
    pa[3] = pack_bf8(t);
}
__device__ __forceinline__ void pv_mma_packed(const LAS unsigned char* vslot, const bf16x8* vf0, const bf16x8* pa, f32x16* o, int lane, int hi) {
    bf16x8 vf1[4]; v_load(vslot, 1, vf1, lane, hi);
    __builtin_amdgcn_s_setprio(1);
#pragma unroll
    for (int ks = 0; ks < 4; ++ks) o[0] = __builtin_amdgcn_mfma_f32_32x32x16_bf16(vf0[ks], pa[ks], o[0], 0, 0, 0);
#pragma unroll
    for (int ks = 0; ks < 4; ++ks) o[1] = __builtin_amdgcn_mfma_f32_32x32x16_bf16(vf1[ks], pa[ks], o[1], 0, 0, 0);
    __builtin_amdgcn_s_setprio(0);
    ATT_SB();
}
__device__ __forceinline__ void pv_mma(const LAS unsigned char* vslot, const bf16x8* vf0, const f32x16& p0, const f32x16& p1, f32x16* o, int lane, int hi) {
    bf16x8 pa[4]; pack_p(p0, p1, pa); ATT_SB();
    pv_mma_packed(vslot, vf0, pa, o, lane, hi);
}
__device__ __forceinline__ float softmax_exp(f32x16& p0, f32x16& p1, float& mref, float& l, f32x16* o, bool has_o) {
    const float rm = row_max(p0, p1); float fac = 1.f;
    if (__any(rm > THR)) {
        const float d = fmaxf(rm, 0.f), alpha = __builtin_amdgcn_exp2f(-d); mref += d; l *= alpha; fac = alpha;
#pragma unroll
        for (int r = 0; r < 16; ++r) { p0[r] -= d; p1[r] -= d; }
        if (has_o) {
#pragma unroll
            for (int r = 0; r < 16; ++r) { o[0][r] *= alpha; o[1][r] *= alpha; }
        }
    }
#pragma unroll
    for (int r = 0; r < 16; ++r) { p0[r] = __builtin_amdgcn_exp2f(p0[r]); p1[r] = __builtin_amdgcn_exp2f(p1[r]); }
    return fac;
}
__device__ __forceinline__ void softmax_sum(const f32x16& p0, const f32x16& p1, float& l) {
    float s0 = 0.f, s1 = 0.f;
#pragma unroll
    for (int r = 0; r < 16; ++r) { s0 += p0[r]; s1 += p1[r]; }
    l += s0 + s1;
}
__device__ __forceinline__ float softmax_step(f32x16& p0, f32x16& p1, float& mref, float& l, f32x16* o, bool has_o) { const float f = softmax_exp(p0, p1, mref, l, o, has_o); softmax_sum(p0, p1, l); return f; }

__device__ __forceinline__ void attn_unit(Frame& F, const Args& A, int bg, int qt) {
    int lane = F.lane; asm volatile("" : "+v"(lane));
    const int b = bg >> 2, g = bg & 3, wid = F.wave, r32 = lane & 31, hi = lane >> 5;
    const int hh = wid & 3, qh = wid >> 2, head = g * 4 + hh;
    const int t0 = qt * 64, u = 32 * qh + r32, t = t0 + u; const size_t m = (size_t)b * SEQ + t;
    LAS unsigned char* lds = F.lds;
    const unsigned lds0 = (unsigned)(uintptr_t)lds;
    unsigned char* ws = F.ws;
    if (F.tid == 0) { *(LAS unsigned*)(lds + UNI_OFF) = 0u; *(LAS unsigned*)(lds + UNI_OFF + 4) = 0u; }
    const bf16* KCb = (const bf16*)(ws + WS_KC) + (size_t)bg * NCP * 64; const bf16* VCb = (const bf16*)(ws + WS_VC) + (size_t)bg * NCP * 64;
    const bf16* KVb = (const bf16*)(ws + WS_KVB) + (size_t)b * SEQ * KVW + g * 64;
    const int rowl = 8 * wid + (lane >> 3), kch = (lane & 7) ^ ((rowl >> 1) & 7), vch = (lane & 7) ^ (((rowl >> 1) & 1) << 2);
    const int kofC = rowl * 64 + kch * 8, vofC = rowl * 64 + vch * 8;
    const int kofT = rowl * KVW + kch * 8, vofT = rowl * KVW + vch * 8;
    const int nct = (((t0 + 32) >> 4) >> 6) + 1;
    const int jlast = qt >= 8 ? qt - 8 : 0, nw = qt - jlast + 1;
    const int sW = nct, sS = sW + nw;
    int total = sS;
    int ipos = 0;
    unsigned long long iss_uni = 0ull;
    const unsigned kdst = lds0 + wid * 1024, vdst = lds0 + 8192 + wid * 1024;
#define ATT_ISSUE() do { if (ipos < total) { const unsigned so = (unsigned)(ipos & (NSLOT - 1)) * SLOTB; \
        if (ipos < sW) { const int row = 64 * ipos; glds16(KCb + row * 64 + kofC, (unsigned)__builtin_amdgcn_readfirstlane(kdst + so)); glds16(VCb + row * 64 + vofC, (unsigned)__builtin_amdgcn_readfirstlane(vdst + so)); } \
        else { int j; const bf16* kb_; if (ipos < sS) { j = qt - (ipos - sW); kb_ = KVb + 4 * 256; } else { j = 63 - __builtin_clzll(iss_uni); iss_uni &= ~(1ull << j); kb_ = KVb + 2 * 256; } \
               const bf16* p_ = kb_ + (size_t)j * 64 * KVW; glds16(p_ + kofT, (unsigned)__builtin_amdgcn_readfirstlane(kdst + so)); glds16(p_ + 256 + vofT, (unsigned)__builtin_amdgcn_readfirstlane(vdst + so)); } \
        ++ipos; } } while (0)
#define ATT_STEP_END(cpos) do { const int ahead = ipos - (cpos) - 2; if (ahead >= 2) ATT_WAIT_BAR(4); else if (ahead == 1) ATT_WAIT_BAR(2); else ATT_WAIT_BAR(0); } while (0)
    ATT_ISSUE(); ATT_ISSUE();
    bf16x8 qf[4];
    {
        const bf16* qp = (const bf16*)(ws + WS_QB) + m * DM + head * 64 + 8 * hi; const float* qng = A.in[3] + 8 * hi;
        v4u w[4]; float ss = 0.f;
#pragma unroll
        for (int ks = 0; ks < 4; ++ks) { w[ks] = *(const v4u*)(qp + 16 * ks); float v[8]; unpack_bf8(w[ks], v);
#pragma unroll
            for (int e = 0; e < 8; ++e) ss += v[e] * v[e]; }
        ss += __shfl_xor(ss, 32);
        const float rs = C2 / sqrtf(ss * (1.f / 64) + EPS);
#pragma unroll
        for (int ks = 0; ks < 4; ++ks) { float v[8]; unpack_bf8(w[ks], v);
#pragma unroll
            for (int e = 0; e < 8; ++e) v[e] *= rs * qng[16 * ks + e];
            qf[ks] = pack_bf8(v); }
    }
    const float sl2 = exp2f(-0.5f * (float)(head + 1)) * LOG2E;
    const bf16* NGp = (const bf16*)(ws + WS_NG) + m * 48 + head * 3;
    const float gate_c = bf2f(NGp[0]), gate_s = bf2f(NGp[1]), gate_w = bf2f(NGp[2]);
    f32x16 o[2];
    unsigned oaccp[2][8];
#pragma unroll
    for (int i = 0; i < 8; ++i) { oaccp[0][i] = 0u; oaccp[1][i] = 0u; }
#define ATT_FOLD(sc_) do { _Pragma("unroll") for (int d_ = 0; d_ < 2; ++d_) _Pragma("unroll") for (int i_ = 0; i_ < 8; ++i_) { \
        const float a_ = bflo(oaccp[d_][i_]) + (sc_) * o[d_][2 * i_], b_ = bfhi(oaccp[d_][i_]) + (sc_) * o[d_][2 * i_ + 1]; oaccp[d_][i_] = cvtpk(a_, b_); } } while (0)
    ATT_WAIT_BAR(0);
    int cpos = 0;
#if PROBE_ID
    unsigned* pc = (unsigned*)(ws + WS_CTL) + 8192; unsigned long long ts0 = __builtin_amdgcn_s_memtime();
#define PROBE_MARK(k) do { const unsigned long long ts1 = __builtin_amdgcn_s_memtime(); if (F.tid == 0) atomicAdd(pc + (k), (unsigned)((ts1 - ts0) >> 4)); ts0 = ts1; } while (0)
#else
#define PROBE_MARK(k) do {} while (0)
#endif
#define ATT_K(cpos) (lds + (unsigned)((cpos) & (NSLOT - 1)) * SLOTB)
#define ATT_V(cpos) (lds + (unsigned)((cpos) & (NSLOT - 1)) * SLOTB + 8192)
    {
        const int nmax = (t - 31) >> 4;
        float mref = MREF0, l = 0.f, mk[4] = {0.f, 0.f, 0.f, 0.f};
#pragma unroll
        for (int r = 0; r < 16; ++r) { o[0][r] = 0.f; o[1][r] = 0.f; }
        LAS _Float16* impw = (LAS _Float16*)(lds + IMP_OFF) + (hh * 64 + u) * IMP_LD;
        float ecarry = 0.f;
#pragma unroll
        for (int kt = 0; kt < 4; ++kt) {
            if (kt < nct) {
                ATT_ISSUE();
                f32x16 p0, p1;
                qk_tile(ATT_K(cpos), qf, sl2 * 16.f, sl2 * (float)(1024 * kt + 31 - t0) - mref, p0, p1, r32, hi);
                bf16x8 vf[4]; v_load(ATT_V(cpos), 0, vf, lane, hi);
                mask_tile<true>(p0, p1, nmax - 64 * kt, hi);
                ecarry *= softmax_step(p0, p1, mref, l, o, true);
                mk[kt] = mref;
                float Eo[2][4];
#pragma unroll
                for (int a4 = 0; a4 < 4; ++a4) { Eo[0][a4] = __shfl_xor(p0[4 * a4 + 3], 32); Eo[1][a4] = __shfl_xor(p1[4 * a4 + 3], 32); }
#pragma unroll
                for (int s = 0; s < 2; ++s)
#pragma unroll
                    for (int a4 = 0; a4 < 4; ++a4) {
                        const float G = s == 0 ? (p0[4 * a4] + p0[4 * a4 + 1]) + (p0[4 * a4 + 2] + p0[4 * a4 + 3]) : (p1[4 * a4] + p1[4 * a4 + 1]) + (p1[4 * a4 + 2] + p1[4 * a4 + 3]);
                        const float prev = a4 >= 1 ? Eo[s][a4 - 1] : (s == 1 ? Eo[0][3] : ecarry);
                        impw[16 * kt + 8 * s + 2 * a4 + hi] = (_Float16)(G + (hi ? Eo[s][a4] : prev));
                    }
                ecarry = Eo[1][3];
                pv_mma(ATT_V(cpos), vf, p0, p1, o, lane, hi);
                ATT_STEP_END(cpos); ++cpos;
            }
        }
        l += __shfl_xor(l, 32);
        const float inv = l > 0.f ? 1.0f / l : 0.f;
        if (hi == 0) { f32x4 sc; sc[0] = __builtin_amdgcn_exp2f(mk[0] - mref) * inv; sc[1] = __builtin_amdgcn_exp2f(mk[1] - mref) * inv; sc[2] = __builtin_amdgcn_exp2f(mk[2] - mref) * inv; sc[3] = __builtin_amdgcn_exp2f(mk[3] - mref) * inv;
            *(LAS f32x4*)(lds + SC_OFF + (hh * 64 + u) * 16) = sc; }
        const float gsc = gate_c * inv;
        ATT_FOLD(gsc);
        asm volatile("s_waitcnt lgkmcnt(0)\n\ts_barrier" ::: "memory");
    }
    PROBE_MARK(0);
    {
        const int q = lane >> 3, kg = lane & 7, uq = 8 * wid + q, tq = t0 + uq;
        float v[8];
#pragma unroll
        for (int i = 0; i < 8; ++i) v[i] = 0.f;
#pragma unroll
        for (int h4 = 0; h4 < 4; ++h4) { typedef _Float16 h8 __attribute__((ext_vector_type(8)));
            const h8 x = *(const LAS h8*)(lds + IMP_OFF + ((h4 * 64 + uq) * IMP_LD + 8 * kg) * 2);
            const float sc = *(const LAS float*)(lds + SC_OFF + (h4 * 64 + uq) * 16 + 4 * (kg >> 1));
#pragma unroll
            for (int i = 0; i < 8; ++i) v[i] += (float)x[i] * sc; }
        unsigned key[8];
#pragma unroll
        for (int i = 0; i < 8; ++i) { const int j = 8 * kg + i; const bool valid = (64 * j <= tq), forced = (j == 0) || (j == qt) || (j == qt - 1);
            const float val = v[i] + (forced ? 1e4f : 0.f);
            key[i] = valid ? (((__float_as_uint(val) >> 16) << 6) | (unsigned)(63 - j)) : 0u; }
        unsigned thr = 0u;
#pragma unroll 1
        for (int bit = 20; bit >= 0; --bit) {
            const unsigned cand = thr | (1u << bit); int c = 0;
#pragma unroll
            for (int i = 0; i < 8; ++i) c += (key[i] >= cand) ? 1 : 0;
            c += __builtin_amdgcn_update_dpp(0, c, 0xB1, 0xF, 0xF, true);
            c += __builtin_amdgcn_update_dpp(0, c, 0x4E, 0xF, 0xF, true);
            c += __builtin_amdgcn_update_dpp(0, c, 0x141, 0xF, 0xF, true);
            thr = c >= 16 ? cand : thr;
        }
        unsigned m8 = 0u;
#pragma unroll
        for (int i = 0; i < 8; ++i) m8 |= ((key[i] != 0u && key[i] >= thr) ? 1u : 0u) << i;
        *(LAS unsigned char*)(lds + MSK_OFF + 8 * uq + kg) = (unsigned char)m8;
        __hip_atomic_fetch_or((LAS unsigned*)(lds + UNI_OFF + 4 * (kg >> 2)), m8 << (8 * (kg & 3)), __ATOMIC_RELAXED, __HIP_MEMORY_SCOPE_WORKGROUP);
        asm volatile("s_waitcnt lgkmcnt(0)\n\ts_barrier" ::: "memory");
    }
    const unsigned mlo = *(const LAS unsigned*)(lds + MSK_OFF + 8 * u), mhi = *(const LAS unsigned*)(lds + MSK_OFF + 8 * u + 4);
    const unsigned long long mymask = ((unsigned long long)mhi << 32) | mlo;
    unsigned long long cmp_uni = ((unsigned long long)(unsigned)__builtin_amdgcn_readfirstlane((int)*(const LAS unsigned*)(lds + UNI_OFF + 4)) << 32) | (unsigned)__builtin_amdgcn_readfirstlane((int)*(const LAS unsigned*)(lds + UNI_OFF));
    iss_uni = cmp_uni; total = sS + __builtin_popcountll(cmp_uni);
    PROBE_MARK(1);
#if PROBE_ID
    if (F.tid == 0) { atomicAdd(pc + 4, (unsigned)__builtin_popcountll(cmp_uni)); atomicAdd(pc + 5, (unsigned)(2 * nct + nw)); }
#endif
#define ATT_WS_LOOP(DEFER) { \
        float mref = MREF0, l = 0.f; \
        _Pragma("unroll") for (int r = 0; r < 16; ++r) { o[0][r] = 0.f; o[1][r] = 0.f; } \
        bf16x8 pa[4]; \
        const int nsteps = nw + __builtin_popcountll(cmp_uni); \
        for (int st = 0; st < nsteps; ++st, ++cpos) { \
            int j; bool win; \
            if (st < nw) { j = qt - st; win = true; } else { j = 63 - __builtin_clzll(cmp_uni); cmp_uni &= ~(1ull << j); win = false; } \
            if (DEFER && st > 0) { bf16x8 vf[4]; v_load(ATT_V(cpos - 1), 0, vf, lane, hi); pv_mma_packed(ATT_V(cpos - 1), vf, pa, o, lane, hi); } \
            if (st == nw) { \
                PROBE_MARK(2); \
                l += __shfl_xor(l, 32); \
                const float sc = l > 0.f ? gate_w / l : 0.f; \
                ATT_FOLD(sc); \
                _Pragma("unroll") for (int r = 0; r < 16; ++r) { o[0][r] = 0.f; o[1][r] = 0.f; } \
                mref = MREF0; l = 0.f; \
            } \
            ATT_ISSUE(); \
            f32x16 p0, p1; \
            const float selb = (win || ((mymask >> j) & 1ull)) ? 0.f : NEGBIG; \
            qk_tile(ATT_K(cpos), qf, sl2, sl2 * (float)(64 * j - t0) - mref + selb, p0, p1, r32, hi); \
            if (!DEFER) { \
                bf16x8 vf[4]; v_load(ATT_V(cpos), 0, vf, lane, hi); \
                if (j == qt) mask_tile<true>(p0, p1, u, hi); \
                if (win && j == qt - 8) mask_tile<false>(p0, p1, u + 1, hi); \
                softmax_step(p0, p1, mref, l, o, true); \
                pv_mma(ATT_V(cpos), vf, p0, p1, o, lane, hi); \
            } else { \
                if (j == qt) mask_tile<true>(p0, p1, u, hi); \
                if (win && j == qt - 8) mask_tile<false>(p0, p1, u + 1, hi); \
                softmax_step(p0, p1, mref, l, o, true); \
                pack_p(p0, p1, pa); \
            } \
            ATT_STEP_END(cpos); \
        } \
        if (DEFER) { bf16x8 vf[4]; v_load(ATT_V(cpos - 1), 0, vf, lane, hi); pv_mma_packed(ATT_V(cpos - 1), vf, pa, o, lane, hi); } \
        l += __shfl_xor(l, 32); \
        const float sc = l > 0.f ? gate_s / l : 0.f; \
        ATT_FOLD(sc); \
    }
    if (F.grp != 0) ATT_WS_LOOP(true) else ATT_WS_LOOP(false)
#undef ATT_WS_LOOP
    PROBE_MARK(3);
    bf16* op = (bf16*)(ws + WS_QB) + m * DM + head * 64 + 4 * hi;
#pragma unroll
    for (int d0 = 0; d0 < 2; ++d0)
#pragma unroll
        for (int a = 0; a < 4; ++a) { v2u pk; pk.x = oaccp[d0][2 * a]; pk.y = oaccp[d0][2 * a + 1]; *(v2u*)(op + 32 * d0 + 8 * a) = pk; }
#undef ATT_FOLD
#undef ATT_ISSUE
#undef ATT_STEP_END
#undef ATT_K
#undef ATT_V
}
#undef ATT_WAIT_BAR
#undef ATT_WAIT_BAR_NOVM
#undef ATT_SB
}

__device__ __forceinline__ void phase3(Frame& F, const Args& A) {
    for (int it = F.vcu; it < 256; it += F.G) lru_pass2(F, A, it);
#if FAST_ATTN
    __syncthreads();
    {
        const bool lab8 = (F.G % 8) == 0; const int nq = lab8 ? 8 : 1, lab = lab8 ? (int)(blockIdx.x & 7) : 0, per = 1024 / nq;
        unsigned* head = (unsigned*)(F.ws + WS_CTL) + CW_QUEUE + 64 * lab;
        volatile LAS unsigned* slotw = (volatile LAS unsigned*)(F.lds + MISC_OFF + 96);
        PIN(PIN_ATT);
        for (;;) {
            if (F.tid == 0) *slotw = __hip_atomic_fetch_add(head, 1u, __ATOMIC_RELAXED, __HIP_MEMORY_SCOPE_AGENT);
            __syncthreads();
            const int i = (int)*slotw;
            __syncthreads();
            if (i >= per) break;
            const int nbg = 16 / nq, bg = lab * nbg + (i % nbg), qt = 63 - i / nbg;
            att::attn_unit(F, A, bg, qt);
            __syncthreads();
        }
    }
#endif
}
constexpr int N_PHASES = 8;

__global__ void __launch_bounds__(NWAVES * 64, 2) fwd_kernel(Args args) {
    extern __shared__ __attribute__((aligned(16))) unsigned char lds[];
    Frame F;
    F.lds = (LAS unsigned char*)lds;
    F.MISC = (volatile LAS unsigned*)(F.lds + MISC_OFF);
    F.tid = threadIdx.x; F.lane = F.tid & 63; F.wave = __builtin_amdgcn_readfirstlane(F.tid >> 6);
    F.G = gridDim.x; { const int bx = blockIdx.x; F.vcu = (F.G % 8 == 0) ? (bx % 8) * (F.G / 8) + bx / 8 : bx; }
    F.out = args.out; F.ws = args.ws; unsigned char* ws = args.ws;
    F.ctl = (gu32*)(ws + WS_CTL);
    for (int u = F.tid; u < (LDS_BYTES - LDSCTL_OFF) / 4; u += NWAVES * 64) ((LAS unsigned*)(F.lds + LDSCTL_OFF))[u] = 0u;
    __syncthreads();
    { const unsigned simd = ((unsigned)__builtin_amdgcn_s_getreg((1 << 11) | (4 << 6) | 4)) & 3u;
      int slot = 0; if (F.lane == 0) slot = (int)__hip_atomic_fetch_add((LAS unsigned*)(F.lds + MISC_OFF + 64 + 4 * simd), 1u, __ATOMIC_RELAXED, __HIP_MEMORY_SCOPE_WORKGROUP);
      F.grp = __builtin_amdgcn_readfirstlane(slot) & 1; }
    const int lo = args.ph_lo, hi = args.ph_hi;
    const bool multi = (hi - lo) > 1;
    XcdBarrier bar; bar.bar = (unsigned*)(F.ctl + CW_BAR); bar.x = 0; bar.st = nullptr;
    if (multi) bar = xcd_barrier_post((unsigned*)(F.ctl + CW_BAR), F.MISC + 8);
    unsigned* labw = (unsigned*)(F.ctl + CW_LAB) + 64 * (blockIdx.x & 7);
    if (multi && F.tid == 0) (void)__hip_atomic_fetch_or(labw + 16, 1u << xb_xcc_id(), __ATOMIC_RELAXED, __HIP_MEMORY_SCOPE_AGENT);
    bool lab_local = false;
#ifdef ONLY
#define IN(k) ((k) == ONLY && lo <= (k) && (k) < hi)
#else
#define IN(k) (lo <= (k) && (k) < hi)
#endif
#if PROBE_ID >= 10
#define STAMP(k) do { if (blockIdx.x == 0 && F.tid == 0) F.MISC[12 + (k)] = (unsigned)__builtin_amdgcn_s_memrealtime(); } while (0)
#else
#define STAMP(k) do {} while (0)
#endif
#define SEAM_L(k) do { if (IN(k) && IN((k) + 1)) { if (lab_local) label_barrier(labw, 32u, bar.bar); else xcd_barrier(bar); } STAMP((k) + 1); } while (0)
#define SEAM(k) do { if (IN(k) && IN((k) + 1)) xcd_barrier(bar); STAMP((k) + 1); } while (0)
    using namespace pg8;
    PG8_LAS unsigned char* ring = (PG8_LAS unsigned char*)lds;

#ifndef REP_PHASE
#define REP_PHASE -1
#endif
#define NREP(k) ((k) == REP_PHASE ? 2 : 1)
    STAMP(0);
    if (IN(0)) { p0_prologue<false>(F, args); SEAM(0); }

    if (IN(1)) {
        Gemm g{2 * DM, 128, 2 * DM, 128, DM / 64};
        SchedSimple S; S.T.init(M_ROWS, NPROJ, F.G, (int)blockIdx.x); S.A = (const char*)(ws + WS_XB); S.B = (const char*)(ws + WS_WIN); S.tA = (size_t)256 * 2 * DM; S.tB = (size_t)256 * 2 * DM;
        EpiProj E{(const float*)(ws + WS_RSTD1), (bf16_t*)(ws + WS_QB), (bf16_t*)(ws + WS_KVB), (bf16_t*)(ws + WS_NG), (bf16_t*)(ws + WS_LX), (bf16_t*)(ws + WS_LGG), (bf16_t*)F.out};
        gemm_phase<EpiProj, SchedSimple, GEMM_ALIGN_P1>(ring, g, S, E);
        {
            const int nwg = S.T.nwg, G = F.G, rem = nwg % G, c = (int)blockIdx.x;
            if (rem == 0) p0_prologue<true>(F, args, c, G);
            else if (c >= rem) p0_prologue<true>(F, args, c - rem, G - rem);
        }
        SEAM(1);
    }
    if (IN(2)) { PIN(38); phase2(F, args); SEAM(2); }
    if (IN(3)) { PIN(53); phase3(F, args); SEAM(3); }
    if (multi && F.G == 256) {
        bool ok = true;
#pragma unroll
        for (int j = 0; j < 8; ++j) { const unsigned mk = xb_ld((unsigned*)(F.ctl + CW_LAB) + 64 * j + 16); ok = ok && (mk != 0u) && ((mk & (mk - 1u)) == 0u); }
        lab_local = __builtin_amdgcn_readfirstlane((int)ok) != 0;
    }
    if (IN(4)) { PIN(55);
        Gemm g{2 * DM, 128, 2 * DM, 128, DM / 64};
        SchedMerge S; S.T.init(M_ROWS, DM, F.G, (int)blockIdx.x); S.A0 = (const char*)(ws + WS_QB); S.A1 = (const char*)(ws + WS_LGG); S.B0 = (const char*)(ws + WS_WOA); S.B1 = (const char*)(ws + WS_WOL);
        S.tA = (size_t)256 * 2 * DM; S.tB = (size_t)256 * 2 * DM;
        EpiMerge E{(const bf16_t*)F.out, (bf16_t*)(ws + WS_LX)};
        for (int rep = 0; rep < NREP(4); ++rep) gemm_phase<EpiMerge, SchedMerge>(ring, g, S, E);
        STAMP(5);
    }
    if (IN(5)) { PIN(54);
        Gemm g{2 * DM, 128, 2 * DM, 128, DM / 64};
        SchedSimple S; S.T.init(M_ROWS, DM, F.G, (int)blockIdx.x); S.A = (const char*)(ws + WS_LX); S.B = (const char*)(ws + WS_WOUT); S.tA = (size_t)256 * 2 * DM; S.tB = (size_t)256 * 2 * DM;
        EpiWout E{args.in[0], F.out, (bf16_t*)(ws + WS_XB), (float*)(ws + WS_SSQ)};
        LabelSeam sm{IN(4) && IN(5), lab_local, labw, 32u, bar};
        gemm_phase<EpiWout, SchedSimple, true, LabelSeam>(ring, g, S, E, sm);
        SEAM_L(5);
    }
    if (IN(6)) { PIN(33);
        Gemm g{2 * DM, 128, 2 * DM, 128, DM / 64};
        SchedHalfTail S; S.T.init(M_ROWS, NGU, F.G, (int)blockIdx.x); S.A = (const char*)(ws + WS_XB); S.B = (const char*)(ws + WS_WGU); S.tA = (size_t)256 * 2 * DM; S.tB = (size_t)256 * 2 * DM;
        S.full = (F.G % 8 == 0 && 2 * (S.T.nwg % F.G) <= F.G) ? S.T.nwg / F.G : (S.T.nwg + F.G - 1) / F.G;
        EpiGU E{(const float*)(ws + WS_SSQ), (bf16_t*)(ws + WS_FF)};
        for (int rep = 0; rep < NREP(6); ++rep) gemm_phase<EpiGU, SchedHalfTail, GEMM_ALIGN_P6>(ring, g, S, E);
        STAMP(7);
    }
    if (IN(7)) { PIN(39);
        Gemm g{2 * DFF, 128, 2 * DFF, 128, DFF / 64};
        SchedSimple S; S.T.init(M_ROWS, DM, F.G, (int)blockIdx.x); S.A = (const char*)(ws + WS_FF); S.B = (const char*)(ws + WS_WDN); S.tA = (size_t)256 * 2 * DFF; S.tB = (size_t)256 * 2 * DFF;
        EpiDown E{F.out, (const bf16_t*)(ws + WS_XB)};
        LabelSeam sm{IN(6) && IN(7), lab_local, labw, 96u, bar};
        gemm_phase<EpiDown, SchedSimple, true, LabelSeam>(ring, g, S, E, sm);
#if PROBE_ID
        const unsigned now_ = (unsigned)__builtin_amdgcn_s_memrealtime();
        xcd_barrier(bar);
        if (blockIdx.x == 0 && F.tid == 0) { const unsigned* pc = (const unsigned*)(ws + WS_CTL) + 8192; float v = 0.f;
            const float c0 = (float)__hip_atomic_load(pc + 0, RLX_AGENT), c1 = (float)__hip_atomic_load(pc + 1, RLX_AGENT), c2 = (float)__hip_atomic_load(pc + 2, RLX_AGENT), c3 = (float)__hip_atomic_load(pc + 3, RLX_AGENT);
            const float c4 = (float)__hip_atomic_load(pc + 4, RLX_AGENT), c5 = (float)__hip_atomic_load(pc + 5, RLX_AGENT);
            if (PROBE_ID == 30) v = lab_local ? 64.f : 32.f;
            if (PROBE_ID == 1) v = c4 / 1024.f;
            if (PROBE_ID == 2) v = 100.f * c0 / (c0 + c1 + c2 + c3);
            if (PROBE_ID == 3) v = 100.f * c1 / (c0 + c1 + c2 + c3);
            if (PROBE_ID == 4) v = 100.f * c2 / (c0 + c1 + c2 + c3);
            if (PROBE_ID == 5) v = 100.f * c3 / (c0 + c1 + c2 + c3);
            if (PROBE_ID == 6) v = 16.f * (c0 + c2 + c3) / (c4 + c5) / 100.f;
            if (PROBE_ID == 7) v = 16.f * c1 / 1024.f / 100.f;
            if (PROBE_ID >= 20 && PROBE_ID < 27) { float tot = 0.f, mine = 0.f;
                for (int i = 0; i < 7; ++i) { const float ci = (float)__hip_atomic_load(pc + 8 + i, RLX_AGENT); tot += ci; if (i == PROBE_ID - 20) mine = ci; }
                v = 100.f * mine / tot; }
            if (PROBE_ID >= 10 && PROBE_ID < 18) { const unsigned now = now_; const int k = PROBE_ID - 10;
                const unsigned t1 = k == 7 ? now : F.MISC[12 + k + 1], t0_ = F.MISC[12 + k]; v = (float)(t1 - t0_) * 0.01f; if (PROBE_ID == 10 || PROBE_ID == 16) v = 10.f + floorf(v / 20.f); if (PROBE_ID == 13) v = floorf(v * 0.5f) - 80.f; if (PROBE_ID == 14) v = 2.f * floorf(v * 0.5f); if (PROBE_ID == 11) v = 2.f * floorf((v - 150.f) * 0.5f); if (PROBE_ID == 15) v = 2.f * floorf(v * 0.5f); }
            const float y0 = __hip_atomic_load(F.out, RLX_AGENT); F.out[0] = y0 + v; }
#endif
    }
#undef IN
#undef SEAM
}

extern "C" void kernel_launch(void* const* d_in, const int* in_sizes, int n_in, void* d_out, int out_size, void* d_ws, size_t ws_size, hipStream_t stream) {
    static int grid = 0;
    if (grid == 0) {
        if (n_in != 29 || out_size != M_ROWS * DM || ws_size < WS_END) { fprintf(stderr, "kernel_launch: unexpected problem (n_in %d, out %d, ws %zu)\n", n_in, out_size, ws_size); grid = -1; return; }
        int dev = 0, cus = 0, per_cu = 0;
        if (hipGetDevice(&dev) != hipSuccess || hipDeviceGetAttribute(&cus, hipDeviceAttributeMultiprocessorCount, dev) != hipSuccess) { grid = -1; return; }
        if (hipFuncSetAttribute((const void*)fwd_kernel, hipFuncAttributeMaxDynamicSharedMemorySize, LDS_BYTES) != hipSuccess) { fprintf(stderr, "kernel_launch: hipFuncSetAttribute failed\n"); grid = -1; return; }
        if (hipOccupancyMaxActiveBlocksPerMultiprocessor(&per_cu, (const void*)fwd_kernel, NWAVES * 64, LDS_BYTES) != hipSuccess || per_cu < 1) { fprintf(stderr, "kernel_launch: occupancy query says %d blocks per CU\n", per_cu); grid = -1; return; }
        (void)hipGetLastError();
        grid = cus;
        if (grid > 256) grid = 256;
    }
    if (grid < 0) return;
    (void)hipMemsetAsync((char*)d_ws + WS_CTL, 0, CTL_ZERO_BYTES, stream);
    Args a{};
    for (int i = 0; i < 29; ++i) a.in[i] = (const float*)d_in[i];
    a.out = (float*)d_out; a.ws = (unsigned char*)d_ws;
#if N_LAUNCHES == 1
    a.ph_lo = 0; a.ph_hi = N_PHASES;
    hipLaunchKernelGGL(fwd_kernel, dim3(grid), dim3(NWAVES * 64), LDS_BYTES, stream, a);
#else
    for (int p = 0; p < N_PHASES; ++p) {
        a.ph_lo = p; a.ph_hi = p + 1;
        hipLaunchKernelGGL(fwd_kernel, dim3(grid), dim3(NWAVES * 64), LDS_BYTES, stream, a);
    }
#endif
}
```
